# Optimizing an MI355X kernel written in HIP

```python
import jax
import jax.numpy as jnp
from jax import lax
import numpy as np

D_MODEL = 2048
BATCH = 2
SEQ = 16384
DEPTH = 2

MEM_LEN = 256
D_FF = 5504
EPS = 1e-6
NEG = -1e30
FORCED = 1e9
Q_BLOCK = 128

NSA_HEADS = 6
NSA_GROUPS = 2
NSA_HEAD_DIM = 128
CMP_LEN = 32
CMP_STRIDE = 16
CMP_HIDDEN = 256
SEL_LEN = 64
SEL_TOPN = 16
WIN_LEN = 512

DIL_PATTERNS = ((128, 1), (512, 4), (2048, 16))
DIL_GROUPS = 3
DIL_HEADS = 4
DIL_HEAD_DIM = 64

MEM_HEADS = 4
MEM_HEAD_DIM = 128

N_ALIBI = NSA_HEADS + DIL_GROUPS * DIL_HEADS
NSA_Q = NSA_HEADS * NSA_HEAD_DIM
NSA_KV = NSA_GROUPS * NSA_HEAD_DIM
DIL_W = DIL_GROUPS * DIL_HEADS * DIL_HEAD_DIM
DIL_OUT = DIL_HEADS * DIL_HEAD_DIM
MEM_Q = MEM_HEADS * MEM_HEAD_DIM
IN_SIZES = (NSA_Q,) + (NSA_KV,) * 6 + (3 * NSA_HEADS,) + (DIL_W,) * 3 + (MEM_Q,) + (D_MODEL,) * 3
N_IN = sum(IN_SIZES)

kernel_name = 'hybrid_nsa_dilated_memory_macaron'


def rms_norm(x, g):
    xf = x.astype(jnp.float32)
    y = xf * lax.rsqrt(jnp.mean(xf * xf, axis=-1, keepdims=True) + EPS)
    return (y * g.astype(jnp.float32)).astype(x.dtype)


def swiglu(x, w_gate, w_up, w_down):
    return (jax.nn.silu(x @ w_gate) * (x @ w_up)) @ w_down


def masked_softmax(s, mask):
    s = jnp.where(mask, s, NEG)
    m = jnp.max(s, axis=-1, keepdims=True)
    e = jnp.where(mask, jnp.exp(s - m), 0.0)
    den = jnp.sum(e, axis=-1, keepdims=True)
    p = e / jnp.maximum(den, 1e-30)
    lse = m[..., 0] + jnp.log(jnp.maximum(den[..., 0], 1e-30))
    return p, lse


def alibi_slopes():
    slopes = 2.0 ** (-8.0 * jnp.arange(1, N_ALIBI + 1, dtype=jnp.float32) / N_ALIBI)
    idx = np.arange(N_ALIBI)
    nsa_idx = idx[::N_ALIBI // NSA_HEADS][:NSA_HEADS]
    dil_idx = np.setdiff1d(idx, nsa_idx)
    return slopes[nsa_idx], slopes[dil_idx].reshape(DIL_GROUPS, DIL_HEADS)


def nsa_compress(k, pe, w1, w2):
    B, S, G, dh = k.shape
    ch = k.reshape(B, S // CMP_STRIDE, CMP_STRIDE, G, dh)
    blocks = jnp.concatenate([ch[:, :-1], ch[:, 1:]], axis=2) + pe[None, None, :, None, :]
    flat = blocks.transpose(0, 1, 3, 2, 4).reshape(B, -1, G, CMP_LEN * dh)
    return jax.nn.silu(flat @ w1) @ w2


def nsa_attention(q, k_cmp, v_cmp, k_slc, v_slc, k_win, v_win, gates, slopes):
    B, S, H, dh = q.shape
    G = k_slc.shape[2]
    R = H // G
    f32 = jnp.float32
    n_cmp = k_cmp.shape[1]
    n_blk = S // SEL_LEN
    n_top = min(SEL_TOPN, n_blk)
    ratio = SEL_LEN // CMP_STRIDE
    scale = dh ** -0.5
    cmp_end = jnp.arange(n_cmp) * CMP_STRIDE + CMP_LEN - 1
    slopes_g = slopes.reshape(G, R)[None, :, :, None, None]
    kb = k_slc.reshape(B, n_blk, SEL_LEN, G, dh).transpose(0, 3, 1, 2, 4)
    vb = v_slc.reshape(B, n_blk, SEL_LEN, G, dh).transpose(0, 3, 1, 2, 4)
    kw = jnp.pad(k_win, ((0, 0), (WIN_LEN, 0), (0, 0), (0, 0)))
    vw = jnp.pad(v_win, ((0, 0), (WIN_LEN, 0), (0, 0), (0, 0)))
    n_qb = S // Q_BLOCK
    qb = q.reshape(B, n_qb, Q_BLOCK, G, R, dh).transpose(1, 0, 3, 4, 2, 5)
    gb = gates.reshape(B, n_qb, Q_BLOCK, G, R, 3).transpose(1, 0, 3, 4, 2, 5)
    b_idx = jnp.arange(B)[:, None, None, None]
    g_idx = jnp.arange(G)[None, :, None, None]
    blk = jnp.arange(n_blk)

    def one_block(args):
        qi, gi, i = args
        t = i * Q_BLOCK + jnp.arange(Q_BLOCK)
        dist_c = t[:, None] - cmp_end[None, :]
        s = jnp.einsum('bgrqd,bcgd->bgrqc', qi, k_cmp).astype(f32) * scale - slopes_g * dist_c.astype(f32)
        p_cmp, _ = masked_softmax(s, dist_c >= 0)
        o_cmp = jnp.einsum('bgrqc,bcgd->bgrqd', p_cmp.astype(v_cmp.dtype), v_cmp)
        imp = jnp.pad(jnp.sum(p_cmp, axis=2), ((0, 0), (0, 0), (0, 0), (1, ratio * n_blk + ratio - n_cmp - 1)))
        quad = imp[..., :ratio * n_blk].reshape(B, G, Q_BLOCK, n_blk, ratio)
        score = (0.5 * quad[..., 0] + quad[..., 1] + quad[..., 2] + quad[..., 3]
                 + 0.5 * imp[..., ratio:ratio * n_blk + ratio:ratio])
        cur = (t // SEL_LEN)[:, None]
        forced = (blk[None, :] == 0) | (blk[None, :] == cur) | (blk[None, :] == cur - 1)
        score = jnp.where(forced, FORCED, jnp.where(blk[None, :] <= cur, score, NEG))
        _, sel = lax.top_k(score, n_top)
        ks = kb[b_idx, g_idx, sel].reshape(B, G, Q_BLOCK, n_top * SEL_LEN, dh)
        vs = vb[b_idx, g_idx, sel].reshape(B, G, Q_BLOCK, n_top * SEL_LEN, dh)
        pos = (sel[..., None] * SEL_LEN + jnp.arange(SEL_LEN)).reshape(B, G, 1, Q_BLOCK, n_top * SEL_LEN)
        dist_s = t[:, None] - pos
        s = jnp.einsum('bgrqd,bgqkd->bgrqk', qi, ks).astype(f32) * scale - slopes_g * dist_s.astype(f32)
        p_slc, _ = masked_softmax(s, dist_s >= 0)
        o_slc = jnp.einsum('bgrqk,bgqkd->bgrqd', p_slc.astype(vs.dtype), vs)
        start = i * Q_BLOCK
        kwi = lax.dynamic_slice_in_dim(kw, start, WIN_LEN + Q_BLOCK, axis=1)
        vwi = lax.dynamic_slice_in_dim(vw, start, WIN_LEN + Q_BLOCK, axis=1)
        spos = start - WIN_LEN + jnp.arange(WIN_LEN + Q_BLOCK)
        dist_w = t[:, None] - spos[None, :]
        mask_w = (dist_w >= 0) & (dist_w < WIN_LEN) & (spos[None, :] >= 0)
        s = jnp.einsum('bgrqd,bkgd->bgrqk', qi, kwi).astype(f32) * scale - slopes_g * dist_w.astype(f32)
        p_win, _ = masked_softmax(s, mask_w)
        o_win = jnp.einsum('bgrqk,bkgd->bgrqd', p_win.astype(vwi.dtype), vwi)
        o = gi[..., 0:1] * o_cmp + gi[..., 1:2] * o_slc + gi[..., 2:3] * o_win
        return o.transpose(0, 3, 1, 2, 4).reshape(B, Q_BLOCK, H * dh)

    out = lax.map(one_block, (qb, gb, jnp.arange(n_qb)))
    return out.transpose(1, 0, 2, 3).reshape(B, S, H * dh)


def dilated_group(q, k, v, window, dilation, slopes):
    B, S, H, dh = q.shape
    f32 = jnp.float32
    blk = window // dilation
    unit = blk * dilation
    s_pad = -(-S // unit) * unit
    n_sub = s_pad // dilation
    nb = n_sub // blk

    def split(x):
        x = jnp.pad(x, ((0, 0), (0, s_pad - S), (0, 0), (0, 0)))
        return x.reshape(B, n_sub, dilation, H, dh).transpose(0, 2, 1, 3, 4).reshape(B, dilation, nb, blk, H, dh)

    def with_prev(x):
        prev = jnp.pad(x, ((0, 0), (0, 0), (1, 0), (0, 0), (0, 0), (0, 0)))[:, :, :-1]
        return jnp.concatenate([prev, x], axis=3)

    qs = split(q)
    kk = with_prev(split(k))
    vv = with_prev(split(v))
    s = jnp.einsum('bdnqhe,bdnkhe->bdnhqk', qs, kk).astype(f32) * dh ** -0.5
    kidx = jnp.arange(2 * blk)
    rel = blk + jnp.arange(blk)[:, None] - kidx[None, :]
    first = (jnp.arange(nb) == 0)[:, None, None] & (kidx < blk)[None, None, :]
    mask = (rel >= 0)[None] & (rel <= blk)[None] & ~first
    s = s - slopes[:, None, None] * (rel * dilation).astype(f32)
    p, lse = masked_softmax(s, mask[None, None, :, None])
    o = jnp.einsum('bdnhqk,bdnkhe->bdnqhe', p.astype(v.dtype), vv)
    o = o.reshape(B, dilation, n_sub, H, dh).transpose(0, 2, 1, 3, 4).reshape(B, s_pad, H, dh)[:, :S]
    lse = lse.transpose(0, 1, 2, 4, 3).reshape(B, dilation, n_sub, H).transpose(0, 2, 1, 3).reshape(B, s_pad, H)[:, :S]
    return o, lse


def dilated_attention(q, k, v, slopes):
    B, S = q.shape[:2]
    outs, lses = [], []
    for gi, (w, d) in enumerate(DIL_PATTERNS):
        o, l = dilated_group(q[:, :, gi], k[:, :, gi], v[:, :, gi], w, d, slopes[gi])
        outs.append(o)
        lses.append(l)
    wts = jax.nn.softmax(jnp.stack(lses, axis=0), axis=0)
    o = jnp.einsum('gbsh,gbshe->bshe', wts, jnp.stack(outs, axis=0).astype(jnp.float32))
    return o.astype(q.dtype).reshape(B, S, DIL_OUT)


def memory_attention(q, mk, mv):
    B, S, H, dh = q.shape
    s = jnp.einsum('bshd,bmhd->bhsm', q, mk).astype(jnp.float32) * dh ** -0.5
    p = jax.nn.softmax(s, axis=-1)
    return jnp.einsum('bhsm,bmhd->bshd', p.astype(mv.dtype), mv).reshape(B, S, H * dh)


def hybrid_mixer(u, mem, w_in, cmp_pe_k, cmp_pe_v, cmp_k_w1, cmp_k_w2, cmp_v_w1, cmp_v_w2,
                 mem_norm_g, w_mem_kv, w_up_nsa, w_up_dil, w_up_mem, w_out):
    B, S, _ = u.shape
    offsets = np.cumsum(IN_SIZES)[:-1].tolist()
    (q_a, kc, vc, ks, vs, kw, vw, g_nsa, q_b, k_b, v_b, q_m,
     g_a, g_b, g_m) = jnp.split(u @ w_in, offsets, axis=-1)
    slope_nsa, slope_dil = alibi_slopes()
    grp = lambda t: t.reshape(B, S, NSA_GROUPS, NSA_HEAD_DIM)
    k_cmp = nsa_compress(grp(kc), cmp_pe_k, cmp_k_w1, cmp_k_w2)
    v_cmp = nsa_compress(grp(vc), cmp_pe_v, cmp_v_w1, cmp_v_w2)
    y_a = nsa_attention(q_a.reshape(B, S, NSA_HEADS, NSA_HEAD_DIM), k_cmp, v_cmp,
                        grp(ks), grp(vs), grp(kw), grp(vw),
                        jax.nn.sigmoid(g_nsa.reshape(B, S, NSA_HEADS, 3)), slope_nsa)
    dil = lambda t: t.reshape(B, S, DIL_GROUPS, DIL_HEADS, DIL_HEAD_DIM)
    y_b = dilated_attention(dil(q_b), dil(k_b), dil(v_b), slope_dil)
    M = mem.shape[1]
    mk, mv = jnp.split(rms_norm(mem, mem_norm_g) @ w_mem_kv, 2, axis=-1)
    y_m = memory_attention(q_m.reshape(B, S, MEM_HEADS, MEM_HEAD_DIM),
                           mk.reshape(B, M, MEM_HEADS, MEM_HEAD_DIM),
                           mv.reshape(B, M, MEM_HEADS, MEM_HEAD_DIM))
    merged = (jax.nn.sigmoid(g_a) * (y_a @ w_up_nsa)
              + jax.nn.sigmoid(g_b) * (y_b @ w_up_dil)
              + jax.nn.sigmoid(g_m) * (y_m @ w_up_mem))
    return merged @ w_out


def setup_inputs(seed: int = 0) -> dict:
    key = jax.random.key(seed)
    keys = iter(jax.random.split(key, 40))
    L, D, F = DEPTH, D_MODEL, D_FF

    def w(shape, fan_in):
        return jax.random.normal(next(keys), shape, jnp.float32) * fan_in ** -0.5

    def gain():
        return 1.0 + 0.02 * jax.random.normal(next(keys), (L, D), jnp.float32)

    cmp_in = CMP_LEN * NSA_HEAD_DIM
    return {
        'x': jax.random.normal(next(keys), (BATCH, SEQ, D), jnp.float32),
        'mem': jax.random.normal(next(keys), (BATCH, MEM_LEN, D), jnp.float32),
        'ffn1_pre_g': gain(),
        'ffn1_w_gate': w((L, D, F), D),
        'ffn1_w_up': w((L, D, F), D),
        'ffn1_w_down': w((L, F, D), F),
        'ffn1_post_g': gain(),
        'mix_pre_g': gain(),
        'w_in': w((L, D, N_IN), D),
        'cmp_pe_k': 0.1 * jax.random.normal(next(keys), (L, CMP_LEN, NSA_HEAD_DIM), jnp.float32),
        'cmp_pe_v': 0.1 * jax.random.normal(next(keys), (L, CMP_LEN, NSA_HEAD_DIM), jnp.float32),
        'cmp_k_w1': w((L, cmp_in, CMP_HIDDEN), cmp_in),
        'cmp_k_w2': w((L, CMP_HIDDEN, NSA_HEAD_DIM), CMP_HIDDEN),
        'cmp_v_w1': w((L, cmp_in, CMP_HIDDEN), cmp_in),
        'cmp_v_w2': w((L, CMP_HIDDEN, NSA_HEAD_DIM), CMP_HIDDEN),
        'mem_norm_g': gain(),
        'w_mem_kv': w((L, D, 2 * MEM_Q), D),
        'w_up_nsa': w((L, NSA_Q, D), NSA_Q),
        'w_up_dil': w((L, DIL_OUT, D), DIL_OUT),
        'w_up_mem': w((L, MEM_Q, D), MEM_Q),
        'w_out': w((L, D, D), D),
        'mix_post_g': gain(),
        'ffn2_pre_g': gain(),
        'ffn2_w_gate': w((L, D, F), D),
        'ffn2_w_up': w((L, D, F), D),
        'ffn2_w_down': w((L, F, D), F),
        'ffn2_post_g': gain(),
    }


def reference(x, mem, ffn1_pre_g, ffn1_w_gate, ffn1_w_up, ffn1_w_down, ffn1_post_g,
              mix_pre_g, w_in, cmp_pe_k, cmp_pe_v, cmp_k_w1, cmp_k_w2, cmp_v_w1, cmp_v_w2,
              mem_norm_g, w_mem_kv, w_up_nsa, w_up_dil, w_up_mem, w_out, mix_post_g,
              ffn2_pre_g, ffn2_w_gate, ffn2_w_up, ffn2_w_down, ffn2_post_g):
    h = x
    for l in range(DEPTH):
        f1 = swiglu(rms_norm(h, ffn1_pre_g[l]), ffn1_w_gate[l], ffn1_w_up[l], ffn1_w_down[l])
        h = h + 0.5 * rms_norm(f1, ffn1_post_g[l])
        mix = hybrid_mixer(rms_norm(h, mix_pre_g[l]), mem, w_in[l], cmp_pe_k[l], cmp_pe_v[l],
                           cmp_k_w1[l], cmp_k_w2[l], cmp_v_w1[l], cmp_v_w2[l], mem_norm_g[l],
                           w_mem_kv[l], w_up_nsa[l], w_up_dil[l], w_up_mem[l], w_out[l])
        h = h + rms_norm(mix, mix_post_g[l])
        f2 = swiglu(rms_norm(h, ffn2_pre_g[l]), ffn2_w_gate[l], ffn2_w_up[l], ffn2_w_down[l])
        h = h + 0.5 * rms_norm(f2, ffn2_post_g[l])
    return h
```

```cpp
#include <hip/hip_runtime.h>
#include <cstdio>
#include <cstdint>

#ifndef MK_ONE_LAUNCH
#define MK_ONE_LAUNCH 1
#endif

namespace pg8 {
#define PG8_LAS __attribute__((address_space(3)))
typedef unsigned short bf16_t;
typedef short bf16x8 __attribute__((ext_vector_type(8)));
typedef float f32x4 __attribute__((ext_vector_type(4)));
typedef unsigned u32x4 __attribute__((ext_vector_type(4)));
constexpr int BM = 256, BK = 64, HALF = 128, HTB = HALF * BK * 2  , STAGE_BYTES = 8 * HTB, NXCD = 8;

__host__ __device__ __forceinline__ int lds_byte(int r, int c) { const int st = (r >> 4) * 2 + (c >> 5), rr = r & 15, cc = c & 31, ob = rr * 64 + cc * 2; return st * 1024 + (ob ^ (((ob >> 9) & 1) << 5)); }
__host__ __device__ __forceinline__ void stage_rc(int b, int& R, int& C) { const int st = b / 1024, sb = b % 1024, swz = sb ^ (((sb >> 9) & 1) << 5); R = (st >> 1) * 16 + swz / 64; C = (st & 1) * 32 + (swz % 64) / 2; }
__host__ __device__ __forceinline__ int perm32(int rho) { const int n = rho >> 4, i = rho & 15; return 8 * (i >> 2) + 4 * n + (i & 3); }

struct Unit { int pm, pn; };
struct Gemm { const bf16_t* A; const bf16_t* Bt; int M, N, K; int ld; };

struct StaticOrder {
    int nM, nN, nwg, G, c, WGM, rev;
    __host__ __device__ void init(int M, int N, int G_, int c_, int wgm = 4) { nM = M / BM; nN = N / BM; nwg = nM * nN; G = G_; c = c_; WGM = wgm; rev = 0; }
    __host__ __device__ bool map(long L, Unit& u) const {
        if (L >= nwg) return false;
        int wgid = (int)L; { const int q = nwg / NXCD, r = nwg % NXCD, xcd = wgid % NXCD, off = wgid / NXCD; wgid = (xcd < r ? xcd * (q + 1) : r * (q + 1) + (xcd - r) * q) + off; }
        const int nig = WGM * nN, gid = wgid / nig, fm = gid * WGM, gsz = (nM - fm) < WGM ? (nM - fm) : WGM;
        u.pm = fm + ((wgid % nig) % gsz); u.pn = (wgid % nig) / gsz; if (rev) u.pm = nM - 1 - u.pm; return true;
    }
    __host__ __device__ bool next(int i, Unit& u) const { return map((long)i * G + c, u); }
    __device__ __forceinline__ void a_ready(const Unit&) const {}
    __device__ __forceinline__ void done(const Unit&) const {}
};
template <class Epi, class Sched, bool ALIGN_EPI = false, bool SP2 = false>
__device__ __forceinline__ void gemm_phase(PG8_LAS unsigned char* lds, const Gemm g, const Sched& S, const Epi& E, int tid_in) {
    int tid_ = tid_in; asm volatile("" : "+v"(tid_));
    const int tid = tid_, wid = __builtin_amdgcn_readfirstlane(tid >> 6), lane = tid & 63, wr = wid >> 2, wc = wid & 3, fr = lane & 15, fq = lane >> 4;
    const int K = g.K, LD = g.ld ? g.ld : K, nt = K / BK;
    unsigned voffA[2], voffB[2];
#pragma unroll
    for (int i = 0; i < 2; ++i) { int R, C; stage_rc(tid * 16 + i * 8192, R, C); const int Rb = Epi::PERM ? ((R & ~31) + perm32(R & 31)) : R;
        voffA[i] = (unsigned)(R * LD + C) * 2u; voffB[i] = (unsigned)(Rb * LD + C) * 2u; }
    const size_t kstep = (size_t)(BK * 2);
    const size_t hstep = (size_t)HALF * LD * 2;
    const size_t tstep = 2 * hstep;
    const unsigned ldsw = (unsigned)wid * 1024u;
    const int aoff = lds_byte(wr * 64 + fr, fq * 8), boff = lds_byte(wc * 32 + fr, fq * 8);
#define PG8_SA(b, h) (((b) * 2 + (h)) * HTB)
#define PG8_SB(b, h) ((4 + (b) * 2 + (h)) * HTB)
#define PG8_STAGE(bufoff, gbase, voff) do { _Pragma("unroll") for (int _i = 0; _i < 2; ++_i) \
        __builtin_amdgcn_global_load_lds((const unsigned*)((const char*)(gbase) + (voff)[_i]), (PG8_LAS unsigned*)(lds + (bufoff) + ldsw + _i * 8192), 16, 0, 0); } while (0)
#define PG8_LDA(dst, b, h) do { _Pragma("unroll") for (int m = 0; m < 4; ++m) _Pragma("unroll") for (int k = 0; k < 2; ++k) dst[m][k] = *(const PG8_LAS bf16x8*)(lds + PG8_SA(b, h) + aoff + m * 2048 + k * 1024); } while (0)
#define PG8_LDB(dst, b, h) do { _Pragma("unroll") for (int n = 0; n < 2; ++n) _Pragma("unroll") for (int k = 0; k < 2; ++k) dst[n][k] = *(const PG8_LAS bf16x8*)(lds + PG8_SB(b, h) + boff + n * 2048 + k * 1024); } while (0)
#define PG8_MMA(ai, bj, At, Bt) do { __builtin_amdgcn_s_setprio(1); _Pragma("unroll") for (int m = 0; m < 4; ++m) _Pragma("unroll") for (int n = 0; n < 2; ++n) _Pragma("unroll") for (int k = 0; k < 2; ++k) \
        acc[ai][bj][m][n] = __builtin_amdgcn_mfma_f32_16x16x32_bf16(Bt[n][k], At[m][k], acc[ai][bj][m][n], 0, 0, 0); __builtin_amdgcn_s_setprio(0); } while (0)
#define PG8_WAIT_V(n) asm volatile("s_waitcnt vmcnt(" #n ")" ::: "memory")
#define PG8_WAIT_L(n) asm volatile("s_waitcnt lgkmcnt(" #n ")" ::: "memory")
#define PG8_BAR __builtin_amdgcn_s_barrier()
#define PG8_SCHED __builtin_amdgcn_sched_barrier(0)
    Unit cur, nxt; int ui = 0;
    if (!S.next(0, cur)) return;
    f32x4 acc[2][2][4][2];
#pragma unroll
    for (int a = 0; a < 2; ++a)
#pragma unroll
        for (int b = 0; b < 2; ++b)
#pragma unroll
            for (int m = 0; m < 4; ++m)
#pragma unroll
                for (int n = 0; n < 2; ++n) acc[a][b][m][n] = (f32x4){0.f, 0.f, 0.f, 0.f};
    bf16x8 At[4][2], B0[2][2], B1[2][2];
    const char* cA = (const char*)g.A + (size_t)cur.pm * tstep; const char* cB = (const char*)g.Bt + (size_t)cur.pn * tstep;
    S.a_ready(cur);
    if constexpr (SP2) {
        PG8_STAGE(PG8_SB(0, 0), cB, voffB); PG8_STAGE(PG8_SB(0, 1), cB + hstep, voffB); PG8_STAGE(PG8_SA(0, 0), cA, voffA); PG8_STAGE(PG8_SA(0, 1), cA + hstep, voffA);
        if (wr == 1) PG8_BAR;
        PG8_WAIT_V(2); PG8_BAR;
        PG8_STAGE(PG8_SB(1, 0), cB + kstep, voffB); PG8_STAGE(PG8_SA(1, 0), cA + kstep, voffA); PG8_STAGE(PG8_SB(1, 1), cB + hstep + kstep, voffB);
        PG8_WAIT_V(6); PG8_BAR;
    } else {
        PG8_STAGE(PG8_SB(0, 0), cB, voffB); PG8_STAGE(PG8_SA(0, 0), cA, voffA); PG8_STAGE(PG8_SB(0, 1), cB + hstep, voffB); PG8_STAGE(PG8_SA(0, 1), cA + hstep, voffA);
        if (wr == 1) PG8_BAR;
        PG8_WAIT_V(4); PG8_BAR;
        PG8_STAGE(PG8_SB(1, 0), cB + kstep, voffB); PG8_STAGE(PG8_SA(1, 0), cA + kstep, voffA); PG8_STAGE(PG8_SB(1, 1), cB + hstep + kstep, voffB);
        PG8_WAIT_V(6); PG8_BAR;
    }
    for (;;) {
        const bool has_next = S.next(ui + 1, nxt);
        const typename Epi::Pre pre = E.prefetch(cur, wr, fr);
        const char* nA = has_next ? (const char*)g.A + (size_t)nxt.pm * tstep : cA; const char* nB = has_next ? (const char*)g.Bt + (size_t)nxt.pn * tstep : cB;
        for (int t = 0; t < nt; t += 2) {
            const bool last = (t == nt - 2);
            const char* a1 = cA + (size_t)(t + 1) * kstep;
            const char* a2 = last ? nA : cA + (size_t)(t + 2) * kstep; const char* b2 = last ? nB : cB + (size_t)(t + 2) * kstep;
            const char* a3 = a2 + kstep; const char* b3 = b2 + kstep;
            if (last && has_next) S.a_ready(nxt);
            if constexpr (SP2) {
            PG8_LDB(B0, 0, 0); PG8_LDB(B1, 0, 1); PG8_SCHED; PG8_LDA(At, 0, 0); PG8_STAGE(PG8_SA(1, 1), a1 + hstep, voffA);
            PG8_WAIT_V(8); PG8_WAIT_L(0); PG8_BAR; PG8_MMA(0, 0, At, B0); PG8_MMA(0, 1, At, B1); PG8_BAR; PG8_SCHED;
            PG8_LDA(At, 0, 1); PG8_STAGE(PG8_SB(0, 0), b2, voffB); PG8_STAGE(PG8_SB(0, 1), b2 + hstep, voffB); PG8_STAGE(PG8_SA(0, 0), a2, voffA);
            PG8_WAIT_V(8); PG8_WAIT_L(0); PG8_BAR; PG8_MMA(1, 0, At, B0); PG8_MMA(1, 1, At, B1); PG8_BAR; PG8_SCHED;
            PG8_LDB(B0, 1, 0); PG8_LDB(B1, 1, 1); PG8_SCHED; PG8_LDA(At, 1, 0); PG8_STAGE(PG8_SA(0, 1), a2 + hstep, voffA);
            PG8_WAIT_V(8); PG8_WAIT_L(0); PG8_BAR; PG8_MMA(0, 0, At, B0); PG8_MMA(0, 1, At, B1); PG8_BAR; PG8_SCHED;
            PG8_LDA(At, 1, 1); PG8_STAGE(PG8_SB(1, 0), b3, voffB); PG8_STAGE(PG8_SB(1, 1), b3 + hstep, voffB); PG8_STAGE(PG8_SA(1, 0), a3, voffA);
            PG8_WAIT_V(8); PG8_WAIT_L(0); PG8_BAR; PG8_MMA(1, 0, At, B0); PG8_MMA(1, 1, At, B1); PG8_BAR; PG8_SCHED;
            } else {
            PG8_LDB(B0, 0, 0); PG8_SCHED; PG8_LDA(At, 0, 0); PG8_STAGE(PG8_SA(1, 1), a1 + hstep, voffA);
            PG8_WAIT_L(8); PG8_BAR; PG8_WAIT_L(0); PG8_MMA(0, 0, At, B0); PG8_BAR; PG8_SCHED;
            PG8_LDB(B1, 0, 1); PG8_STAGE(PG8_SB(0, 0), b2, voffB);
            PG8_BAR; PG8_WAIT_L(0); PG8_MMA(0, 1, At, B1); PG8_BAR;
            PG8_LDA(At, 0, 1); PG8_STAGE(PG8_SA(0, 0), a2, voffA);
            PG8_BAR; PG8_WAIT_L(0); PG8_MMA(1, 0, At, B0); PG8_BAR; PG8_SCHED;
            PG8_STAGE(PG8_SB(0, 1), b2 + hstep, voffB);
            PG8_WAIT_V(6); PG8_BAR; PG8_MMA(1, 1, At, B1); PG8_BAR;
            PG8_LDB(B0, 1, 0); PG8_SCHED; PG8_LDA(At, 1, 0); PG8_STAGE(PG8_SA(0, 1), a2 + hstep, voffA);
            PG8_WAIT_L(8); PG8_BAR; PG8_WAIT_L(0); PG8_MMA(0, 0, At, B0); PG8_BAR; PG8_SCHED;
            PG8_LDB(B1, 1, 1); PG8_STAGE(PG8_SB(1, 0), b3, voffB);
            PG8_BAR; PG8_WAIT_L(0); PG8_MMA(0, 1, At, B1); PG8_BAR;
            PG8_LDA(At, 1, 1); PG8_STAGE(PG8_SA(1, 0), a3, voffA);
            PG8_BAR; PG8_WAIT_L(0); PG8_MMA(1, 0, At, B0); PG8_BAR; PG8_SCHED;
            PG8_STAGE(PG8_SB(1, 1), b3 + hstep, voffB);
            PG8_WAIT_V(6); PG8_BAR; PG8_MMA(1, 1, At, B1); PG8_BAR;
            }
        }
        if constexpr (ALIGN_EPI) { if (wr == 0) PG8_BAR; }
        if constexpr (!Epi::AFTER_DRAIN) { E(acc, cur, wr, wc, fr, fq, pre); S.done(cur); }
        if (!has_next) break;
#pragma unroll
        for (int a = 0; a < 2; ++a)
#pragma unroll
            for (int b = 0; b < 2; ++b)
#pragma unroll
                for (int m = 0; m < 4; ++m)
#pragma unroll
                    for (int n = 0; n < 2; ++n) acc[a][b][m][n] = (f32x4){0.f, 0.f, 0.f, 0.f};
        cur = nxt; cA = nA; cB = nB; ++ui;
        if constexpr (ALIGN_EPI) { if (wr == 1) PG8_BAR; }
    }
    PG8_WAIT_V(0);
    if constexpr (!ALIGN_EPI) { if (wr == 0) PG8_BAR; }
    PG8_BAR;
    if constexpr (Epi::AFTER_DRAIN) { E.fused(acc, cur, wr, wc, fr, fq, lds, wid, lane); S.done(cur); }
#undef PG8_SA
#undef PG8_SB
#undef PG8_STAGE
#undef PG8_LDA
#undef PG8_LDB
#undef PG8_MMA
#undef PG8_WAIT_V
#undef PG8_WAIT_L
#undef PG8_BAR
#undef PG8_SCHED
}
__device__ __forceinline__ unsigned cvt_pk_bf16(float lo, float hi) { typedef __bf16 bf2 __attribute__((ext_vector_type(2))); bf2 v; v[0] = (__bf16)lo; v[1] = (__bf16)hi; return __builtin_bit_cast(unsigned, v); }
__device__ __forceinline__ float bf_lo(unsigned w) { return __builtin_bit_cast(float, w << 16); }
__device__ __forceinline__ float bf_hi(unsigned w) { return __builtin_bit_cast(float, w & 0xffff0000u); }
__device__ __forceinline__ float sigmoid_f(float x) { return __builtin_amdgcn_rcpf(1.0f + __builtin_amdgcn_exp2f(-1.4426950408889634f * x)); }

struct RowScale { float r[2][4]; };
__device__ __forceinline__ RowScale load_row_scale(const float* R, int row0) { RowScale p;
#pragma unroll
    for (int ai = 0; ai < 2; ++ai)
#pragma unroll
        for (int m = 0; m < 4; ++m) p.r[ai][m] = R ? R[row0 + ai * HALF + m * 16] : 1.0f;
    return p; }
struct EpiBf16 {
    static constexpr bool PERM = true, AFTER_DRAIN = false;
    bf16_t* O; int ldc; int pm_split, pn_split; bf16_t* O2; int ldc2; const float* R;
    typedef RowScale Pre;
    __device__ __forceinline__ Pre prefetch(const Unit& u, int wr, int fr) const { return load_row_scale(R, u.pm * BM + wr * 64 + fr); }
    __device__ __forceinline__ void operator()(const f32x4 (&acc)[2][2][4][2], const Unit& u, int wr, int wc, int fr, int fq, const Pre& pre) const {
        bf16_t* base = O; int ld = ldc, pm = u.pm, pn = u.pn;
        if (pm >= pm_split) { base = O2; ld = ldc2; pm -= pm_split; pn -= pn_split; }
        const int row0 = pm * BM + wr * 64 + fr, col0 = pn * BM + wc * 32 + 8 * fq;
#pragma unroll
        for (int ai = 0; ai < 2; ++ai)
#pragma unroll
            for (int m = 0; m < 4; ++m) { bf16_t* rowp = base + (size_t)(row0 + ai * HALF + m * 16) * ld + col0;
#pragma unroll
                for (int bj = 0; bj < 2; ++bj) { const f32x4 v0 = acc[ai][bj][m][0] * pre.r[ai][m], v1 = acc[ai][bj][m][1] * pre.r[ai][m];
                    u32x4 w; w.x = cvt_pk_bf16(v0[0], v0[1]); w.y = cvt_pk_bf16(v0[2], v0[3]); w.z = cvt_pk_bf16(v1[0], v1[1]); w.w = cvt_pk_bf16(v1[2], v1[3]);
                    *(u32x4*)(rowp + bj * HALF) = w; } }
    }
};
struct EpiSwiGLU {
    static constexpr bool PERM = true, AFTER_DRAIN = false;
    bf16_t* O; int ldc; const float* R;
    typedef RowScale Pre;
    __device__ __forceinline__ Pre prefetch(const Unit& u, int wr, int fr) const { return load_row_scale(R, u.pm * BM + wr * 64 + fr); }
    __device__ __forceinline__ void operator()(const f32x4 (&acc)[2][2][4][2], const Unit& u, int wr, int wc, int fr, int fq, const Pre& pre) const {
        const int row0 = u.pm * BM + wr * 64 + fr, col0 = u.pn * HALF + wc * 32 + 8 * fq;
#pragma unroll
        for (int ai = 0; ai < 2; ++ai)
#pragma unroll
            for (int m = 0; m < 4; ++m) { bf16_t* rowp = O + (size_t)(row0 + ai * HALF + m * 16) * ldc + col0;
                float o[8];
#pragma unroll
                for (int n = 0; n < 2; ++n)
#pragma unroll
                    for (int j = 0; j < 4; ++j) { const float g = acc[ai][0][m][n][j] * pre.r[ai][m], up = acc[ai][1][m][n][j] * pre.r[ai][m]; o[4 * n + j] = g * sigmoid_f(g) * up; }
                u32x4 w; w.x = cvt_pk_bf16(o[0], o[1]); w.y = cvt_pk_bf16(o[2], o[3]); w.z = cvt_pk_bf16(o[4], o[5]); w.w = cvt_pk_bf16(o[6], o[7]);
                *(u32x4*)rowp = w; }
    }
};
struct OrderOne { int pm, pn;
    __device__ bool next(int i, Unit& u) const { if (i != 0) return false; u.pm = pm; u.pn = pn; return true; }
    __device__ __forceinline__ void a_ready(const Unit&) const {}
    __device__ __forceinline__ void done(const Unit&) const {} };
template <class BarF>
struct EpiSwiGLUPair {
    static constexpr bool PERM = true, AFTER_DRAIN = true;
    bf16_t* O; int ldc; const float* R; float* X; int kh; BarF barf;
    typedef int Pre;
    __device__ __forceinline__ Pre prefetch(const Unit&, int, int) const { return 0; }
    template <int AI> __device__ __forceinline__ void send(const f32x4 (&acc)[2][2][4][2], float* dst, int tid) const {
#pragma unroll
        for (int bj = 0; bj < 2; ++bj)
#pragma unroll
            for (int m = 0; m < 4; ++m)
#pragma unroll
                for (int n = 0; n < 2; ++n) *(f32x4*)(dst + ((size_t)((bj * 8 + m * 2 + n) * 512 + tid)) * 4) = acc[AI][bj][m][n];
    }
    template <int AI> __device__ __forceinline__ void finish(const f32x4 (&acc)[2][2][4][2], const float* src, const Unit& u, int wr, int wc, int fr, int fq, int tid) const {
        f32x4 pv[2][4][2]; float rsv[4];
        const int row0 = u.pm * BM + wr * 64 + fr + AI * HALF, col0 = u.pn * HALF + wc * 32 + 8 * fq;
#pragma unroll
        for (int bj = 0; bj < 2; ++bj)
#pragma unroll
            for (int m = 0; m < 4; ++m)
#pragma unroll
                for (int n = 0; n < 2; ++n) pv[bj][m][n] = *(const f32x4*)(src + ((size_t)((bj * 8 + m * 2 + n) * 512 + tid)) * 4);
#pragma unroll
        for (int m = 0; m < 4; ++m) rsv[m] = R[row0 + m * 16];
#pragma unroll
        for (int m = 0; m < 4; ++m) { bf16_t* rowp = O + (size_t)(row0 + m * 16) * ldc + col0;
            float o[8];
#pragma unroll
            for (int n = 0; n < 2; ++n)
#pragma unroll
                for (int j = 0; j < 4; ++j) { const float g = (acc[AI][0][m][n][j] + pv[0][m][n][j]) * rsv[m], up = (acc[AI][1][m][n][j] + pv[1][m][n][j]) * rsv[m]; o[4 * n + j] = g * sigmoid_f(g) * up; }
            u32x4 w; w.x = cvt_pk_bf16(o[0], o[1]); w.y = cvt_pk_bf16(o[2], o[3]); w.z = cvt_pk_bf16(o[4], o[5]); w.w = cvt_pk_bf16(o[6], o[7]);
            *(u32x4*)rowp = w; }
    }
    __device__ __forceinline__ void fused(const f32x4 (&acc)[2][2][4][2], const Unit& u, int wr, int wc, int fr, int fq, PG8_LAS unsigned char*, int wid, int lane) const {
        const int tid = wid * 64 + lane;
        float* slab = X + (size_t)u.pm * 65536;
        if (kh == 0) send<1>(acc, slab + 32768, tid); else send<0>(acc, slab, tid);
        barf();
        if (kh == 0) finish<0>(acc, slab, u, wr, wc, fr, fq, tid); else finish<1>(acc, slab + 32768, u, wr, wc, fr, fq, tid);
    }
};
struct EpiGateMerge {
    static constexpr bool PERM = true, AFTER_DRAIN = false;
    bf16_t* P; size_t pstride; int ldc; const float* R;
    typedef RowScale Pre;
    __device__ __forceinline__ Pre prefetch(const Unit& u, int wr, int fr) const { return load_row_scale(R, u.pm * BM + wr * 64 + fr); }
    __device__ __forceinline__ void operator()(const f32x4 (&acc)[2][2][4][2], const Unit& u, int wr, int wc, int fr, int fq, const Pre& pre) const {
        const int x = u.pn >> 3, pt = u.pn & 7;
        const int row0 = u.pm * BM + wr * 64 + fr, col0 = pt * BM + wc * 32 + 8 * fq;
        const bf16_t* Px = P + (size_t)x * pstride;
#pragma unroll
        for (int ai = 0; ai < 2; ++ai) {
            u32x4 pw[4][2], mw[4][2];
#pragma unroll
            for (int m = 0; m < 4; ++m)
#pragma unroll
                for (int bj = 0; bj < 2; ++bj) { const size_t off = (size_t)(row0 + ai * HALF + m * 16) * ldc + col0 + bj * HALF;
                    pw[m][bj] = *(const u32x4*)(Px + off); mw[m][bj] = (u32x4){0u, 0u, 0u, 0u}; if (x > 0) mw[m][bj] = *(const u32x4*)(P + off); }
#pragma unroll
            for (int m = 0; m < 4; ++m)
#pragma unroll
                for (int bj = 0; bj < 2; ++bj) { const size_t off = (size_t)(row0 + ai * HALF + m * 16) * ldc + col0 + bj * HALF;
                    const f32x4 v0 = acc[ai][bj][m][0] * pre.r[ai][m], v1 = acc[ai][bj][m][1] * pre.r[ai][m]; const u32x4 p = pw[m][bj], q = mw[m][bj];
                    float o[8];
                    o[0] = sigmoid_f(v0[0]) * bf_lo(p.x) + bf_lo(q.x); o[1] = sigmoid_f(v0[1]) * bf_hi(p.x) + bf_hi(q.x); o[2] = sigmoid_f(v0[2]) * bf_lo(p.y) + bf_lo(q.y); o[3] = sigmoid_f(v0[3]) * bf_hi(p.y) + bf_hi(q.y);
                    o[4] = sigmoid_f(v1[0]) * bf_lo(p.z) + bf_lo(q.z); o[5] = sigmoid_f(v1[1]) * bf_hi(p.z) + bf_hi(q.z); o[6] = sigmoid_f(v1[2]) * bf_lo(p.w) + bf_lo(q.w); o[7] = sigmoid_f(v1[3]) * bf_hi(p.w) + bf_hi(q.w);
                    u32x4 w; w.x = cvt_pk_bf16(o[0], o[1]); w.y = cvt_pk_bf16(o[2], o[3]); w.z = cvt_pk_bf16(o[4], o[5]); w.w = cvt_pk_bf16(o[6], o[7]);
                    *(u32x4*)(P + off) = w; }
        }
    }
};
struct OrderPlusExtra : StaticOrder {
    int nextra, pm0, pn0, ncx;
    __device__ bool next(int i, Unit& u) const { const long L = (long)i * G + c; if (L < nwg) return map(L, u);
        const long e = L - nwg; if (e >= nextra) return false; u.pm = pm0 + (int)(e / ncx); u.pn = pn0 + (int)(e % ncx); return true; }
};
struct OrderTriple : StaticOrder {
    __device__ bool next(int i, Unit& u) const { const int i3 = i / 3, x = i - 3 * i3; if (!map((long)i3 * G + c, u)) return false; u.pn += 8 * x; return true; }
};
}
constexpr int D = 2048, BATCH = 2, SEQ = 16384, T = BATCH * SEQ, DEPTH = 2, MEML = 256, FF = 5504;
constexpr int TM = T + BATCH * MEML;
constexpr int NIN = 11282;
constexpr float EPS = 1e-6f;
constexpr float LOG2E = 1.4426950408889634f;
constexpr int QP = 5376;
constexpr int C_QA = 0, C_KC = 768, C_VC = 1024, C_KS = 1280, C_VS = 1536, C_KW = 1792, C_VW = 2048, C_QB = 2304, C_KB = 3072, C_VB = 3840, C_QM = 4608, C_GN = 5120;
constexpr int SRC_GN = 2304, SRC_QB = 2322, SRC_GATES = 5138;
constexpr int NWIN = QP + 1024;
constexpr int NCMP = 1023;

constexpr size_t MiB = 1u << 20;
constexpr size_t WS_CTL = 0, CTL_ZERO_BYTES = 1 * MiB;
constexpr size_t SZ_WGU = (size_t)2 * FF * D * 2, SZ_WD = (size_t)D * FF * 2;
constexpr size_t WS_WGU1 = 1 * MiB, WS_WD1 = WS_WGU1 + SZ_WGU, WS_WGU2 = WS_WD1 + SZ_WD, WS_WD2 = WS_WGU2 + SZ_WGU;
constexpr size_t WS_WIN = WS_WD2 + SZ_WD, WS_WGATE = WS_WIN + (size_t)NWIN * D * 2;
constexpr size_t WS_WC1K = WS_WGATE + (size_t)3 * D * D * 2, WS_WC1V = WS_WC1K + 2 * MiB, WS_WC2K = WS_WC1V + 2 * MiB, WS_WC2V = WS_WC2K + 65536;
constexpr size_t WS_CBIAS = WS_WC2V + 65536;
constexpr size_t WS_WUPA = WS_CBIAS + 65536, WS_WUPB = WS_WUPA + (size_t)D * 768 * 2, WS_WUPM = WS_WUPB + (size_t)D * 256 * 2, WS_WOUT = WS_WUPM + (size_t)D * 512 * 2;
constexpr size_t WS_U = WS_WOUT + (size_t)D * D * 2;
constexpr size_t WS_R2 = WS_U + (size_t)TM * D * 2;
constexpr size_t WS_F = WS_R2;
constexpr size_t WS_HID = WS_F + (size_t)T * D * 2;
constexpr size_t WS_YA = WS_HID, WS_YB = WS_YA + (size_t)T * 768 * 2, WS_YM = WS_YB + (size_t)T * 256 * 2;
constexpr size_t WS_MEMKV = WS_YM + (size_t)T * 512 * 2;
constexpr size_t WS_KCMP = WS_MEMKV + 1 * MiB, WS_VCMP = WS_KCMP + 1 * MiB;
constexpr size_t WS_DILL = WS_VCMP + 1 * MiB;
constexpr size_t WS_P = WS_DILL + 2 * MiB;
constexpr size_t WS_DILO = WS_P;
constexpr size_t WS_QKV = WS_DILO + (size_t)3 * T * 256 * 2;
constexpr size_t WS_QKV_END = WS_QKV + (size_t)(T + 64) * QP * 2;
constexpr size_t WS_P_END = WS_P + (size_t)3 * T * D * 2;
constexpr size_t WS_HID_END = WS_HID + (size_t)T * FF * 2;
constexpr size_t WS_HB = WS_HID_END;
static_assert(WS_HB + (size_t)T * D * 2 <= WS_P_END, "WS_HB must fit in the dead P region");
constexpr size_t WS_END = (WS_QKV_END > WS_P_END ? (WS_QKV_END > WS_HID_END ? WS_QKV_END : WS_HID_END) : (WS_P_END > WS_HID_END ? WS_P_END : WS_HID_END));
static_assert(WS_END < (size_t)1040 * MiB, "workspace map exceeds the guaranteed d_ws size");
constexpr int CW_TMO = 0;
constexpr int CW_BAR = 4096;
constexpr int CW_QUEUE = 16384;
constexpr size_t WS_KNS = WS_CTL + 262144;
constexpr size_t WS_RS = WS_CTL + 524288;
constexpr size_t WS_KNC = WS_KNS + 16384;

constexpr int NWAVES = 8, NTHREADS = NWAVES * 64;
constexpr int RING_BYTES = 131072;
constexpr int LDSCTL_OFF = 145408, MISC_OFF = LDSCTL_OFF + 320;
constexpr int LDS_BYTES = 147456;

#define GAS __attribute__((address_space(1)))
#define LAS __attribute__((address_space(3)))
#define DI __device__ __forceinline__
typedef unsigned short bf16;
typedef unsigned v4u __attribute__((ext_vector_type(4)));
typedef unsigned v2u __attribute__((ext_vector_type(2)));
typedef float f32x4 __attribute__((ext_vector_type(4)));
typedef float f32x16 __attribute__((ext_vector_type(16)));
typedef short bf16x8 __attribute__((ext_vector_type(8)));
typedef short s16x4 __attribute__((ext_vector_type(4)));
typedef GAS unsigned gu32;
#define RLX_AGENT __ATOMIC_RELAXED, __HIP_MEMORY_SCOPE_AGENT
#define LDS_WAIT() asm volatile("s_waitcnt lgkmcnt(0)" ::: "memory")
#define VM_WAIT() asm volatile("s_waitcnt vmcnt(0)" ::: "memory")
DI unsigned pk2(float lo, float hi) { return pg8::cvt_pk_bf16(lo, hi); }
DI float bflo(unsigned w) { return __builtin_bit_cast(float, w << 16); }
DI float bfhi(unsigned w) { return __builtin_bit_cast(float, w & 0xffff0000u); }
DI float bf2f(bf16 v) { return __builtin_bit_cast(float, (unsigned)v << 16); }
DI float ex2(float x) { return __builtin_amdgcn_exp2f(x); }
DI float sigm(float x) { return __builtin_amdgcn_rcpf(1.0f + ex2(-LOG2E * x)); }
DI float wave_sum(float v) {
#pragma unroll
    for (int o = 1; o < 64; o <<= 1) v += __shfl_xor(v, o);
    return v;
}
DI unsigned char* opaque_p(unsigned char* p) { unsigned long long v = (unsigned long long)p; unsigned lo = (unsigned)v, hi = (unsigned)(v >> 32); asm volatile("" : "+s"(lo), "+s"(hi)); return (unsigned char*)(((unsigned long long)hi << 32) | lo); }
DI int opaque_v(int v) { asm volatile("" : "+v"(v)); return v; }
DI int opaque_s(int v) { asm volatile("" : "+s"(v)); return v; }
DI int lane_id_v() { int l; asm volatile("v_mbcnt_lo_u32_b32 %0, -1, 0\n\tv_mbcnt_hi_u32_b32 %0, -1, %0" : "=&v"(l)); return l; }
typedef float f32x2g __attribute__((ext_vector_type(2)));
template <class F, class R>
DI void conv_matrix2(F colptr, R drow, int pitch, int K, int nrows, bf16* WT, LAS float* scr, int bx, int G, int tid, const float* gain = nullptr) {
    const int nkb = K / 64, nnb = nrows / 128, nitems = nnb * nkb, wave = tid >> 6, lane = tid & 63;
    f32x2g v[8], w[8], x2[8], y2[8];
    auto issue = [&](int item, f32x2g (&dst)[8]) { const int kb = item / nnb, nb = item - kb * nnb; const float* cp = colptr(128 * nb + 2 * lane);
        const float* cq = cp ? cp : colptr(0);
#pragma unroll
        for (int i = 0; i < 8; ++i) { const f32x2g x = *(const GAS f32x2g*)(cq + (size_t)(64 * kb + 8 * wave + i) * pitch); dst[i] = cp ? x : (f32x2g){0.f, 0.f}; } };
    auto issue_c = [&](int item, f32x2g (&dst)[8]) { issue(item < nitems ? item : nitems - 1, dst); };
    int it = bx;
    if (it < nitems) { issue_c(it, v); issue_c(it + G, w); issue_c(it + 2 * G, x2); }
#pragma unroll 1
    for (; it < nitems; it += G) {
        issue_c(it + 3 * G, y2);
        __builtin_amdgcn_sched_barrier(0);
        const int kb = it / nnb, nb = it - kb * nnb, k0 = 64 * kb, d0 = drow(128 * nb);
#pragma unroll
        for (int i = 0; i < 8; ++i) { const float gk = gain ? gain[k0 + 8 * wave + i] : 1.0f;
            scr[(8 * wave + i) * 129 + 2 * lane] = v[i].x * gk; scr[(8 * wave + i) * 129 + 2 * lane + 1] = v[i].y * gk; }
        __syncthreads();
        const int c = lane & 7;
#pragma unroll
        for (int j = 0; j < 2; ++j) { const int n = 16 * wave + (lane >> 3) + 8 * j; const LAS float* s = scr + (8 * c) * 129 + n;
            v4u o; o.x = pk2(s[0 * 129], s[1 * 129]); o.y = pk2(s[2 * 129], s[3 * 129]); o.z = pk2(s[4 * 129], s[5 * 129]); o.w = pk2(s[6 * 129], s[7 * 129]);
            *(GAS v4u*)(WT + (size_t)(d0 + n) * K + k0 + 8 * c) = o; }
        __syncthreads();
#pragma unroll
        for (int i = 0; i < 8; ++i) { v[i] = w[i]; w[i] = x2[i]; x2[i] = y2[i]; }
    }
}
template <class F>
DI void conv_matrix(F colptr, int pitch, int K, int nrows, bf16* WT, LAS float* scr, int bx, int G, int tid, const float* gain = nullptr) { conv_matrix2(colptr, [](int n) { return n; }, pitch, K, nrows, WT, scr, bx, G, tid, gain); }

struct LayerW {
    const float *f1pre, *f1g, *f1u, *f1d, *f1post, *mixpre, *win, *pek, *pev, *c1k, *c2k, *c1v, *c2v, *memg, *wmkv, *wupa, *wupb, *wupm, *wout, *mixpost, *f2pre, *f2g, *f2u, *f2d, *f2post;
};
struct WsPtrs {
    unsigned char* ws;
#define WSP(name, type, off) DI type* name() const { return (type*)(ws + (off)); }
    WSP(wgu1, bf16, WS_WGU1) WSP(wd1, bf16, WS_WD1) WSP(wgu2, bf16, WS_WGU2) WSP(wd2, bf16, WS_WD2) WSP(win, bf16, WS_WIN) WSP(wgate, bf16, WS_WGATE)
    WSP(wc1k, bf16, WS_WC1K) WSP(wc1v, bf16, WS_WC1V) WSP(wc2k, bf16, WS_WC2K) WSP(wc2v, bf16, WS_WC2V) WSP(cbias, float, WS_CBIAS)
    WSP(wupa, bf16, WS_WUPA) WSP(wupb, bf16, WS_WUPB) WSP(wupm, bf16, WS_WUPM) WSP(wout, bf16, WS_WOUT)
    WSP(U, bf16, WS_U) WSP(F, bf16, WS_F) WSP(HID, bf16, WS_HID) WSP(HB, bf16, WS_HB) WSP(RS, float, WS_RS) WSP(YA, bf16, WS_YA) WSP(YB, bf16, WS_YB) WSP(YM, bf16, WS_YM)
    WSP(MEMKV, bf16, WS_MEMKV) WSP(KCMP, bf16, WS_KCMP) WSP(VCMP, bf16, WS_VCMP) WSP(P, bf16, WS_P) WSP(DILO, bf16, WS_DILO) WSP(QKV, bf16, WS_QKV) WSP(DILL, float, WS_DILL)
#undef WSP
};

template <int PART>
DI void convert_layer(const LayerW& L, const WsPtrs& W, LAS unsigned char* lds, int bx, int G, int tid) {
    LAS float* scr = (LAS float*)lds; const int wave = tid >> 6, lane = tid & 63, gw = bx * NWAVES + wave, NGW = G * NWAVES;
    if constexpr (PART != 2) {
    { const float* s = L.f1g; conv_matrix2([=](int r) { return s + r; }, [](int n) { return (n >> 7) * 256 + (n & 127); }, FF, D, FF, W.wgu1(), scr, bx, G, tid, L.f1pre); }
    { const float* s = L.f1u; conv_matrix2([=](int r) { return s + r; }, [](int n) { return (n >> 7) * 256 + (n & 127) + 128; }, FF, D, FF, W.wgu1(), scr, bx, G, tid, L.f1pre); }
    { const float* s = L.f1d; conv_matrix([=](int r) { return s + r; }, D, FF, D, W.wd1(), scr, bx, G, tid); }
    { const float* s = L.win; conv_matrix([=](int r) -> const float* { if (r < C_QB) return s + r; if (r < C_GN) return s + (r - C_QB + SRC_QB); if (r < C_GN + 18) return s + (r - C_GN + SRC_GN); return nullptr; }, NIN, D, QP, W.win(), scr, bx, G, tid, L.mixpre); }
    { const float* s = L.wmkv; conv_matrix([=](int r) { return s + r; }, 1024, D, 1024, W.win() + (size_t)QP * D, scr, bx, G, tid, L.memg); }
    { const float* s = L.c1k; conv_matrix([=](int r) { return s + r; }, 256, 4096, 256, W.wc1k(), scr, bx, G, tid); }
    { const float* s = L.c1v; conv_matrix([=](int r) { return s + r; }, 256, 4096, 256, W.wc1v(), scr, bx, G, tid); }
    { const float* s = L.c2k; conv_matrix([=](int r) { return s + r; }, 128, 256, 128, W.wc2k(), scr, bx, G, tid); }
    { const float* s = L.c2v; conv_matrix([=](int r) { return s + r; }, 128, 256, 128, W.wc2v(), scr, bx, G, tid); }
    }
    if constexpr (PART != 1) {
    { const float* s = L.f2g; conv_matrix2([=](int r) { return s + r; }, [](int n) { return (n >> 7) * 256 + (n & 127); }, FF, D, FF, W.wgu2(), scr, bx, G, tid, L.f2pre); }
    { const float* s = L.f2u; conv_matrix2([=](int r) { return s + r; }, [](int n) { return (n >> 7) * 256 + (n & 127) + 128; }, FF, D, FF, W.wgu2(), scr, bx, G, tid, L.f2pre); }
    { const float* s = L.f2d; conv_matrix([=](int r) { return s + r; }, D, FF, D, W.wd2(), scr, bx, G, tid); }
    { const float* s = L.win; conv_matrix([=](int r) { return s + SRC_GATES + r; }, NIN, D, 3 * D, W.wgate(), scr, bx, G, tid, L.mixpre); }
    { const float* s = L.wupa; conv_matrix([=](int r) { return s + r; }, D, 768, D, W.wupa(), scr, bx, G, tid); }
    { const float* s = L.wupb; conv_matrix([=](int r) { return s + r; }, D, 256, D, W.wupb(), scr, bx, G, tid); }
    { const float* s = L.wupm; conv_matrix([=](int r) { return s + r; }, D, 512, D, W.wupm(), scr, bx, G, tid); }
    { const float* s = L.wout; conv_matrix([=](int r) { return s + r; }, D, D, D, W.wout(), scr, bx, G, tid); }
    }
    if constexpr (PART != 2)
    for (int it = gw; it < 512; it += NGW) { const int which = it >> 8, hid = it & 255; const float* pe = which ? L.pev : L.pek; const float* w1 = which ? L.c1v : L.c1k;
        float a = 0.f;
#pragma unroll 8
        for (int i = 0; i < 64; ++i) { const int k = lane + 64 * i; a += pe[k] * w1[(size_t)k * 256 + hid]; }
        a = wave_sum(a);
        if (lane == 0) W.cbias()[which * 256 + hid] = a; }
}

DI void norm_phase_first(const float* xbase, bf16* ubase, float* rs, int nrows, int gw, int NGW, int lane) {
    f32x4 v[8], vn[8];
    auto issue = [&](int m, f32x4 (&d)[8]) { const GAS f32x4* xr = (const GAS f32x4*)(xbase + (size_t)m * D) + lane;
#pragma unroll
        for (int j = 0; j < 8; ++j) d[j] = xr[64 * j]; };
    int m = gw;
    if (m < nrows) issue(m, v);
#pragma unroll 1
    for (; m < nrows; m += NGW) {
        if (m + NGW < nrows) issue(m + NGW, vn);
        __builtin_amdgcn_sched_barrier(0);
        float s = 0.f;
#pragma unroll
        for (int j = 0; j < 8; ++j) s += (v[j].x * v[j].x + v[j].y * v[j].y) + (v[j].z * v[j].z + v[j].w * v[j].w);
        const float r = 1.0f / sqrtf(wave_sum(s) * (1.0f / D) + EPS);
        if (lane == 0) rs[m] = r;
        GAS v2u* o8 = (GAS v2u*)(ubase + (size_t)m * D) + lane;
#pragma unroll
        for (int j = 0; j < 8; ++j) { v2u o; o.x = pk2(v[j].x, v[j].y); o.y = pk2(v[j].z, v[j].w); o8[64 * j] = o; }
#pragma unroll
        for (int j = 0; j < 8; ++j) v[j] = vn[j];
    }
}
template <bool HIN_F32, bool HOUT_F32>
DI void norm_phase_res(const void* hin, const bf16* fbuf, const float* gpost, float cs, void* hout, float* rs, int gw, int NGW, int lane) {
    f32x4 h[HIN_F32 ? 8 : 1], hn[HIN_F32 ? 8 : 1], hn2[HIN_F32 ? 8 : 1]; v2u hb[HIN_F32 ? 1 : 8], hbn[HIN_F32 ? 1 : 8], hbn2[HIN_F32 ? 1 : 8]; v2u fw[8], fwn[8], fwn2[8];
    f32x4 gpv[8];
    { const GAS f32x4* gp = (const GAS f32x4*)gpost + lane;
#pragma unroll
      for (int j = 0; j < 8; ++j) gpv[j] = gp[64 * j]; }
    auto issue = [&](int m, f32x4 (&hd)[HIN_F32 ? 8 : 1], v2u (&hbd)[HIN_F32 ? 1 : 8], v2u (&fd)[8]) { const GAS v2u* fr = (const GAS v2u*)(fbuf + (size_t)m * D) + lane;
        if constexpr (HIN_F32) { const GAS f32x4* hr = (const GAS f32x4*)((const float*)hin + (size_t)m * D) + lane;
#pragma unroll
            for (int j = 0; j < 8; ++j) { hd[j] = __builtin_nontemporal_load(hr + 64 * j); fd[j] = __builtin_nontemporal_load(fr + 64 * j); } }
        else { const GAS v2u* hr = (const GAS v2u*)((const bf16*)hin + (size_t)m * D) + lane;
#pragma unroll
            for (int j = 0; j < 8; ++j) { hbd[j] = __builtin_nontemporal_load(hr + 64 * j); fd[j] = __builtin_nontemporal_load(fr + 64 * j); } } };
    int m = gw;
    if (m < T) issue(m, h, hb, fw);
    if (m + NGW < T) issue(m + NGW, hn, hbn, fwn);
#pragma unroll 1
    for (; m < T; m += NGW) {
        const int mn = m + 2 * NGW;
        if (mn < T) issue(mn, hn2, hbn2, fwn2);
        __builtin_amdgcn_sched_barrier(0);
        f32x4 f[8]; float s0 = 0.f;
#pragma unroll
        for (int j = 0; j < 8; ++j) { f[j] = (f32x4){bflo(fw[j].x), bfhi(fw[j].x), bflo(fw[j].y), bfhi(fw[j].y)}; s0 += (f[j].x * f[j].x + f[j].y * f[j].y) + (f[j].z * f[j].z + f[j].w * f[j].w); }
        const float ra = cs / sqrtf(wave_sum(s0) * (1.0f / D) + EPS);
        float t0 = 0.f;
#pragma unroll
        for (int j = 0; j < 8; ++j) { const f32x4 gg = gpv[j]; f32x4 hv;
            if constexpr (HIN_F32) hv = h[j]; else hv = (f32x4){bflo(hb[j].x), bfhi(hb[j].x), bflo(hb[j].y), bfhi(hb[j].y)};
            f[j] = hv + f[j] * ra * gg; t0 += (f[j].x * f[j].x + f[j].y * f[j].y) + (f[j].z * f[j].z + f[j].w * f[j].w);
            if constexpr (HOUT_F32) { GAS f32x4* ho = (GAS f32x4*)((float*)hout + (size_t)m * D) + lane; __builtin_nontemporal_store(f[j], ho + 64 * j); }
            else { GAS v2u* ho = (GAS v2u*)((bf16*)hout + (size_t)m * D) + lane; v2u a; a.x = pk2(f[j].x, f[j].y); a.y = pk2(f[j].z, f[j].w); ho[64 * j] = a; } }
        if (rs) { const float qa = 1.0f / sqrtf(wave_sum(t0) * (1.0f / D) + EPS); if (lane == 0) rs[m] = qa; }
#pragma unroll
        for (int j = 0; j < 8; ++j) { if constexpr (HIN_F32) { h[j] = hn[j]; hn[j] = hn2[j]; } else { hb[j] = hbn[j]; hbn[j] = hbn2[j]; } fw[j] = fwn[j]; fwn[j] = fwn2[j]; }
    }
}
constexpr float NEGB = -1e30f;
struct LaneIx { int lane, r, h, q4, p4, blk; };
DI LaneIx lane_ix(int tid) { LaneIx L; L.lane = tid & 63; L.r = L.lane & 31; L.h = L.lane >> 5; const int i16 = L.lane & 15; L.q4 = i16 >> 2; L.p4 = i16 & 3; L.blk = (L.lane >> 4) & 1; return L; }
DI f32x16 mfma32(bf16x8 a, bf16x8 b, f32x16 c) { return __builtin_amdgcn_mfma_f32_32x32x16_bf16(a, b, c, 0, 0, 0); }
DI f32x16 zero16() { f32x16 z;
#pragma unroll
    for (int i = 0; i < 16; ++i) z[i] = 0.f;
    return z; }
template <int S> DI bf16x8 pack8(const f32x16& x) { typedef __bf16 bfv8 __attribute__((ext_vector_type(8))); bfv8 v;
#pragma unroll
    for (int j = 0; j < 8; ++j) v[j] = (__bf16)x[8 * S + j];
    return __builtin_bit_cast(bf16x8, v); }
DI s16x4 tr16(LAS const unsigned char* p) { return __builtin_amdgcn_ds_read_tr16_b64_v4i16((LAS s16x4*)p); }
DI bf16x8 cat4(s16x4 lo, s16x4 hi) { return __builtin_shufflevector(lo, hi, 0, 1, 2, 3, 4, 5, 6, 7); }
DI float alibi_slope(int i) { return exp2f(-8.0f * (float)(i + 1) / 18.0f); }

template <int DH> struct FlashSt { f32x16 o[DH / 32]; float m, l; };
template <int DH> DI void flash_init(FlashSt<DH>& st) {
#pragma unroll
    for (int d = 0; d < DH / 32; ++d) st.o[d] = zero16();
    st.m = NEGB; st.l = 0.f; }

template <int DH, int KSTR, int QR>
DI f32x16 qk32(const bf16x8 (&q)[QR], LAS const unsigned char* qx, LAS const unsigned char* Kb, const LaneIx& L) {
    bf16x8 kf[DH / 16], qt[DH / 16 - QR + 1];
#pragma unroll
    for (int ks = 0; ks < DH / 16; ++ks) kf[ks] = *(LAS const bf16x8*)(Kb + L.r * KSTR + (16 * ks + 8 * L.h) * 2);
#pragma unroll
    for (int ks = QR; ks < DH / 16; ++ks) qt[ks - QR] = *(LAS const bf16x8*)(qx + ((ks - QR) * 64 + L.lane) * 16);
    __builtin_amdgcn_sched_barrier(0);
    f32x16 s = zero16();
#pragma unroll
    for (int ks = 0; ks < DH / 16; ++ks) s = mfma32(kf[ks], ks < QR ? q[ks < QR ? ks : 0] : qt[ks < QR ? 0 : ks - QR], s);
    return s; }
constexpr float RESCALE_THR = 8.0f, SKIP_THR = 40.0f;
template <int DH, int KSTR, int VSTR, int QR, class OK>
DI void flash32(FlashSt<DH>& st, const bf16x8 (&q)[QR], LAS const unsigned char* qx, LAS const unsigned char* Kb, LAS const unsigned char* Vb, float c2, const LaneIx& L, bool allvalid, float bias0, float bstep, OK okfn) {
    f32x16 s = qk32<DH, KSTR, QR>(q, qx, Kb, L);
    asm volatile("" : "+v"(bstep));
    const float bl = bias0 + bstep * (float)(4 * L.h);
    float mx = NEGB;
    if (allvalid) {
#pragma unroll
        for (int i = 0; i < 16; ++i) { const float v = s[i] * c2 + (bstep * (float)((i & 3) + 8 * (i >> 2)) + bl); s[i] = v; mx = fmaxf(mx, v); }
    } else {
#pragma unroll
        for (int i = 0; i < 16; ++i) { const int kl = (i & 3) + 8 * (i >> 2) + 4 * L.h; const float v = okfn(kl) ? (s[i] * c2 + (bstep * (float)((i & 3) + 8 * (i >> 2)) + bl)) : NEGB; s[i] = v; mx = fmaxf(mx, v); }
    }
    mx = fmaxf(mx, __shfl_xor(mx, 32));
    if (__all(mx < st.m - SKIP_THR)) return;
    if (!__all(mx <= st.m + RESCALE_THR)) {
        const float mn = fmaxf(st.m, mx), alpha = ex2(st.m - mn);
        st.m = mn; st.l *= alpha;
#pragma unroll
        for (int d = 0; d < DH / 32; ++d)
#pragma unroll
            for (int i = 0; i < 16; ++i) st.o[d][i] *= alpha;
    }
    const float mn = st.m;
    float ps = 0.f;
    if (allvalid) {
#pragma unroll
        for (int i = 0; i < 16; ++i) { const float p = ex2(s[i] - mn); s[i] = p; ps += p; }
    } else {
#pragma unroll
        for (int i = 0; i < 16; ++i) { const float p = (s[i] > -1e29f) ? ex2(s[i] - mn) : 0.f; s[i] = p; ps += p; }
    }
    st.l += ps;
    const bf16x8 p0 = pack8<0>(s), p1 = pack8<1>(s);
    { LAS const unsigned char* vp = Vb + (4 * L.h + L.q4) * VSTR + (16 * L.blk + 4 * L.p4) * 2;
      s16x4 vf[DH / 32][4];
#pragma unroll
      for (int d = 0; d < DH / 32; ++d) { vf[d][0] = tr16(vp + 64 * d); vf[d][1] = tr16(vp + 64 * d + 8 * VSTR); vf[d][2] = tr16(vp + 64 * d + 16 * VSTR); vf[d][3] = tr16(vp + 64 * d + 24 * VSTR); }
      __builtin_amdgcn_sched_barrier(0);
#pragma unroll
      for (int d = 0; d < DH / 32; ++d) { st.o[d] = mfma32(cat4(vf[d][0], vf[d][1]), p0, st.o[d]); st.o[d] = mfma32(cat4(vf[d][2], vf[d][3]), p1, st.o[d]); } }
}
template <int DH> DI float flash_l(const FlashSt<DH>& st) { return st.l + __shfl_xor(st.l, 32); }

template <int DH, int STR, int NR, class RF>
DI void stage_rows(LAS unsigned char* dst, RF rowptr, int tid) {
    constexpr int CPR = DH / 8, TOTAL = NR * CPR, NK = TOTAL / NTHREADS; static_assert(TOTAL % NTHREADS == 0, "stage_rows: chunk count");
    v4u v[NK]; bool okv[NK];
#pragma unroll
    for (int k = 0; k < NK; ++k) { const int id = tid + k * NTHREADS, row = id / CPR, ch = id % CPR; const bf16* p = rowptr(row, okv[k]); v[k] = *(const GAS v4u*)(p + ch * 8); }
#pragma unroll
    for (int k = 0; k < NK; ++k) { const int id = tid + k * NTHREADS, row = id / CPR, ch = id % CPR; const v4u z = (v4u){0u, 0u, 0u, 0u};
        *(LAS v4u*)(dst + row * STR + ch * 16) = okv[k] ? v[k] : z; }
}
template <int DH> DI void store_ot(const f32x16 (&o)[DH / 32], float sc, bf16* orow, const LaneIx& L) {
#pragma unroll
    for (int d = 0; d < DH / 32; ++d)
#pragma unroll
        for (int g4 = 0; g4 < 4; ++g4) { v2u w; w.x = pk2(o[d][4 * g4] * sc, o[d][4 * g4 + 1] * sc); w.y = pk2(o[d][4 * g4 + 2] * sc, o[d][4 * g4 + 3] * sc);
            *(GAS v2u*)(orow + 32 * d + 8 * g4 + 4 * L.h) = w; }
}

constexpr int K64STR = 144, V64STR = 192, K128STR = 272, V128STR = 320;
constexpr float C2_64 = 0.125f * LOG2E, C2_128 = 0.08838834764831845f * LOG2E;
DI void dil_unit(const WsPtrs& W, LAS unsigned char* lds, int idx, int tid, int wave, const LaneIx& L) {
    const int gi = idx >> 9; int rem = idx & 511; const int b = rem >> 8; rem &= 255; const int hd = rem >> 6; rem &= 63;
    const int dsh = 2 * gi, d = 1 << dsh, rs = rem & (d - 1), nt = rem >> dsh;
    const int n0 = nt * 256, nk0 = n0 - 128;
    const bf16* base = W.QKV() + (size_t)b * SEQ * QP + gi * 256 + hd * 64;
    LAS unsigned char* Kt = lds; LAS unsigned char* Vt = lds + 384 * K64STR;
    __syncthreads();
    stage_rows<64, K64STR, 384>(Kt, [&](int i, bool& ok) -> const bf16* { const int n = nk0 + i; ok = n >= 0; return base + (size_t)(((ok ? n : 0) << dsh) + rs) * QP + C_KB; }, tid);
    stage_rows<64, V64STR, 384>(Vt, [&](int i, bool& ok) -> const bf16* { const int n = nk0 + i; ok = n >= 0; return base + (size_t)(((ok ? n : 0) << dsh) + rs) * QP + C_VB; }, tid);
    __syncthreads();
    const int nq = n0 + 32 * wave + L.r, tq = (nq << dsh) + rs;
    const bf16* qrow = base + (size_t)tq * QP + C_QB;
    bf16x8 q[4];
#pragma unroll
    for (int ks = 0; ks < 4; ++ks) q[ks] = *(const GAS bf16x8*)(qrow + 16 * ks + 8 * L.h);
    const float sl2 = alibi_slope(6 * gi + (hd < 2 ? hd + 1 : hd + 2)) * LOG2E * (float)d;
    FlashSt<64> st; flash_init(st);
#pragma unroll 1
    for (int sb = 4; sb >= 0; --sb) { const int kb = 32 * wave + 32 * sb, relb = 128 - 32 * sb + L.r, nkb = nk0 + kb;
        flash32<64, K64STR, V64STR, 4>(st, q, nullptr, Kt + kb * K64STR, Vt + kb * V64STR, C2_64, L, sb >= 1 && sb <= 3 && nkb >= 0, -sl2 * (float)relb, sl2,
            [&](int kl) { const int rel = relb - kl; return rel >= 0 && rel <= 128 && (nkb + kl) >= 0; }); }
    const float l = flash_l(st), inv = 1.0f / l;
    const size_t orow = (size_t)gi * T + (size_t)b * SEQ + tq;
    store_ot<64>(st.o, inv, W.DILO() + orow * 256 + hd * 64, L);
    if (L.h == 0) W.DILL()[orow * 4 + hd] = st.m + log2f(l);
}
DI void dil_merge(const WsPtrs& W, int gtid, int gthreads) {
    for (int it = gtid; it < T * 32; it += gthreads) { const int row = it >> 5, ch = it & 31, hd = ch >> 3;
        const float l0 = W.DILL()[(size_t)row * 4 + hd], l1 = W.DILL()[((size_t)T + row) * 4 + hd], l2 = W.DILL()[((size_t)2 * T + row) * 4 + hd];
        const float mx = fmaxf(l0, fmaxf(l1, l2)); float w0 = ex2(l0 - mx), w1 = ex2(l1 - mx), w2 = ex2(l2 - mx); const float inv = 1.0f / (w0 + w1 + w2); w0 *= inv; w1 *= inv; w2 *= inv;
        const v4u a = *(const GAS v4u*)(W.DILO() + (size_t)row * 256 + ch * 8), bq = *(const GAS v4u*)(W.DILO() + ((size_t)T + row) * 256 + ch * 8), c = *(const GAS v4u*)(W.DILO() + ((size_t)2 * T + row) * 256 + ch * 8);
        v4u o;
        o.x = pk2(w0 * bflo(a.x) + w1 * bflo(bq.x) + w2 * bflo(c.x), w0 * bfhi(a.x) + w1 * bfhi(bq.x) + w2 * bfhi(c.x));
        o.y = pk2(w0 * bflo(a.y) + w1 * bflo(bq.y) + w2 * bflo(c.y), w0 * bfhi(a.y) + w1 * bfhi(bq.y) + w2 * bfhi(c.y));
        o.z = pk2(w0 * bflo(a.z) + w1 * bflo(bq.z) + w2 * bflo(c.z), w0 * bfhi(a.z) + w1 * bfhi(bq.z) + w2 * bfhi(c.z));
        o.w = pk2(w0 * bflo(a.w) + w1 * bflo(bq.w) + w2 * bflo(c.w), w0 * bfhi(a.w) + w1 * bfhi(bq.w) + w2 * bfhi(c.w));
        *(GAS v4u*)(W.YB() + (size_t)row * 256 + ch * 8) = o; }
}
DI void mem_unit(const WsPtrs& W, LAS unsigned char* lds, int idx, int tid, int wave, const LaneIx& L) {
    const int b = idx >> 8, hd = (idx >> 6) & 3, qt = idx & 63;
    const size_t row = (size_t)b * SEQ + 256 * qt + 32 * wave + L.r;
    const bf16* qrow = W.QKV() + row * QP + C_QM + hd * 128;
    bf16x8 q[8];
#pragma unroll
    for (int ks = 0; ks < 8; ++ks) q[ks] = *(const GAS bf16x8*)(qrow + 16 * ks + 8 * L.h);
    LAS unsigned char* Kt = lds; LAS unsigned char* Vt = lds + 128 * K128STR;
    FlashSt<128> st; flash_init(st);
#pragma unroll 1
    for (int half = 0; half < 2; ++half) {
        const bf16* kb = W.MEMKV() + (size_t)(b * MEML + 128 * half) * 1024 + hd * 128;
        __syncthreads();
        stage_rows<128, K128STR, 128>(Kt, [&](int i, bool& ok) -> const bf16* { ok = true; return kb + (size_t)i * 1024; }, tid);
        stage_rows<128, V128STR, 128>(Vt, [&](int i, bool& ok) -> const bf16* { ok = true; return kb + (size_t)i * 1024 + 512; }, tid);
        __syncthreads();
#pragma unroll 1
        for (int sb = 0; sb < 4; ++sb) flash32<128, K128STR, V128STR, 8>(st, q, nullptr, Kt + 32 * sb * K128STR, Vt + 32 * sb * V128STR, C2_128, L, true, 0.f, 0.f, [](int) { return true; });
    }
    const float l = flash_l(st);
    store_ot<128>(st.o, 1.0f / l, W.YM() + row * 512 + hd * 128, L);
}
DI void cmp_unit(const WsPtrs& W, LAS unsigned char* lds, int idx, int tid, int wave, const LaneIx& L) {
    const int which = idx >> 7, rg = idx & 127;
    const bf16* w1t = which ? W.wc1v() : W.wc1k(); const bf16* w2t = which ? W.wc2v() : W.wc2k();
    const int rho = 32 * rg + L.r, b = rho >> 11, c = (rho >> 1) & 1023, g = rho & 1;
    const bf16* src = W.QKV() + (size_t)b * SEQ * QP + (which ? C_VC : C_KC) + g * 128;
    f32x16 hid[8];
#pragma unroll
    for (int i = 0; i < 8; ++i) hid[i] = zero16();
    auto issue = [&](int j, bf16x8 (&af)[8], bf16x8& bf) { const int kt = 8 * wave + (j >> 2), ks = j & 3, pos = kt >> 1, e0 = (kt & 1) * 64; int tok = 16 * c + pos; tok = tok < SEQ ? tok : SEQ - 1;
        bf = *(const GAS bf16x8*)(src + (size_t)tok * QP + e0 + 8 * L.h + 16 * ks);
        const bf16* ap = w1t + (size_t)L.r * 4096 + 64 * kt + 8 * L.h + 16 * ks;
#pragma unroll
        for (int hb = 0; hb < 8; ++hb) af[hb] = *(const GAS bf16x8*)(ap + (size_t)(32 * hb) * 4096); };
    bf16x8 a0[8], a1[8], b0, b1;
    issue(0, a0, b0);
#pragma unroll 1
    for (int j = 0; j < 32; j += 2) {
        issue(j + 1, a1, b1);
        __builtin_amdgcn_sched_barrier(0);
#pragma unroll
        for (int hb = 0; hb < 8; ++hb) hid[hb] = mfma32(a0[hb], b0, hid[hb]);
        __builtin_amdgcn_sched_barrier(0);
        issue(j + 2 < 32 ? j + 2 : 31, a0, b0);
        __builtin_amdgcn_sched_barrier(0);
#pragma unroll
        for (int hb = 0; hb < 8; ++hb) hid[hb] = mfma32(a1[hb], b1, hid[hb]);
        __builtin_amdgcn_sched_barrier(0);
    }
    __syncthreads();
#pragma unroll
    for (int half = 4; half >= 1; half >>= 1) {
        if (wave >= half && wave < 2 * half) { LAS float* slot = (LAS float*)(lds + (wave - half) * 32768);
#pragma unroll
            for (int hb = 0; hb < 8; ++hb)
#pragma unroll
                for (int i = 0; i < 16; ++i) slot[(hb * 16 + i) * 64 + L.lane] = hid[hb][i]; }
        __syncthreads();
        if (wave < half) { const LAS float* slot = (const LAS float*)(lds + wave * 32768);
#pragma unroll
            for (int hb = 0; hb < 8; ++hb)
#pragma unroll
                for (int i = 0; i < 16; ++i) hid[hb][i] += slot[(hb * 16 + i) * 64 + L.lane]; }
        __syncthreads();
    }
    if (wave == 0) {
        const float* cb = W.cbias() + which * 256;
        bf16x8 ph[8][2];
#pragma unroll
        for (int hb = 0; hb < 8; ++hb) {
#pragma unroll
            for (int i = 0; i < 16; ++i) { const float v = hid[hb][i] + cb[32 * hb + (i & 3) + 8 * (i >> 2) + 4 * L.h]; hid[hb][i] = v * sigm(v); }
            ph[hb][0] = pack8<0>(hid[hb]); ph[hb][1] = pack8<1>(hid[hb]); }
        f32x16 out[4];
#pragma unroll
        for (int i = 0; i < 4; ++i) out[i] = zero16();
#pragma unroll
        for (int hb = 0; hb < 8; ++hb) { s16x4 wa[4][4];
#pragma unroll
            for (int ob = 0; ob < 4; ++ob) { const bf16* wr = w2t + (size_t)(32 * ob + L.r) * 256 + 32 * hb + 4 * L.h;
                wa[ob][0] = *(const GAS s16x4*)(wr); wa[ob][1] = *(const GAS s16x4*)(wr + 8); wa[ob][2] = *(const GAS s16x4*)(wr + 16); wa[ob][3] = *(const GAS s16x4*)(wr + 24); }
            __builtin_amdgcn_sched_barrier(0);
#pragma unroll
            for (int ob = 0; ob < 4; ++ob) { out[ob] = mfma32(cat4(wa[ob][0], wa[ob][1]), ph[hb][0], out[ob]); out[ob] = mfma32(cat4(wa[ob][2], wa[ob][3]), ph[hb][1], out[ob]); }
            __builtin_amdgcn_sched_barrier(0);
        }
        bf16* dst = (which ? W.VCMP() : W.KCMP()) + ((size_t)(b * 2 + g) * 1024 + c) * 128;
        store_ot<128>(out, 1.0f, dst, L);
        if (which == 0) {
            float ss = 0.f;
#pragma unroll
            for (int ob = 0; ob < 4; ++ob)
#pragma unroll
                for (int i = 0; i < 16; ++i) ss += out[ob][i] * out[ob][i];
            ss += __shfl_xor(ss, 32);
            if (L.h == 0) ((float*)(W.ws + WS_KNC))[(size_t)(b * 2 + g) * 1024 + c] = sqrtf(ss);
        }
    }
}
DI void key_norms(const WsPtrs& W, int gw, int NGW, int lane) {
#pragma unroll 1
    for (int wu = gw; wu < 2048; wu += NGW) { const int type = wu >> 10, b = (wu >> 9) & 1, g = (wu >> 8) & 1, j = wu & 255;
        const bf16* rp = W.QKV() + ((size_t)b * SEQ + 64 * j + lane) * QP + (type ? C_KW : C_KS) + g * 128;
        v4u x[16];
#pragma unroll
        for (int k = 0; k < 16; ++k) x[k] = *(const GAS v4u*)(rp + 8 * k);
        float ss = 0.f;
#pragma unroll
        for (int k = 0; k < 16; ++k) { ss += bflo(x[k].x) * bflo(x[k].x) + bfhi(x[k].x) * bfhi(x[k].x); ss += bflo(x[k].y) * bflo(x[k].y) + bfhi(x[k].y) * bfhi(x[k].y);
            ss += bflo(x[k].z) * bflo(x[k].z) + bfhi(x[k].z) * bfhi(x[k].z); ss += bflo(x[k].w) * bflo(x[k].w) + bfhi(x[k].w) * bfhi(x[k].w); }
#pragma unroll
        for (int o = 1; o < 64; o <<= 1) ss = fmaxf(ss, __shfl_xor(ss, o));
        if (lane == 0) ((float*)(W.ws + WS_KNS))[wu] = sqrtf(ss); }
}
constexpr int NSA_BUF = 64 * K128STR + 64 * V128STR;
constexpr int NSA_SEL_OFF = 2 * NSA_BUF, NSA_WUN_OFF = NSA_SEL_OFF + 8192, NSA_GUN_OFF = NSA_WUN_OFF + 256, NSA_LIST_OFF = NSA_GUN_OFF + 256, NSA_NLIST_OFF = NSA_LIST_OFF + 2048, NSA_QX_OFF = NSA_NLIST_OFF + 256, NSA_STAT_OFF = NSA_QX_OFF + 8 * 4096;
constexpr int NSA_PM_OFF = NSA_STAT_OFF + 3 * NTHREADS * 8;
constexpr int NSA_PMW_OFF = NSA_PM_OFF + 1024, NSA_PMC_OFF = NSA_PMW_OFF + 1024, NSA_VOTE_OFF = NSA_PMC_OFF + 64;
static_assert(NSA_VOTE_OFF + 64 <= RING_BYTES + 14336, "NSA LDS map");
#ifndef NSA_CUT
#define NSA_CUT 7
#endif
static_assert(256 * K128STR <= NSA_SEL_OFF, "step A stages 256 compressed keys at a time below the masks");
#define TOPN 13
typedef unsigned long long u64;
DI void top_insert(u64 (&tk)[TOPN], u64 c) {
#pragma unroll
    for (int k = 0; k < TOPN; ++k) { const u64 a = tk[k]; const bool gt = c > a; tk[k] = gt ? c : a; c = gt ? a : c; }
}
DI u64 top_key(float score, int j) { return ((u64)__builtin_bit_cast(unsigned, score) << 32) | (u64)(0xffffffffu - (unsigned)j); }
DI void nsa_unit(const WsPtrs& W, LAS unsigned char* lds, int idx, int tid, int wave, const LaneIx& L) {
    const int b = idx >> 7, g = (idx >> 6) & 1, qt = idx & 63;
    const int t0 = qt * 256, tw0 = t0 + 32 * wave, t = tw0 + L.r, cur = t >> 6;
    const bf16* qkvb = W.QKV() + (size_t)b * SEQ * QP;
    const bf16* kcmp = W.KCMP() + (size_t)(b * 2 + g) * 1024 * 128; const bf16* vcmp = W.VCMP() + (size_t)(b * 2 + g) * 1024 * 128;
    LAS unsigned char* Kt = lds; LAS unsigned char* Vt = lds + 64 * K128STR;
    LAS unsigned* selm = (LAS unsigned*)(lds + NSA_SEL_OFF); LAS unsigned* wun = (LAS unsigned*)(lds + NSA_WUN_OFF); LAS unsigned* gun = (LAS unsigned*)(lds + NSA_GUN_OFF);
    int n_c = t0 / 16 + 15; n_c = n_c < NCMP ? n_c : NCMP;
    const int ntile = (n_c + 63) >> 6, wave_cmax = t0 / 16 + 2 * wave;
    float sl2[3];
#pragma unroll
    for (int hh = 0; hh < 3; ++hh) sl2[hh] = alibi_slope(3 * (g * 3 + hh)) * LOG2E;
    if (tid == 0) { LAS unsigned* list = (LAS unsigned*)(lds + NSA_LIST_OFF); for (int i = 0; i < ntile; ++i) list[i] = (unsigned)(ntile - 1 - i); }
    if (wave < 2) { const float* kn = (const float*)(W.ws + WS_KNS) + (size_t)((wave * 2 + b) * 2 + g) * 256; const f32x4 v = *(const GAS f32x4*)(kn + 4 * L.lane);
        float p0 = v.x, p1 = fmaxf(p0, v.y), p2 = fmaxf(p1, v.z), p3 = fmaxf(p2, v.w), c = p3;
#pragma unroll
        for (int o = 1; o < 64; o <<= 1) { const float n = __shfl_up(c, o); if (L.lane >= o) c = fmaxf(c, n); }
        float ex = __shfl_up(c, 1); if (L.lane == 0) ex = 0.f;
        LAS float* pm = (LAS float*)(lds + (wave ? NSA_PMW_OFF : NSA_PM_OFF)) + 4 * L.lane;
        pm[0] = fmaxf(p0, ex); pm[1] = fmaxf(p1, ex); pm[2] = fmaxf(p2, ex); pm[3] = fmaxf(p3, ex); }
    if (wave == 2) { const float* knc = (const float*)(W.ws + WS_KNC) + (size_t)(b * 2 + g) * 1024; float pm = 0.f;
#pragma unroll 1
        for (int i = 0; i < ntile; ++i) { const int c = 64 * i + L.lane; float v = c < NCMP ? knc[c] : 0.f;
#pragma unroll
            for (int o = 1; o < 64; o <<= 1) v = fmaxf(v, __shfl_xor(v, o));
            pm = fmaxf(pm, v); if (L.lane == 0) ((LAS float*)(lds + NSA_PMC_OFF))[i] = pm; } }
    __syncthreads();
#pragma unroll 1
    for (int pass = 0; pass < 6; ++pass) { const int hh = pass < 3 ? pass : pass - 3;
        if (pass == 3) {
        const int tS = opaque_v(t), curS = tS >> 6; const LaneIx LS = lane_ix(opaque_v(tid));
        bf16x8 q3[3][8];
#pragma unroll
        for (int hh = 0; hh < 3; ++hh) { const bf16* qrow = qkvb + (size_t)tS * QP + C_QA + (g * 3 + hh) * 128;
#pragma unroll
            for (int ks = 0; ks < 8; ++ks) q3[hh][ks] = *(const GAS bf16x8*)(qrow + 16 * ks + 8 * LS.h); }
        float m3[3], inv3[3];
        { const LAS float* stf = (const LAS float*)(lds + NSA_STAT_OFF);
#pragma unroll
          for (int hh = 0; hh < 3; ++hh) { m3[hh] = stf[(hh * NTHREADS + tid) * 2]; const float lt = stf[(hh * NTHREADS + tid) * 2 + 1]; inv3[hh] = lt > 0.f ? 1.0f / lt : 0.f; } }
        u64 tk[TOPN];
#pragma unroll
        for (int k = 0; k < TOPN; ++k) tk[k] = 0ull;
        float carry = 0.f;
        float qn3[3];
#pragma unroll
        for (int hh = 0; hh < 3; ++hh) { float ss = 0.f;
#pragma unroll
            for (int ks = 0; ks < 8; ++ks)
#pragma unroll
                for (int j = 0; j < 8; ++j) { const float a = bf2f((bf16)q3[hh][ks][j]); ss += a * a; }
            qn3[hh] = sqrtf(ss + __shfl_xor(ss, 32)) * (C2_128 * 1.02f); }
        const int E = (t0 / 16 + 16 + 31) & ~31, NS = (E + 255) >> 8;
        auto skipfn = [&](int cbx) -> bool {
            const float T = tk[TOPN - 1] != 0ull ? __builtin_bit_cast(float, (unsigned)(tk[TOPN - 1] >> 32)) : -1.0f;
            const float kn = ((LAS const float*)(lds + NSA_PMC_OFF))[(cbx + 31) >> 6]; const int dm = tS - (16 * (cbx + 31) + 31); const float dmin = (float)(dm > 0 ? dm : 0);
            float ub = 0.f;
#pragma unroll
            for (int hh = 0; hh < 3; ++hh) ub += ex2(qn3[hh] * kn - sl2[hh] * dmin - m3[hh]) * inv3[hh];
            return __all(4.1f * ub < T); };
        float dfs = 0.f; int dfj = -1;
#pragma unroll 1
        for (int step = 0; step < NS * 8; ++step) {
            const bool ph1 = step < 8; const int sidx = ph1 ? NS - 1 : ((step - 8) >> 3), sub = step & 7, lo = E - 256 * (NS - sidx);
            if (sub == 0) {
                __syncthreads();
                stage_rows<128, K128STR, 256>(Kt, [&](int i, bool& ok) -> const bf16* { const int c = lo + i; ok = c >= 0 && c < NCMP; return kcmp + (size_t)(ok ? c : 0) * 128; }, opaque_v(tid));
                __syncthreads();
                if (!ph1 && sidx == 0) carry = 0.f;
            }
            const int cb = lo + 32 * sub;
            if (cb < 0 || cb > wave_cmax) continue;
            bool defer = false;
            if (!ph1) { const bool last = step == NS * 8 - 1; const bool skB = skipfn(cb); const bool skN = last ? false : skipfn(cb + 32);
                if (skB && skN) { carry = 0.f; continue; } }
            else defer = sub == 0 && NS >= 2;
            {
                const int dist0 = tS - (16 * cb + 31);
                f32x16 imp = zero16();
#pragma unroll
                for (int hh = 0; hh < 3; ++hh) { const f32x16 s = qk32<128, K128STR, 8>(q3[hh], nullptr, Kt + 32 * sub * K128STR, LS);
#pragma unroll
                    for (int i = 0; i < 16; ++i) { const int kl = (i & 3) + 8 * (i >> 2) + 4 * LS.h, dist = dist0 - 16 * kl;
                        const float p = dist >= 0 ? ex2(s[i] * C2_128 - sl2[hh] * (float)dist - m3[hh]) * inv3[hh] : 0.f; imp[i] += p; } }
                const float sx0 = __shfl_xor(imp[3], 32), sx1 = __shfl_xor(imp[7], 32), sx2 = __shfl_xor(imp[11], 32), sx3 = __shfl_xor(imp[15], 32), cx = __shfl_xor(carry, 32);
                float sc[4];
                sc[0] = 0.5f * (LS.h ? sx0 : cx) + imp[0] + imp[1] + imp[2] + 0.5f * imp[3];
                sc[1] = 0.5f * (LS.h ? sx1 : sx0) + imp[4] + imp[5] + imp[6] + 0.5f * imp[7];
                sc[2] = 0.5f * (LS.h ? sx2 : sx1) + imp[8] + imp[9] + imp[10] + 0.5f * imp[11];
                sc[3] = 0.5f * (LS.h ? sx3 : sx2) + imp[12] + imp[13] + imp[14] + 0.5f * imp[15];
                carry = imp[15];
                if (defer) { dfs = imp[0] + imp[1] + imp[2] + 0.5f * imp[3]; dfj = cb >> 2; }
#pragma unroll
                for (int g4 = 0; g4 < 4; ++g4) { const int j = (cb >> 2) + 2 * g4 + LS.h; bool ok = j >= 1 && j <= curS - 2; if (g4 == 0 && defer && LS.h == 0) ok = false; const u64 ck = ok ? top_key(sc[g4], j) : 0ull;
                    if (__any(ck > tk[TOPN - 1])) top_insert(tk, ck); }
            }
        }
        if (dfj >= 0) { const float cx = __shfl_xor(carry, 32); const float scd = 0.5f * cx + dfs;
            const bool ok = LS.h == 0 && dfj >= 1 && dfj <= curS - 2; const u64 ck = ok ? top_key(scd, dfj) : 0ull;
            if (__any(ck > tk[TOPN - 1])) top_insert(tk, ck); }
        { u64 pk[TOPN];
#pragma unroll
            for (int k = 0; k < TOPN; ++k) { const unsigned lo = (unsigned)__shfl_xor((int)(unsigned)tk[k], 32), hi = (unsigned)__shfl_xor((int)(unsigned)(tk[k] >> 32), 32); pk[k] = ((u64)hi << 32) | lo; }
#pragma unroll
            for (int k = 0; k < TOPN; ++k) top_insert(tk, pk[k]); }
        unsigned wsel[8];
#pragma unroll
        for (int wd = 0; wd < 8; ++wd) { unsigned v = (wd == 0) ? 1u : 0u; v |= ((curS >> 5) == wd) ? (1u << (curS & 31)) : 0u; if (curS >= 1) v |= (((curS - 1) >> 5) == wd) ? (1u << ((curS - 1) & 31)) : 0u; wsel[wd] = v; }
#pragma unroll
        for (int k = 0; k < TOPN; ++k) { const bool ok = tk[k] != 0ull; const unsigned jj = 0xffffffffu - (unsigned)tk[k]; const unsigned wj = jj >> 5, bit = 1u << (jj & 31);
#pragma unroll
            for (int wd = 0; wd < 8; ++wd) wsel[wd] |= (ok && wj == (unsigned)wd) ? bit : 0u; }
#pragma unroll
        for (int wd = 0; wd < 8; ++wd) { if (LS.h == 0) selm[(32 * wave + LS.r) * 8 + wd] = wsel[wd];
            unsigned u = wsel[wd]; u |= __shfl_xor(u, 1); u |= __shfl_xor(u, 2); u |= __shfl_xor(u, 4); u |= __shfl_xor(u, 8); u |= __shfl_xor(u, 16);
            if (LS.lane == 0) wun[wave * 8 + wd] = u; }
        __syncthreads();
        if (tid < 8) { unsigned u = 0; for (int w = 0; w < 8; ++w) u |= wun[w * 8 + tid]; gun[tid] = u; }
        __syncthreads();
        if (tid == 0) {
            LAS unsigned* list = (LAS unsigned*)(lds + NSA_LIST_OFF); int n = ntile;
            for (int wd = 7; wd >= 0; --wd) { unsigned wm = gun[wd]; while (wm) { const int bit = 31 - __builtin_clz(wm); wm &= ~(1u << bit); list[n++] = 0x10000u | (unsigned)(32 * wd + bit); } }
            *(LAS int*)(lds + NSA_NLIST_OFF + 4) = n;
            for (int i = 11; i >= 0; --i) if (t0 - 512 + 64 * i + 63 >= 0) list[n++] = 0x20000u | (unsigned)i;
            *(LAS int*)(lds + NSA_NLIST_OFF) = n; }
        __syncthreads();
        }
        const int head = g * 3 + hh; const float s2 = alibi_slope(3 * head) * LOG2E;
        const int tq = opaque_v(t);
        const bf16* trow = qkvb + (size_t)tq * QP;
        bf16x8 q[4];
        LAS unsigned char* qx = lds + NSA_QX_OFF + wave * 4096;
        const LaneIx Lq = lane_ix(opaque_v(tid));
#pragma unroll
        for (int ks = 0; ks < 4; ++ks) q[ks] = *(const GAS bf16x8*)(trow + C_QA + head * 128 + 16 * ks + 8 * Lq.h);
        float qss = 0.f;
        { bf16x8 qt4[4];
#pragma unroll
          for (int ks = 4; ks < 8; ++ks) qt4[ks - 4] = *(const GAS bf16x8*)(trow + C_QA + head * 128 + 16 * ks + 8 * Lq.h);
#pragma unroll
          for (int ks = 4; ks < 8; ++ks) *(LAS bf16x8*)(qx + ((ks - 4) * 64 + Lq.lane) * 16) = qt4[ks - 4];
#pragma unroll
          for (int ks = 0; ks < 4; ++ks)
#pragma unroll
              for (int j = 0; j < 8; ++j) { const float a = bf2f((bf16)q[ks][j]), c = bf2f((bf16)qt4[ks][j]); qss += a * a + c * c; } }
        const float qn = sqrtf(qss + __shfl_xor(qss, 32)) * (C2_128 * 1.02f);
        FlashSt<128> st; flash_init(st);
        const LAS unsigned* list = (const LAS unsigned*)(lds + NSA_LIST_OFF);
        const int e0 = pass < 3 ? 0 : ntile, nlist = pass < 3 ? ntile : __builtin_amdgcn_readfirstlane(*(const LAS int*)(lds + NSA_NLIST_OFF));
        v4u kreg[2], vreg[2];
        auto tile_geom = [&](unsigned e, const bf16*& kb, const bf16*& vb, int& pitch, int& r0, int& r1) {
            const int ty = (int)(e >> 16), ix = (int)(e & 0xffffu); r0 = 0; r1 = 64;
            if (ty == 0) { kb = kcmp + (size_t)(64 * ix) * 128; vb = vcmp + (size_t)(64 * ix) * 128; pitch = 128; r1 = NCMP - 64 * ix; }
            else if (ty == 1) { kb = qkvb + (size_t)(64 * ix) * QP + C_KS + g * 128; vb = kb + (C_VS - C_KS); pitch = QP; }
            else { const int tk0 = t0 - 512 + 64 * ix; kb = qkvb + (ptrdiff_t)tk0 * QP + C_KW + g * 128; vb = kb + (C_VW - C_KW); pitch = QP; r0 = -tk0; } };
        auto tile_load = [&](unsigned e, int tidx) {
            const bf16 *kb, *vb; int pitch, r0, r1; tile_geom(e, kb, vb, pitch, r0, r1);
#pragma unroll
            for (int k = 0; k < 2; ++k) { const int id = tidx + k * NTHREADS, row = id >> 4, ch = id & 15; const bool ok = row >= r0 && row < r1; const int rc = ok ? row : (r0 > 0 ? r0 : 0);
                kreg[k] = *(const GAS v4u*)(kb + (ptrdiff_t)rc * pitch + ch * 8); vreg[k] = *(const GAS v4u*)(vb + (ptrdiff_t)rc * pitch + ch * 8); } };
        auto tile_store = [&](unsigned e, int buf, int tidx) { LAS unsigned char* kt = lds + buf * NSA_BUF; LAS unsigned char* vt = kt + 64 * K128STR;
            const bf16 *kb, *vb; int pitch, r0, r1; tile_geom(e, kb, vb, pitch, r0, r1); const v4u z = (v4u){0u, 0u, 0u, 0u};
#pragma unroll
            for (int k = 0; k < 2; ++k) { const int id = tidx + k * NTHREADS, row = id >> 4, ch = id & 15; const bool ok = row >= r0 && row < r1;
                *(LAS v4u*)(kt + row * K128STR + ch * 16) = ok ? kreg[k] : z; *(LAS v4u*)(vt + row * V128STR + ch * 16) = ok ? vreg[k] : z; } };
        auto branch_done = [&](int ty) {
            const int tq2 = opaque_v(t);
            const int hq2 = opaque_v(tid) >> 5 & 1;
            const float gsel = sigm(bf2f(qkvb[(size_t)tq2 * QP + C_GN + head * 3 + ty]));
            const float lt = flash_l(st), sc = lt > 0.f ? gsel / lt : 0.f;
            float* yacc = (float*)W.F() + ((size_t)b * SEQ + tq2) * 768 + head * 128 + 4 * hq2;
            bf16* yo = W.YA() + ((size_t)b * SEQ + tq2) * 768 + head * 128 + 4 * hq2;
            f32x4 acc[4][4];
            if (ty != 0) {
#pragma unroll
                for (int d = 0; d < 4; ++d)
#pragma unroll
                    for (int g4 = 0; g4 < 4; ++g4) acc[d][g4] = *(const GAS f32x4*)(yacc + 32 * d + 8 * g4);
            } else {
#pragma unroll
                for (int d = 0; d < 4; ++d)
#pragma unroll
                    for (int g4 = 0; g4 < 4; ++g4) acc[d][g4] = (f32x4){0.f, 0.f, 0.f, 0.f};
            }
#pragma unroll
            for (int d = 0; d < 4; ++d)
#pragma unroll
                for (int g4 = 0; g4 < 4; ++g4) { f32x4 a = acc[d][g4];
                    a = (f32x4){a.x + st.o[d][4 * g4] * sc, a.y + st.o[d][4 * g4 + 1] * sc, a.z + st.o[d][4 * g4 + 2] * sc, a.w + st.o[d][4 * g4 + 3] * sc};
                    if (ty != 2) *(GAS f32x4*)(yacc + 32 * d + 8 * g4) = a; else { v2u w; w.x = pk2(a.x, a.y); w.y = pk2(a.z, a.w); *(GAS v2u*)(yo + 32 * d + 8 * g4) = w; } }
            flash_init(st); };
        __syncthreads();
        { const int tid0 = opaque_v(tid); const unsigned d0 = (unsigned)__builtin_amdgcn_readfirstlane((int)list[e0]); tile_load(d0, tid0); tile_store(d0, 0, tid0); }
        __syncthreads();
        int curty = pass < 3 ? 0 : 1;
        const int winstart = __builtin_amdgcn_readfirstlane(*(const LAS int*)(lds + NSA_NLIST_OFF + 4));
        LAS unsigned* votes = (LAS unsigned*)(lds + NSA_VOTE_OFF);
        bool fresh = true;
#pragma unroll 1
        for (int e = e0; e < nlist; ++e) {
            if (!fresh) {
                LAS const unsigned* vp = votes + ((e - 1 - e0) & 1) * 8; const v4u va = *(LAS const v4u*)vp, vb = *(LAS const v4u*)(vp + 4);
                const unsigned all8 = va.x & va.y & va.z & va.w & vb.x & vb.y & vb.z & vb.w;
                if (__builtin_amdgcn_readfirstlane((int)all8) != 0) {
                    const int en = curty == 0 ? nlist : (curty == 1 ? winstart : nlist);
                    if (en >= nlist) break;
                    e = en;
                    { const int tid0 = opaque_v(tid); const unsigned dj = (unsigned)__builtin_amdgcn_readfirstlane((int)list[e]); tile_load(dj, tid0); tile_store(dj, (e - e0) & 1, tid0); }
                    __syncthreads();
                    fresh = true;
                }
            }
            const unsigned de = (unsigned)__builtin_amdgcn_readfirstlane((int)list[e]);
            const int tide = opaque_v(tid); const LaneIx Le = lane_ix(tide);
            if (e + 1 < nlist) tile_load((unsigned)__builtin_amdgcn_readfirstlane((int)list[e + 1]), tide);
            __builtin_amdgcn_sched_barrier(0);
            const int ty = (int)(de >> 16), ix = (int)(de & 0xffffu);
            if (ty != curty) { branch_done(curty); curty = ty; }
            LAS const unsigned char* kt = lds + ((e - e0) & 1) * NSA_BUF; LAS const unsigned char* vt = kt + 64 * K128STR;
            bool selb = true; unsigned wu1 = 1u;
            if (ty == 1) { const int wd = ix >> 5, bit = ix & 31; wu1 = ((unsigned)__builtin_amdgcn_readfirstlane((int)wun[wave * 8 + wd]) >> bit) & 1u; selb = (selm[(32 * wave + Le.r) * 8 + wd] >> bit) & 1u; }
            const bool allsel = __all(selb);
#pragma unroll 1
            for (int sub = 1; sub >= 0; --sub) {
                int dist0, step, dmax, klmin; bool active, allv;
                if (ty == 0) { const int cb = 64 * ix + 32 * sub; active = cb <= wave_cmax; dist0 = t - (16 * cb + 31); step = 16; dmax = 0x7fffffff; klmin = 0; allv = tw0 - 16 * cb - 527 >= 0; }
                else if (ty == 1) { active = wu1 != 0u; dist0 = t - (64 * ix + 32 * sub); step = 1; dmax = 0x7fffffff; klmin = 0; allv = allsel && (tw0 - 64 * ix - 32 * sub - 31 >= 0); }
                else { const int tb = t0 - 512 + 64 * ix + 32 * sub; active = !(tb + 31 < tw0 - 511 || tb > tw0 + 31); dist0 = t - tb; step = 1; dmax = 512; klmin = -tb; allv = tb >= 0 && (tw0 - tb - 31 >= 0) && (tw0 + 31 - tb <= 511); }
                if (active)
                    flash32<128, K128STR, V128STR, 4>(st, q, qx, kt + 32 * sub * K128STR, vt + 32 * sub * V128STR, C2_128, Le, allv, -s2 * (float)dist0, s2 * (float)step,
                        [&](int kl) { const int dist = dist0 - step * kl; return selb && dist >= 0 && dist < dmax && kl >= klmin; });
            }
            { unsigned vote = 0u;
              if (e + 1 < nlist) { const unsigned dn = (unsigned)__builtin_amdgcn_readfirstlane((int)list[e + 1]);
                  if ((int)(dn >> 16) == ty && ((NSA_CUT >> ty) & 1)) {
                      float knr; int npos;
                      if (ty == 0) { knr = ((LAS const float*)(lds + NSA_PMC_OFF))[ix - 1]; npos = 1024 * ix + 15; }
                      else if (ty == 1) { const int jn = (int)(dn & 0xffffu); knr = ((LAS const float*)(lds + NSA_PM_OFF))[jn]; npos = 64 * jn + 63; }
                      else { const int bi = 4 * qt - 8 + ix - 1; knr = ((LAS const float*)(lds + NSA_PMW_OFF))[bi]; npos = 64 * bi + 63; }
                      const int dm = t - npos; const float dmin = (float)(dm > 0 ? dm : 0);
                      const bool okc = qn * knr - s2 * dmin < st.m - SKIP_THR;
                      vote = __all(okc) ? 1u : 0u; } }
              if (Le.lane == 0) votes[((e - e0) & 1) * 8 + wave] = vote; }
            fresh = false;
            __builtin_amdgcn_sched_barrier(0);
            if (e + 1 < nlist) tile_store((unsigned)__builtin_amdgcn_readfirstlane((int)list[e + 1]), (e + 1 - e0) & 1, opaque_v(tid));
            asm volatile("s_waitcnt lgkmcnt(0)" ::: "memory"); __builtin_amdgcn_s_barrier(); asm volatile("" ::: "memory");
        }
        if (pass < 3) { LAS float* stf = (LAS float*)(lds + NSA_STAT_OFF); stf[(hh * NTHREADS + tid) * 2] = st.m; stf[(hh * NTHREADS + tid) * 2 + 1] = flash_l(st); }
        branch_done(curty);
    }
}

#define XB_TMO      128
#define XB_XCNT(j)  (256  + 64 * (j))
#define XB_XSUB(j)  (1280 + 64 * (j))
#define XB_XGEN(j)  (2304 + 64 * (j))
#define XB_TOP      3328
#define XB_TOPGEN   3392
#define XCD_BAR_WORDS 3456
#define XB_SPIN_CAP (1u << 18)

__device__ __forceinline__ unsigned xb_ld(unsigned* p)              { return __hip_atomic_load(p, __ATOMIC_RELAXED, __HIP_MEMORY_SCOPE_AGENT); }
__device__ __forceinline__ unsigned xb_add(unsigned* p, unsigned v) { return __hip_atomic_fetch_add(p, v, __ATOMIC_RELAXED, __HIP_MEMORY_SCOPE_AGENT); }
__device__ __forceinline__ unsigned xb_xcc_id() { return (unsigned)__builtin_amdgcn_s_getreg((3 << 11) | 20) & 0xFu; }
#define XB_SPIN(cond, bar) do { unsigned _sp = 0; while (cond) { __builtin_amdgcn_s_sleep(1); \
    if ((++_sp & 255u) == 0u) { if (xb_ld(&(bar)[XB_TMO])) break; if (_sp > XB_SPIN_CAP) { atomicAdd(&(bar)[XB_TMO], 1u); break; } } } } while (0)

struct XcdBarrier {
    unsigned* bar; unsigned x;
    volatile LAS unsigned* st;
};

__device__ __forceinline__ XcdBarrier xcd_barrier_post(unsigned* bar, volatile LAS unsigned* st, int tid) {
    XcdBarrier b; b.bar = bar; b.x = xb_xcc_id(); b.st = st;
    if (tid == 0) (void)xb_add(&bar[XB_XCNT(b.x)], 1u);
    return b;
}
__device__ __forceinline__ void xcd_barrier_complete(unsigned* bar, unsigned x, unsigned& nloc, unsigned& nx) {
    const unsigned G = gridDim.x * gridDim.y * gridDim.z;
    unsigned sum, cnt, mine, sp = 0u;
    for (;;) {
        sum = 0u; cnt = 0u; mine = 0u;
#pragma unroll
        for (unsigned j = 0; j < 16; ++j) { const unsigned c = xb_ld(&bar[XB_XCNT(j)]); sum += c; cnt += (c > 0u) ? 1u : 0u; mine = (j == x) ? c : mine; }
        if (sum == G) break;
        __builtin_amdgcn_s_sleep(1);
        if ((++sp & 255u) == 0u) { if (xb_ld(&bar[XB_TMO])) break; if (sp > XB_SPIN_CAP) { atomicAdd(&bar[XB_TMO], 1u); break; } }
    }
    nloc = mine > 0u ? mine : 1u; nx = cnt > 0u ? cnt : 1u;
}

__device__ __forceinline__ void xcd_barrier(const XcdBarrier& b, int tid) {
    asm volatile("s_waitcnt vmcnt(0)" ::: "memory");
    __syncthreads();
    if (tid == 0) {
        unsigned* bar = b.bar;
        __builtin_amdgcn_s_waitcnt(0);
        unsigned nloc = b.st[0], nx = b.st[1];
        if (nloc == 0u) { xcd_barrier_complete(bar, b.x, nloc, nx); b.st[0] = nloc; b.st[1] = nx; }
        const unsigned old = xb_add(&bar[XB_XSUB(b.x)], 1u);
        const unsigned gen = old / nloc;
        if (old + 1u == (gen + 1u) * nloc) {
            __builtin_amdgcn_fence(__ATOMIC_RELEASE, "agent");
            asm volatile("s_waitcnt vmcnt(0)" ::: "memory");
            const unsigned og = xb_add(&bar[XB_TOP], 1u);
            const unsigned tg = og / nx;
            if (og + 1u == (tg + 1u) * nx) xb_add(&bar[XB_TOPGEN], 1u);
            else XB_SPIN(xb_ld(&bar[XB_TOPGEN]) == tg, bar);
            __builtin_amdgcn_fence(__ATOMIC_ACQUIRE, "agent");
            xb_add(&bar[XB_XGEN(b.x)], 1u);
            asm volatile("s_waitcnt vmcnt(0)" ::: "memory");
        } else {
            XB_SPIN(xb_ld(&bar[XB_XGEN(b.x)]) == gen, bar);
            __builtin_amdgcn_fence(__ATOMIC_ACQUIRE, "agent");
            asm volatile("s_waitcnt vmcnt(0)" ::: "memory");
        }
    }
    __syncthreads();
}

constexpr int NCONVQ = 256;
constexpr int NPL = 14;
constexpr int NPH = 1 + NPL * DEPTH;
struct Args { const float* in[27]; float* out; unsigned char* ws; int ph_lo, ph_hi; };
static_assert(sizeof(Args) == 27 * 8 + 8 + 8 + 8, "Args has no padding");

typedef __attribute__((address_space(4))) const unsigned long long* kargp_t;
DI kargp_t kargs_opaque() { const unsigned long long v = (unsigned long long)__builtin_amdgcn_kernarg_segment_ptr(); unsigned lo = (unsigned)v, hi = (unsigned)(v >> 32);
    asm volatile("" : "+s"(lo), "+s"(hi)); return (kargp_t)(((unsigned long long)hi << 32) | lo); }
DI const float* kin(kargp_t kp, int i) { return (const float*)kp[i]; }
DI LayerW layer_w(kargp_t kp, int l) {
    LayerW L;
    L.f1pre = kin(kp, 2) + (size_t)l * D; L.f1g = kin(kp, 3) + (size_t)l * D * FF; L.f1u = kin(kp, 4) + (size_t)l * D * FF; L.f1d = kin(kp, 5) + (size_t)l * FF * D; L.f1post = kin(kp, 6) + (size_t)l * D;
    L.mixpre = kin(kp, 7) + (size_t)l * D; L.win = kin(kp, 8) + (size_t)l * D * NIN; L.pek = kin(kp, 9) + (size_t)l * 4096; L.pev = kin(kp, 10) + (size_t)l * 4096;
    L.c1k = kin(kp, 11) + (size_t)l * 4096 * 256; L.c2k = kin(kp, 12) + (size_t)l * 256 * 128; L.c1v = kin(kp, 13) + (size_t)l * 4096 * 256; L.c2v = kin(kp, 14) + (size_t)l * 256 * 128;
    L.memg = kin(kp, 15) + (size_t)l * D; L.wmkv = kin(kp, 16) + (size_t)l * D * 1024; L.wupa = kin(kp, 17) + (size_t)l * 768 * D; L.wupb = kin(kp, 18) + (size_t)l * 256 * D; L.wupm = kin(kp, 19) + (size_t)l * 512 * D;
    L.wout = kin(kp, 20) + (size_t)l * D * D; L.mixpost = kin(kp, 21) + (size_t)l * D; L.f2pre = kin(kp, 22) + (size_t)l * D; L.f2g = kin(kp, 23) + (size_t)l * D * FF; L.f2u = kin(kp, 24) + (size_t)l * D * FF;
    L.f2d = kin(kp, 25) + (size_t)l * FF * D; L.f2post = kin(kp, 26) + (size_t)l * D;
    return L;
}

__global__ void __launch_bounds__(NTHREADS, 2) mk_fwd(Args args) {
    extern __shared__ __attribute__((aligned(16))) unsigned char lds_raw[];
    LAS unsigned char* lds = (LAS unsigned char*)lds_raw;
    const int G = gridDim.x, bx = blockIdx.x;
    const int wave0 = __builtin_amdgcn_readfirstlane((int)threadIdx.x >> 6);
#define MK_TID() (wave0 * 64 + lane_id_v())
    { const int tid0 = MK_TID();
      for (int u = tid0; u < (LDS_BYTES - LDSCTL_OFF) / 4; u += NTHREADS) ((LAS unsigned*)(lds + LDSCTL_OFF))[u] = 0u; }
    __syncthreads();
#if MK_ONE_LAUNCH
    XcdBarrier bar = xcd_barrier_post((unsigned*)((unsigned char*)kargs_opaque()[28] + WS_CTL) + CW_BAR, (volatile LAS unsigned*)(lds + MISC_OFF + 32), MK_TID());
#define GRID_BAR() xcd_barrier(bar, MK_TID())
#else
#define GRID_BAR() do { } while (0)
#endif
    const int lo = args.ph_lo, hi = args.ph_hi;
#define IN(k) (lo <= (k) && (k) < hi)
#define SEAM(k) do { if (IN(k) && IN((k) + 1)) GRID_BAR(); } while (0)
#ifndef PROBE_MASK
#define PROBE_MASK 0
#endif
#define PH_BEGIN(k) {
#define PH_END(k) }
#define PHASE_VIEWS() const kargp_t kp = kargs_opaque(); WsPtrs W; W.ws = (unsigned char*)kp[28]; float* const outp = (float*)kp[27]; (void)outp; const int tid = opaque_v(MK_TID()), lane = tid & 63, wave = wave0; \
    const int bxp = opaque_s(bx), Gp = opaque_s(G); const int gw = bxp * NWAVES + wave, NGW = Gp * NWAVES; (void)lane; (void)gw; (void)NGW; (void)W

    if (IN(0)) { PHASE_VIEWS();
        const LayerW L0 = layer_w(kp, 0);
        convert_layer<0>(L0, W, lds, bxp, Gp, tid);
        const float* x = kin(kp, 0);
        norm_phase_first(x, (bf16*)outp, W.RS(), T, gw, NGW, lane);
    }
    SEAM(0);
#pragma unroll 1
    for (int l = 0; l < DEPTH; ++l) {
        const int pb = 1 + NPL * l;
        if (IN(pb + 0)) { PH_BEGIN(0) PHASE_VIEWS(); const bool split = (MK_ONE_LAUNCH != 0) && Gp == 256;
            pg8::Gemm g{(const bf16*)outp, W.wgu1(), T, 2 * FF, D}; pg8::StaticOrder S; S.init(T, split ? 42 * 256 : 2 * FF, Gp, bxp); pg8::EpiSwiGLU E{W.HID(), FF, W.RS()};
            pg8::gemm_phase<pg8::EpiSwiGLU, pg8::StaticOrder, true, true>(lds, g, S, E, tid);
            if (split) { const int kh = (bxp >> 3) & 1; auto barf = [&]() { GRID_BAR(); };
                pg8::Gemm g2{(const bf16*)outp + kh * 1024, W.wgu1() + kh * 1024, T, 2 * FF, 1024, D}; pg8::OrderOne S2{((bxp >> 4) << 3) | (bxp & 7), 42};
                pg8::EpiSwiGLUPair<decltype(barf)> E2{W.HID(), FF, W.RS(), (float*)W.U(), kh, barf};
                pg8::gemm_phase<pg8::EpiSwiGLUPair<decltype(barf)>, pg8::OrderOne, true, true>(lds, g2, S2, E2, tid); }
            PH_END(0) }
        SEAM(pb + 0);
        if (IN(pb + 1)) { PH_BEGIN(1) PHASE_VIEWS(); pg8::Gemm g{W.HID(), W.wd1(), T, D, FF}; pg8::StaticOrder S; S.init(T, D, Gp, bxp, 2); S.rev = 1; pg8::EpiBf16 E{W.F(), D, 1 << 30, 0, nullptr, 0, nullptr};
            pg8::gemm_phase<pg8::EpiBf16, pg8::StaticOrder, true, true>(lds, g, S, E, tid); PH_END(1) }
        SEAM(pb + 1);
        if (IN(pb + 2)) { PHASE_VIEWS(); const LayerW LW = layer_w(kp, opaque_s(l));
            bf16* hA = (bf16*)outp; const float* mem = kin(kp, 1);
            norm_phase_res<false, false>(hA, W.F(), LW.f1post, 0.5f, hA, W.RS(), gw, NGW, lane);
            norm_phase_first(mem, hA + (size_t)T * D, W.RS() + T, BATCH * MEML, gw, NGW, lane);
        }
        SEAM(pb + 2);
        if (IN(pb + 3)) { PH_BEGIN(3) PHASE_VIEWS(); pg8::Gemm g{(const bf16*)outp, W.win(), TM, NWIN, D}; pg8::OrderPlusExtra S; S.init(T, QP, Gp, bxp); S.nextra = 8; S.pm0 = T / 256; S.pn0 = QP / 256; S.ncx = 4;
            pg8::EpiBf16 E{W.QKV(), QP, T / 256, QP / 256, W.MEMKV(), 1024, W.RS()};
            pg8::gemm_phase<pg8::EpiBf16, pg8::OrderPlusExtra, true, true>(lds, g, S, E, tid); PH_END(3) }
        SEAM(pb + 3);
        if (IN(pb + 4)) { PH_BEGIN(4) PHASE_VIEWS();
#pragma unroll 1
            for (int it = bxp; it < 256; it += Gp) { const int tidu = opaque_v(MK_TID()); const LaneIx LX = lane_ix(tidu); cmp_unit(W, lds, it, tidu, wave, LX); }
            key_norms(W, gw, NGW, lane);
            __syncthreads();
        PH_END(4) }
        SEAM(pb + 4);
        if (IN(pb + 5)) { PH_BEGIN(5) PHASE_VIEWS();
#pragma unroll 1
            for (int it = bxp; it < 256; it += Gp) { const int tidu = opaque_v(MK_TID()); const LaneIx LX = lane_ix(tidu); nsa_unit(W, lds, ((it & 7) << 5) | ((it >> 3) & 31), tidu, wave, LX); }
            gu32* qhead = (gu32*)(W.ws + WS_CTL) + CW_QUEUE + 64 * opaque_s(l);
            volatile LAS int* qslot = (volatile LAS int*)(lds + MISC_OFF + 64);
#pragma unroll 1
            for (;;) {
                __syncthreads();
                if (MK_TID() == 0) *qslot = (int)__hip_atomic_fetch_add(qhead, 1u, RLX_AGENT);
                __syncthreads();
                int it = __builtin_amdgcn_readfirstlane(*qslot);
                const int ncv = (l + 1 < DEPTH) ? NCONVQ : 0;
                if (it >= ncv + 512 + 1536) break;
                const int tidu = opaque_v(MK_TID());
                if (it < ncv) { const LayerW LN = layer_w(kp, opaque_s(l + 1)); convert_layer<1>(LN, W, lds, it, NCONVQ, tidu); continue; }
                it -= ncv;
                const LaneIx LX = lane_ix(tidu);
                if (it < 512) mem_unit(W, lds, it, tidu, wave, LX); else dil_unit(W, lds, it - 512, tidu, wave, LX);
            }
            __syncthreads();
        PH_END(5) }
        SEAM(pb + 5);
        if (IN(pb + 6)) { PH_BEGIN(6) PHASE_VIEWS();
            dil_merge(W, bxp * NTHREADS + tid, Gp * NTHREADS);
            { pg8::Gemm g{W.YA(), W.wupa(), T, D, 768}; pg8::StaticOrder S; S.init(T, D, Gp, bxp); pg8::EpiBf16 E{W.P(), D, 1 << 30, 0, nullptr, 0, nullptr}; pg8::gemm_phase<pg8::EpiBf16, pg8::StaticOrder, true, true>(lds, g, S, E, tid); }
            { pg8::Gemm g{W.YM(), W.wupm(), T, D, 512}; pg8::StaticOrder S; S.init(T, D, Gp, bxp); pg8::EpiBf16 E{W.P() + (size_t)2 * T * D, D, 1 << 30, 0, nullptr, 0, nullptr}; pg8::gemm_phase<pg8::EpiBf16, pg8::StaticOrder, true, true>(lds, g, S, E, tid); }
        PH_END(6) }
        SEAM(pb + 6);
        if (IN(pb + 7)) { PH_BEGIN(7) PHASE_VIEWS();
            { pg8::Gemm g{W.YB(), W.wupb(), T, D, 256}; pg8::StaticOrder S; S.init(T, D, Gp, bxp); pg8::EpiBf16 E{W.P() + (size_t)T * D, D, 1 << 30, 0, nullptr, 0, nullptr}; pg8::gemm_phase<pg8::EpiBf16, pg8::StaticOrder, true, true>(lds, g, S, E, tid); }
        PH_END(7) }
        SEAM(pb + 7);
        if (IN(pb + 8)) { PHASE_VIEWS(); pg8::Gemm g{(const bf16*)outp, W.wgate(), T, 3 * D, D}; pg8::OrderTriple S; S.init(T, D, Gp, bxp); pg8::EpiGateMerge E{W.P(), (size_t)T * D, D, W.RS()};
            pg8::gemm_phase<pg8::EpiGateMerge, pg8::OrderTriple, true, true>(lds, g, S, E, tid); }
        SEAM(pb + 8);
        if (IN(pb + 9)) { PH_BEGIN(9) PHASE_VIEWS(); pg8::Gemm g{W.P(), W.wout(), T, D, D}; pg8::StaticOrder S; S.init(T, D, Gp, bxp); pg8::EpiBf16 E{W.F(), D, 1 << 30, 0, nullptr, 0, nullptr};
            pg8::gemm_phase<pg8::EpiBf16, pg8::StaticOrder, true, true>(lds, g, S, E, tid); PH_END(9) }
        SEAM(pb + 9);
        if (IN(pb + 10)) { PHASE_VIEWS(); const LayerW LW = layer_w(kp, opaque_s(l));
            norm_phase_res<false, false>((const bf16*)outp, W.F(), LW.mixpost, 1.0f, W.HB(), W.RS(), gw, NGW, lane);
        }
        SEAM(pb + 10);
        if (IN(pb + 11)) { PH_BEGIN(11) PHASE_VIEWS(); const bool split = (MK_ONE_LAUNCH != 0) && Gp == 256;
            pg8::Gemm g{W.HB(), W.wgu2(), T, 2 * FF, D}; pg8::StaticOrder S; S.init(T, split ? 42 * 256 : 2 * FF, Gp, bxp); pg8::EpiSwiGLU E{W.HID(), FF, W.RS()};
            pg8::gemm_phase<pg8::EpiSwiGLU, pg8::StaticOrder, true, true>(lds, g, S, E, tid);
            if (split) { const int kh = (bxp >> 3) & 1; auto barf = [&]() { GRID_BAR(); };
                pg8::Gemm g2{W.HB() + kh * 1024, W.wgu2() + kh * 1024, T, 2 * FF, 1024, D}; pg8::OrderOne S2{((bxp >> 4) << 3) | (bxp & 7), 42};
                pg8::EpiSwiGLUPair<decltype(barf)> E2{W.HID(), FF, W.RS(), (float*)W.U(), kh, barf};
                pg8::gemm_phase<pg8::EpiSwiGLUPair<decltype(barf)>, pg8::OrderOne, true, true>(lds, g2, S2, E2, tid); }
            PH_END(11) }
        SEAM(pb + 11);
        if (IN(pb + 12)) { PH_BEGIN(12) PHASE_VIEWS(); pg8::Gemm g{W.HID(), W.wd2(), T, D, FF}; pg8::StaticOrder S; S.init(T, D, Gp, bxp, 2); S.rev = 1; pg8::EpiBf16 E{W.F(), D, 1 << 30, 0, nullptr, 0, nullptr};
            pg8::gemm_phase<pg8::EpiBf16, pg8::StaticOrder, true, true>(lds, g, S, E, tid); PH_END(12) }
        SEAM(pb + 12);
        if (IN(pb + 13)) { PHASE_VIEWS(); const LayerW LW = layer_w(kp, opaque_s(l));
            const bool more = (l + 1 < DEPTH);
            const LayerW LN = layer_w(kp, opaque_s(more ? l + 1 : l));
            if (more) norm_phase_res<false, false>(W.HB(), W.F(), LW.f2post, 0.5f, (bf16*)outp, W.RS(), gw, NGW, lane);
            else norm_phase_res<false, true>(W.HB(), W.F(), LW.f2post, 0.5f, outp, nullptr, gw, NGW, lane);
            if (more) { __syncthreads(); convert_layer<2>(LN, W, lds, bxp, Gp, tid); }
        }
        SEAM(pb + 13);
    }
#undef IN
#undef SEAM
}

extern "C" void kernel_launch(void* const* d_in, const int* in_sizes, int n_in, void* d_out, int out_size, void* d_ws, size_t ws_size, hipStream_t stream) {
    static int grid = 0;
    if (grid == 0) {
        if (n_in != 27 || in_sizes[0] != T * D || out_size != T * D || ws_size < WS_END) { fprintf(stderr, "kernel_launch: unexpected shapes (n_in %d, in0 %d, out %d, ws %zu, need %zu); nothing launched\n", n_in, n_in > 0 ? in_sizes[0] : -1, out_size, ws_size, (size_t)WS_END); grid = -1; return; }
        int dev = 0, cus = 0, per_cu = 0;
        if (hipGetDevice(&dev) != hipSuccess || hipDeviceGetAttribute(&cus, hipDeviceAttributeMultiprocessorCount, dev) != hipSuccess) { grid = -1; return; }
        if (hipFuncSetAttribute((const void*)mk_fwd, hipFuncAttributeMaxDynamicSharedMemorySize, LDS_BYTES) != hipSuccess) { fprintf(stderr, "kernel_launch: hipFuncSetAttribute failed\n"); grid = -1; return; }
        if (hipOccupancyMaxActiveBlocksPerMultiprocessor(&per_cu, (const void*)mk_fwd, NTHREADS, LDS_BYTES) != hipSuccess || per_cu < 1) fprintf(stderr, "kernel_launch: note: occupancy query reports %d\n", per_cu);
        (void)hipGetLastError();
        grid = cus;
    }
    if (grid < 0) return;
    if (hipMemsetAsync((char*)d_ws + WS_CTL, 0, CTL_ZERO_BYTES, stream) != hipSuccess) return;
    Args a{};
    for (int i = 0; i < 27; ++i) a.in[i] = (const float*)d_in[i];
    a.out = (float*)d_out; a.ws = (unsigned char*)d_ws;
#if MK_ONE_LAUNCH
    a.ph_lo = 0; a.ph_hi = NPH;
    hipLaunchKernelGGL(mk_fwd, dim3(grid), dim3(NTHREADS), LDS_BYTES, stream, a);
#else
    for (int p = 0; p < NPH; ++p) { a.ph_lo = p; a.ph_hi = p + 1; const int reps = ((p >= 1 && ((PROBE_MASK >> ((p - 1) % NPL)) & 1)) || (p == 0 && ((PROBE_MASK >> 13) & 1))) ? 2 : 1;
        for (int r = 0; r < reps; ++r) hipLaunchKernelGGL(mk_fwd, dim3(grid), dim3(NTHREADS), LDS_BYTES, stream, a); }
#endif
}
```

```cpp
#include <hip/hip_runtime.h>
#include <cstdio>
#include <cstdint>

#ifndef MK_ONE_LAUNCH
#define MK_ONE_LAUNCH 1
#endif

namespace pg8 {
#define PG8_LAS __attribute__((address_space(3)))
typedef unsigned short bf16_t;
typedef short bf16x8 __attribute__((ext_vector_type(8)));
typedef float f32x4 __attribute__((ext_vector_type(4)));
typedef unsigned u32x4 __attribute__((ext_vector_type(4)));
constexpr int BM = 256, BK = 64, HALF = 128, HTB = HALF * BK * 2  , STAGE_BYTES = 8 * HTB, NXCD = 8;

__host__ __device__ __forceinline__ int lds_byte(int r, int c) { const int st = (r >> 4) * 2 + (c >> 5), rr = r & 15, cc = c & 31, ob = rr * 64 + cc * 2; return st * 1024 + (ob ^ (((ob >> 9) & 1) << 5)); }
__host__ __device__ __forceinline__ void stage_rc(int b, int& R, int& C) { const int st = b / 1024, sb = b % 1024, swz = sb ^ (((sb >> 9) & 1) << 5); R = (st >> 1) * 16 + swz / 64; C = (st & 1) * 32 + (swz % 64) / 2; }
__host__ __device__ __forceinline__ int perm32(int rho) { const int n = rho >> 4, i = rho & 15; return 8 * (i >> 2) + 4 * n + (i & 3); }

struct Unit { int pm, pn; };
struct Gemm { const bf16_t* A; const bf16_t* Bt; int M, N, K; };

struct StaticOrder {
    int nM, nN, nwg, G, c, WGM, rev;
    __host__ __device__ void init(int M, int N, int G_, int c_, int wgm = 4) { nM = M / BM; nN = N / BM; nwg = nM * nN; G = G_; c = c_; WGM = wgm; rev = 0; }
    __host__ __device__ bool map(long L, Unit& u) const {
        if (L >= nwg) return false;
        int wgid = (int)L; { const int q = nwg / NXCD, r = nwg % NXCD, xcd = wgid % NXCD, off = wgid / NXCD; wgid = (xcd < r ? xcd * (q + 1) : r * (q + 1) + (xcd - r) * q) + off; }
        const int nig = WGM * nN, gid = wgid / nig, fm = gid * WGM, gsz = (nM - fm) < WGM ? (nM - fm) : WGM;
        u.pm = fm + ((wgid % nig) % gsz); u.pn = (wgid % nig) / gsz; if (rev) u.pm = nM - 1 - u.pm; return true;
    }
    __host__ __device__ bool next(int i, Unit& u) const { return map((long)i * G + c, u); }
    __device__ __forceinline__ void a_ready(const Unit&) const {}
    __device__ __forceinline__ void done(const Unit&) const {}
};
template <class Epi, class Sched, bool ALIGN_EPI = false, bool SP2 = false>
__device__ __forceinline__ void gemm_phase(PG8_LAS unsigned char* lds, const Gemm g, const Sched& S, const Epi& E, int tid_in) {
    int tid_ = tid_in; asm volatile("" : "+v"(tid_));
    const int tid = tid_, wid = __builtin_amdgcn_readfirstlane(tid >> 6), lane = tid & 63, wr = wid >> 2, wc = wid & 3, fr = lane & 15, fq = lane >> 4;
    const int K = g.K, nt = K / BK;
    unsigned voffA[2], voffB[2];
#pragma unroll
    for (int i = 0; i < 2; ++i) { int R, C; stage_rc(tid * 16 + i * 8192, R, C); const int Rb = Epi::PERM ? ((R & ~31) + perm32(R & 31)) : R;
        voffA[i] = (unsigned)(R * K + C) * 2u; voffB[i] = (unsigned)(Rb * K + C) * 2u; }
    const size_t kstep = (size_t)(BK * 2);
    const size_t hstep = (size_t)HALF * K * 2;
    const size_t tstep = 2 * hstep;
    const unsigned ldsw = (unsigned)wid * 1024u;
    const int aoff = lds_byte(wr * 64 + fr, fq * 8), boff = lds_byte(wc * 32 + fr, fq * 8);
#define PG8_SA(b, h) (((b) * 2 + (h)) * HTB)
#define PG8_SB(b, h) ((4 + (b) * 2 + (h)) * HTB)
#define PG8_STAGE(bufoff, gbase, voff) do { _Pragma("unroll") for (int _i = 0; _i < 2; ++_i) \
        __builtin_amdgcn_global_load_lds((const unsigned*)((const char*)(gbase) + (voff)[_i]), (PG8_LAS unsigned*)(lds + (bufoff) + ldsw + _i * 8192), 16, 0, 0); } while (0)
#define PG8_LDA(dst, b, h) do { _Pragma("unroll") for (int m = 0; m < 4; ++m) _Pragma("unroll") for (int k = 0; k < 2; ++k) dst[m][k] = *(const PG8_LAS bf16x8*)(lds + PG8_SA(b, h) + aoff + m * 2048 + k * 1024); } while (0)
#define PG8_LDB(dst, b, h) do { _Pragma("unroll") for (int n = 0; n < 2; ++n) _Pragma("unroll") for (int k = 0; k < 2; ++k) dst[n][k] = *(const PG8_LAS bf16x8*)(lds + PG8_SB(b, h) + boff + n * 2048 + k * 1024); } while (0)
#define PG8_MMA(ai, bj, At, Bt) do { __builtin_amdgcn_s_setprio(1); _Pragma("unroll") for (int m = 0; m < 4; ++m) _Pragma("unroll") for (int n = 0; n < 2; ++n) _Pragma("unroll") for (int k = 0; k < 2; ++k) \
        acc[ai][bj][m][n] = __builtin_amdgcn_mfma_f32_16x16x32_bf16(Bt[n][k], At[m][k], acc[ai][bj][m][n], 0, 0, 0); __builtin_amdgcn_s_setprio(0); } while (0)
#define PG8_WAIT_V(n) asm volatile("s_waitcnt vmcnt(" #n ")" ::: "memory")
#define PG8_WAIT_L(n) asm volatile("s_waitcnt lgkmcnt(" #n ")" ::: "memory")
#define PG8_BAR __builtin_amdgcn_s_barrier()
#define PG8_SCHED __builtin_amdgcn_sched_barrier(0)
    Unit cur, nxt; int ui = 0;
    if (!S.next(0, cur)) return;
    f32x4 acc[2][2][4][2];
#pragma unroll
    for (int a = 0; a < 2; ++a)
#pragma unroll
        for (int b = 0; b < 2; ++b)
#pragma unroll
            for (int m = 0; m < 4; ++m)
#pragma unroll
                for (int n = 0; n < 2; ++n) acc[a][b][m][n] = (f32x4){0.f, 0.f, 0.f, 0.f};
    bf16x8 At[4][2], B0[2][2], B1[2][2];
    const char* cA = (const char*)g.A + (size_t)cur.pm * tstep; const char* cB = (const char*)g.Bt + (size_t)cur.pn * tstep;
    S.a_ready(cur);
    if constexpr (SP2) {
        PG8_STAGE(PG8_SB(0, 0), cB, voffB); PG8_STAGE(PG8_SB(0, 1), cB + hstep, voffB); PG8_STAGE(PG8_SA(0, 0), cA, voffA); PG8_STAGE(PG8_SA(0, 1), cA + hstep, voffA);
        if (wr == 1) PG8_BAR;
        PG8_WAIT_V(2); PG8_BAR;
        PG8_STAGE(PG8_SB(1, 0), cB + kstep, voffB); PG8_STAGE(PG8_SA(1, 0), cA + kstep, voffA); PG8_STAGE(PG8_SB(1, 1), cB + hstep + kstep, voffB);
        PG8_WAIT_V(6); PG8_BAR;
    } else {
        PG8_STAGE(PG8_SB(0, 0), cB, voffB); PG8_STAGE(PG8_SA(0, 0), cA, voffA); PG8_STAGE(PG8_SB(0, 1), cB + hstep, voffB); PG8_STAGE(PG8_SA(0, 1), cA + hstep, voffA);
        if (wr == 1) PG8_BAR;
        PG8_WAIT_V(4); PG8_BAR;
        PG8_STAGE(PG8_SB(1, 0), cB + kstep, voffB); PG8_STAGE(PG8_SA(1, 0), cA + kstep, voffA); PG8_STAGE(PG8_SB(1, 1), cB + hstep + kstep, voffB);
        PG8_WAIT_V(6); PG8_BAR;
    }
    for (;;) {
        const bool has_next = S.next(ui + 1, nxt);
        const typename Epi::Pre pre = E.prefetch(cur, wr, fr);
        const char* nA = has_next ? (const char*)g.A + (size_t)nxt.pm * tstep : cA; const char* nB = has_next ? (const char*)g.Bt + (size_t)nxt.pn * tstep : cB;
        for (int t = 0; t < nt; t += 2) {
            const bool last = (t == nt - 2);
            const char* a1 = cA + (size_t)(t + 1) * kstep;
            const char* a2 = last ? nA : cA + (size_t)(t + 2) * kstep; const char* b2 = last ? nB : cB + (size_t)(t + 2) * kstep;
            const char* a3 = a2 + kstep; const char* b3 = b2 + kstep;
            if (last && has_next) S.a_ready(nxt);
            if constexpr (SP2) {
            PG8_LDB(B0, 0, 0); PG8_LDB(B1, 0, 1); PG8_SCHED; PG8_LDA(At, 0, 0); PG8_STAGE(PG8_SA(1, 1), a1 + hstep, voffA);
            PG8_WAIT_V(8); PG8_WAIT_L(0); PG8_BAR; PG8_MMA(0, 0, At, B0); PG8_MMA(0, 1, At, B1); PG8_BAR; PG8_SCHED;
            PG8_LDA(At, 0, 1); PG8_STAGE(PG8_SB(0, 0), b2, voffB); PG8_STAGE(PG8_SB(0, 1), b2 + hstep, voffB); PG8_STAGE(PG8_SA(0, 0), a2, voffA);
            PG8_WAIT_V(8); PG8_WAIT_L(0); PG8_BAR; PG8_MMA(1, 0, At, B0); PG8_MMA(1, 1, At, B1); PG8_BAR; PG8_SCHED;
            PG8_LDB(B0, 1, 0); PG8_LDB(B1, 1, 1); PG8_SCHED; PG8_LDA(At, 1, 0); PG8_STAGE(PG8_SA(0, 1), a2 + hstep, voffA);
            PG8_WAIT_V(8); PG8_WAIT_L(0); PG8_BAR; PG8_MMA(0, 0, At, B0); PG8_MMA(0, 1, At, B1); PG8_BAR; PG8_SCHED;
            PG8_LDA(At, 1, 1); PG8_STAGE(PG8_SB(1, 0), b3, voffB); PG8_STAGE(PG8_SB(1, 1), b3 + hstep, voffB); PG8_STAGE(PG8_SA(1, 0), a3, voffA);
            PG8_WAIT_V(8); PG8_WAIT_L(0); PG8_BAR; PG8_MMA(1, 0, At, B0); PG8_MMA(1, 1, At, B1); PG8_BAR; PG8_SCHED;
            } else {
            PG8_LDB(B0, 0, 0); PG8_SCHED; PG8_LDA(At, 0, 0); PG8_STAGE(PG8_SA(1, 1), a1 + hstep, voffA);
            PG8_WAIT_L(8); PG8_BAR; PG8_WAIT_L(0); PG8_MMA(0, 0, At, B0); PG8_BAR; PG8_SCHED;
            PG8_LDB(B1, 0, 1); PG8_STAGE(PG8_SB(0, 0), b2, voffB);
            PG8_BAR; PG8_WAIT_L(0); PG8_MMA(0, 1, At, B1); PG8_BAR;
            PG8_LDA(At, 0, 1); PG8_STAGE(PG8_SA(0, 0), a2, voffA);
            PG8_BAR; PG8_WAIT_L(0); PG8_MMA(1, 0, At, B0); PG8_BAR; PG8_SCHED;
            PG8_STAGE(PG8_SB(0, 1), b2 + hstep, voffB);
            PG8_WAIT_V(6); PG8_BAR; PG8_MMA(1, 1, At, B1); PG8_BAR;
            PG8_LDB(B0, 1, 0); PG8_SCHED; PG8_LDA(At, 1, 0); PG8_STAGE(PG8_SA(0, 1), a2 + hstep, voffA);
            PG8_WAIT_L(8); PG8_BAR; PG8_WAIT_L(0); PG8_MMA(0, 0, At, B0); PG8_BAR; PG8_SCHED;
            PG8_LDB(B1, 1, 1); PG8_STAGE(PG8_SB(1, 0), b3, voffB);
            PG8_BAR; PG8_WAIT_L(0); PG8_MMA(0, 1, At, B1); PG8_BAR;
            PG8_LDA(At, 1, 1); PG8_STAGE(PG8_SA(1, 0), a3, voffA);
            PG8_BAR; PG8_WAIT_L(0); PG8_MMA(1, 0, At, B0); PG8_BAR; PG8_SCHED;
            PG8_STAGE(PG8_SB(1, 1), b3 + hstep, voffB);
            PG8_WAIT_V(6); PG8_BAR; PG8_MMA(1, 1, At, B1); PG8_BAR;
            }
        }
        if constexpr (ALIGN_EPI) { if (wr == 0) PG8_BAR; }
        if constexpr (!Epi::AFTER_DRAIN) { E(acc, cur, wr, wc, fr, fq, pre); S.done(cur); }
        if (!has_next) break;
#pragma unroll
        for (int a = 0; a < 2; ++a)
#pragma unroll
            for (int b = 0; b < 2; ++b)
#pragma unroll
                for (int m = 0; m < 4; ++m)
#pragma unroll
                    for (int n = 0; n < 2; ++n) acc[a][b][m][n] = (f32x4){0.f, 0.f, 0.f, 0.f};
        cur = nxt; cA = nA; cB = nB; ++ui;
        if constexpr (ALIGN_EPI) { if (wr == 1) PG8_BAR; }
    }
    PG8_WAIT_V(0);
    if constexpr (!ALIGN_EPI) { if (wr == 0) PG8_BAR; }
    PG8_BAR;
    if constexpr (Epi::AFTER_DRAIN) { E.fused(acc, cur, wr, wc, fr, fq, lds, wid, lane); S.done(cur); }
#undef PG8_SA
#undef PG8_SB
#undef PG8_STAGE
#undef PG8_LDA
#undef PG8_LDB
#undef PG8_MMA
#undef PG8_WAIT_V
#undef PG8_WAIT_L
#undef PG8_BAR
#undef PG8_SCHED
}
__device__ __forceinline__ unsigned cvt_pk_bf16(float lo, float hi) { typedef __bf16 bf2 __attribute__((ext_vector_type(2))); bf2 v; v[0] = (__bf16)lo; v[1] = (__bf16)hi; return __builtin_bit_cast(unsigned, v); }
__device__ __forceinline__ float bf_lo(unsigned w) { return __builtin_bit_cast(float, w << 16); }
__device__ __forceinline__ float bf_hi(unsigned w) { return __builtin_bit_cast(float, w & 0xffff0000u); }
__device__ __forceinline__ float sigmoid_f(float x) { return __builtin_amdgcn_rcpf(1.0f + __builtin_amdgcn_exp2f(-1.4426950408889634f * x)); }

struct RowScale { float r[2][4]; };
__device__ __forceinline__ RowScale load_row_scale(const float* R, int row0) { RowScale p;
#pragma unroll
    for (int ai = 0; ai < 2; ++ai)
#pragma unroll
        for (int m = 0; m < 4; ++m) p.r[ai][m] = R ? R[row0 + ai * HALF + m * 16] : 1.0f;
    return p; }
struct EpiBf16 {
    static constexpr bool PERM = true, AFTER_DRAIN = false;
    bf16_t* O; int ldc; int pm_split, pn_split; bf16_t* O2; int ldc2; const float* R;
    typedef RowScale Pre;
    __device__ __forceinline__ Pre prefetch(const Unit& u, int wr, int fr) const { return load_row_scale(R, u.pm * BM + wr * 64 + fr); }
    __device__ __forceinline__ void operator()(const f32x4 (&acc)[2][2][4][2], const Unit& u, int wr, int wc, int fr, int fq, const Pre& pre) const {
        bf16_t* base = O; int ld = ldc, pm = u.pm, pn = u.pn;
        if (pm >= pm_split) { base = O2; ld = ldc2; pm -= pm_split; pn -= pn_split; }
        const int row0 = pm * BM + wr * 64 + fr, col0 = pn * BM + wc * 32 + 8 * fq;
#pragma unroll
        for (int ai = 0; ai < 2; ++ai)
#pragma unroll
            for (int m = 0; m < 4; ++m) { bf16_t* rowp = base + (size_t)(row0 + ai * HALF + m * 16) * ld + col0;
#pragma unroll
                for (int bj = 0; bj < 2; ++bj) { const f32x4 v0 = acc[ai][bj][m][0] * pre.r[ai][m], v1 = acc[ai][bj][m][1] * pre.r[ai][m];
                    u32x4 w; w.x = cvt_pk_bf16(v0[0], v0[1]); w.y = cvt_pk_bf16(v0[2], v0[3]); w.z = cvt_pk_bf16(v1[0], v1[1]); w.w = cvt_pk_bf16(v1[2], v1[3]);
                    *(u32x4*)(rowp + bj * HALF) = w; } }
    }
};
struct EpiSwiGLU {
    static constexpr bool PERM = true, AFTER_DRAIN = false;
    bf16_t* O; int ldc; const float* R;
    typedef RowScale Pre;
    __device__ __forceinline__ Pre prefetch(const Unit& u, int wr, int fr) const { return load_row_scale(R, u.pm * BM + wr * 64 + fr); }
    __device__ __forceinline__ void operator()(const f32x4 (&acc)[2][2][4][2], const Unit& u, int wr, int wc, int fr, int fq, const Pre& pre) const {
        const int row0 = u.pm * BM + wr * 64 + fr, col0 = u.pn * HALF + wc * 32 + 8 * fq;
#pragma unroll
        for (int ai = 0; ai < 2; ++ai)
#pragma unroll
            for (int m = 0; m < 4; ++m) { bf16_t* rowp = O + (size_t)(row0 + ai * HALF + m * 16) * ldc + col0;
                float o[8];
#pragma unroll
                for (int n = 0; n < 2; ++n)
#pragma unroll
                    for (int j = 0; j < 4; ++j) { const float g = acc[ai][0][m][n][j] * pre.r[ai][m], up = acc[ai][1][m][n][j] * pre.r[ai][m]; o[4 * n + j] = g * sigmoid_f(g) * up; }
                u32x4 w; w.x = cvt_pk_bf16(o[0], o[1]); w.y = cvt_pk_bf16(o[2], o[3]); w.z = cvt_pk_bf16(o[4], o[5]); w.w = cvt_pk_bf16(o[6], o[7]);
                *(u32x4*)rowp = w; }
    }
};
struct EpiGateMerge {
    static constexpr bool PERM = true, AFTER_DRAIN = false;
    bf16_t* P; size_t pstride; int ldc; const float* R;
    typedef RowScale Pre;
    __device__ __forceinline__ Pre prefetch(const Unit& u, int wr, int fr) const { return load_row_scale(R, u.pm * BM + wr * 64 + fr); }
    __device__ __forceinline__ void operator()(const f32x4 (&acc)[2][2][4][2], const Unit& u, int wr, int wc, int fr, int fq, const Pre& pre) const {
        const int x = u.pn >> 3, pt = u.pn & 7;
        const int row0 = u.pm * BM + wr * 64 + fr, col0 = pt * BM + wc * 32 + 8 * fq;
        const bf16_t* Px = P + (size_t)x * pstride;
#pragma unroll
        for (int ai = 0; ai < 2; ++ai) {
            u32x4 pw[4][2], mw[4][2];
#pragma unroll
            for (int m = 0; m < 4; ++m)
#pragma unroll
                for (int bj = 0; bj < 2; ++bj) { const size_t off = (size_t)(row0 + ai * HALF + m * 16) * ldc + col0 + bj * HALF;
                    pw[m][bj] = *(const u32x4*)(Px + off); mw[m][bj] = (u32x4){0u, 0u, 0u, 0u}; if (x > 0) mw[m][bj] = *(const u32x4*)(P + off); }
#pragma unroll
            for (int m = 0; m < 4; ++m)
#pragma unroll
                for (int bj = 0; bj < 2; ++bj) { const size_t off = (size_t)(row0 + ai * HALF + m * 16) * ldc + col0 + bj * HALF;
                    const f32x4 v0 = acc[ai][bj][m][0] * pre.r[ai][m], v1 = acc[ai][bj][m][1] * pre.r[ai][m]; const u32x4 p = pw[m][bj], q = mw[m][bj];
                    float o[8];
                    o[0] = sigmoid_f(v0[0]) * bf_lo(p.x) + bf_lo(q.x); o[1] = sigmoid_f(v0[1]) * bf_hi(p.x) + bf_hi(q.x); o[2] = sigmoid_f(v0[2]) * bf_lo(p.y) + bf_lo(q.y); o[3] = sigmoid_f(v0[3]) * bf_hi(p.y) + bf_hi(q.y);
                    o[4] = sigmoid_f(v1[0]) * bf_lo(p.z) + bf_lo(q.z); o[5] = sigmoid_f(v1[1]) * bf_hi(p.z) + bf_hi(q.z); o[6] = sigmoid_f(v1[2]) * bf_lo(p.w) + bf_lo(q.w); o[7] = sigmoid_f(v1[3]) * bf_hi(p.w) + bf_hi(q.w);
                    u32x4 w; w.x = cvt_pk_bf16(o[0], o[1]); w.y = cvt_pk_bf16(o[2], o[3]); w.z = cvt_pk_bf16(o[4], o[5]); w.w = cvt_pk_bf16(o[6], o[7]);
                    *(u32x4*)(P + off) = w; }
        }
    }
};
struct OrderPlusExtra : StaticOrder {
    int nextra, pm0, pn0, ncx;
    __device__ bool next(int i, Unit& u) const { const long L = (long)i * G + c; if (L < nwg) return map(L, u);
        const long e = L - nwg; if (e >= nextra) return false; u.pm = pm0 + (int)(e / ncx); u.pn = pn0 + (int)(e % ncx); return true; }
};
struct OrderTriple : StaticOrder {
    __device__ bool next(int i, Unit& u) const { const int i3 = i / 3, x = i - 3 * i3; if (!map((long)i3 * G + c, u)) return false; u.pn += 8 * x; return true; }
};
}
constexpr int D = 2048, BATCH = 2, SEQ = 16384, T = BATCH * SEQ, DEPTH = 2, MEML = 256, FF = 5504;
constexpr int TM = T + BATCH * MEML;
constexpr int NIN = 11282;
constexpr float EPS = 1e-6f;
constexpr float LOG2E = 1.4426950408889634f;
constexpr int QP = 5376;
constexpr int C_QA = 0, C_KC = 768, C_VC = 1024, C_KS = 1280, C_VS = 1536, C_KW = 1792, C_VW = 2048, C_QB = 2304, C_KB = 3072, C_VB = 3840, C_QM = 4608, C_GN = 5120;
constexpr int SRC_GN = 2304, SRC_QB = 2322, SRC_GATES = 5138;
constexpr int NWIN = QP + 1024;
constexpr int NCMP = 1023;

constexpr size_t MiB = 1u << 20;
constexpr size_t WS_CTL = 0, CTL_ZERO_BYTES = 1 * MiB;
constexpr size_t SZ_WGU = (size_t)2 * FF * D * 2, SZ_WD = (size_t)D * FF * 2;
constexpr size_t WS_WGU1 = 1 * MiB, WS_WD1 = WS_WGU1 + SZ_WGU, WS_WGU2 = WS_WD1 + SZ_WD, WS_WD2 = WS_WGU2 + SZ_WGU;
constexpr size_t WS_WIN = WS_WD2 + SZ_WD, WS_WGATE = WS_WIN + (size_t)NWIN * D * 2;
constexpr size_t WS_WC1K = WS_WGATE + (size_t)3 * D * D * 2, WS_WC1V = WS_WC1K + 2 * MiB, WS_WC2K = WS_WC1V + 2 * MiB, WS_WC2V = WS_WC2K + 65536;
constexpr size_t WS_CBIAS = WS_WC2V + 65536;
constexpr size_t WS_WUPA = WS_CBIAS + 65536, WS_WUPB = WS_WUPA + (size_t)D * 768 * 2, WS_WUPM = WS_WUPB + (size_t)D * 256 * 2, WS_WOUT = WS_WUPM + (size_t)D * 512 * 2;
constexpr size_t WS_U = WS_WOUT + (size_t)D * D * 2;
constexpr size_t WS_R2 = WS_U + (size_t)TM * D * 2;
constexpr size_t WS_F = WS_R2;
constexpr size_t WS_HID = WS_F + (size_t)T * D * 2;
constexpr size_t WS_YA = WS_HID, WS_YB = WS_YA + (size_t)T * 768 * 2, WS_YM = WS_YB + (size_t)T * 256 * 2;
constexpr size_t WS_MEMKV = WS_YM + (size_t)T * 512 * 2;
constexpr size_t WS_KCMP = WS_MEMKV + 1 * MiB, WS_VCMP = WS_KCMP + 1 * MiB;
constexpr size_t WS_DILL = WS_VCMP + 1 * MiB;
constexpr size_t WS_P = WS_DILL + 2 * MiB;
constexpr size_t WS_DILO = WS_P;
constexpr size_t WS_QKV = WS_DILO + (size_t)3 * T * 256 * 2;
constexpr size_t WS_QKV_END = WS_QKV + (size_t)(T + 64) * QP * 2;
constexpr size_t WS_P_END = WS_P + (size_t)3 * T * D * 2;
constexpr size_t WS_HID_END = WS_HID + (size_t)T * FF * 2;
constexpr size_t WS_HB = WS_HID_END;
static_assert(WS_HB + (size_t)T * D * 2 <= WS_P_END, "WS_HB must fit in the dead P region");
constexpr size_t WS_END = (WS_QKV_END > WS_P_END ? (WS_QKV_END > WS_HID_END ? WS_QKV_END : WS_HID_END) : (WS_P_END > WS_HID_END ? WS_P_END : WS_HID_END));
static_assert(WS_END < (size_t)1040 * MiB, "workspace map exceeds the guaranteed d_ws size");
constexpr int CW_TMO = 0;
constexpr int CW_BAR = 4096;
constexpr int CW_QUEUE = 16384;
constexpr size_t WS_KNS = WS_CTL + 262144;
constexpr size_t WS_RS = WS_CTL + 524288;
constexpr size_t WS_KNC = WS_KNS + 16384;

constexpr int NWAVES = 8, NTHREADS = NWAVES * 64;
constexpr int RING_BYTES = 131072;
constexpr int LDSCTL_OFF = 145408, MISC_OFF = LDSCTL_OFF + 320;
constexpr int LDS_BYTES = 147456;

#define GAS __attribute__((address_space(1)))
#define LAS __attribute__((address_space(3)))
#define DI __device__ __forceinline__
typedef unsigned short bf16;
typedef unsigned v4u __attribute__((ext_vector_type(4)));
typedef unsigned v2u __attribute__((ext_vector_type(2)));
typedef float f32x4 __attribute__((ext_vector_type(4)));
typedef float f32x16 __attribute__((ext_vector_type(16)));
typedef short bf16x8 __attribute__((ext_vector_type(8)));
typedef short s16x4 __attribute__((ext_vector_type(4)));
typedef GAS unsigned gu32;
#define RLX_AGENT __ATOMIC_RELAXED, __HIP_MEMORY_SCOPE_AGENT
#define LDS_WAIT() asm volatile("s_waitcnt lgkmcnt(0)" ::: "memory")
#define VM_WAIT() asm volatile("s_waitcnt vmcnt(0)" ::: "memory")
DI unsigned pk2(float lo, float hi) { return pg8::cvt_pk_bf16(lo, hi); }
DI float bflo(unsigned w) { return __builtin_bit_cast(float, w << 16); }
DI float bfhi(unsigned w) { return __builtin_bit_cast(float, w & 0xffff0000u); }
DI float bf2f(bf16 v) { return __builtin_bit_cast(float, (unsigned)v << 16); }
DI float ex2(float x) { return __builtin_amdgcn_exp2f(x); }
DI float sigm(float x) { return __builtin_amdgcn_rcpf(1.0f + ex2(-LOG2E * x)); }
DI float wave_sum(float v) {
#pragma unroll
    for (int o = 1; o < 64; o <<= 1) v += __shfl_xor(v, o);
    return v;
}
DI unsigned char* opaque_p(unsigned char* p) { unsigned long long v = (unsigned long long)p; unsigned lo = (unsigned)v, hi = (unsigned)(v >> 32); asm volatile("" : "+s"(lo), "+s"(hi)); return (unsigned char*)(((unsigned long long)hi << 32) | lo); }
DI int opaque_v(int v) { asm volatile("" : "+v"(v)); return v; }
DI int opaque_s(int v) { asm volatile("" : "+s"(v)); return v; }
DI int lane_id_v() { int l; asm volatile("v_mbcnt_lo_u32_b32 %0, -1, 0\n\tv_mbcnt_hi_u32_b32 %0, -1, %0" : "=&v"(l)); return l; }
typedef float f32x2g __attribute__((ext_vector_type(2)));
template <class F, class R>
DI void conv_matrix2(F colptr, R drow, int pitch, int K, int nrows, bf16* WT, LAS float* scr, int bx, int G, int tid, const float* gain = nullptr) {
    const int nkb = K / 64, nnb = nrows / 128, nitems = nnb * nkb, wave = tid >> 6, lane = tid & 63;
    f32x2g v[8], w[8], x2[8], y2[8];
    auto issue = [&](int item, f32x2g (&dst)[8]) { const int kb = item / nnb, nb = item - kb * nnb; const float* cp = colptr(128 * nb + 2 * lane);
        const float* cq = cp ? cp : colptr(0);
#pragma unroll
        for (int i = 0; i < 8; ++i) { const f32x2g x = *(const GAS f32x2g*)(cq + (size_t)(64 * kb + 8 * wave + i) * pitch); dst[i] = cp ? x : (f32x2g){0.f, 0.f}; } };
    auto issue_c = [&](int item, f32x2g (&dst)[8]) { issue(item < nitems ? item : nitems - 1, dst); };
    int it = bx;
    if (it < nitems) { issue_c(it, v); issue_c(it + G, w); issue_c(it + 2 * G, x2); }
#pragma unroll 1
    for (; it < nitems; it += G) {
        issue_c(it + 3 * G, y2);
        __builtin_amdgcn_sched_barrier(0);
        const int kb = it / nnb, nb = it - kb * nnb, k0 = 64 * kb, d0 = drow(128 * nb);
#pragma unroll
        for (int i = 0; i < 8; ++i) { const float gk = gain ? gain[k0 + 8 * wave + i] : 1.0f;
            scr[(8 * wave + i) * 129 + 2 * lane] = v[i].x * gk; scr[(8 * wave + i) * 129 + 2 * lane + 1] = v[i].y * gk; }
        __syncthreads();
        const int c = lane & 7;
#pragma unroll
        for (int j = 0; j < 2; ++j) { const int n = 16 * wave + (lane >> 3) + 8 * j; const LAS float* s = scr + (8 * c) * 129 + n;
            v4u o; o.x = pk2(s[0 * 129], s[1 * 129]); o.y = pk2(s[2 * 129], s[3 * 129]); o.z = pk2(s[4 * 129], s[5 * 129]); o.w = pk2(s[6 * 129], s[7 * 129]);
            *(GAS v4u*)(WT + (size_t)(d0 + n) * K + k0 + 8 * c) = o; }
        __syncthreads();
#pragma unroll
        for (int i = 0; i < 8; ++i) { v[i] = w[i]; w[i] = x2[i]; x2[i] = y2[i]; }
    }
}
template <class F>
DI void conv_matrix(F colptr, int pitch, int K, int nrows, bf16* WT, LAS float* scr, int bx, int G, int tid, const float* gain = nullptr) { conv_matrix2(colptr, [](int n) { return n; }, pitch, K, nrows, WT, scr, bx, G, tid, gain); }

struct LayerW {
    const float *f1pre, *f1g, *f1u, *f1d, *f1post, *mixpre, *win, *pek, *pev, *c1k, *c2k, *c1v, *c2v, *memg, *wmkv, *wupa, *wupb, *wupm, *wout, *mixpost, *f2pre, *f2g, *f2u, *f2d, *f2post;
};
struct WsPtrs {
    unsigned char* ws;
#define WSP(name, type, off) DI type* name() const { return (type*)(ws + (off)); }
    WSP(wgu1, bf16, WS_WGU1) WSP(wd1, bf16, WS_WD1) WSP(wgu2, bf16, WS_WGU2) WSP(wd2, bf16, WS_WD2) WSP(win, bf16, WS_WIN) WSP(wgate, bf16, WS_WGATE)
    WSP(wc1k, bf16, WS_WC1K) WSP(wc1v, bf16, WS_WC1V) WSP(wc2k, bf16, WS_WC2K) WSP(wc2v, bf16, WS_WC2V) WSP(cbias, float, WS_CBIAS)
    WSP(wupa, bf16, WS_WUPA) WSP(wupb, bf16, WS_WUPB) WSP(wupm, bf16, WS_WUPM) WSP(wout, bf16, WS_WOUT)
    WSP(U, bf16, WS_U) WSP(F, bf16, WS_F) WSP(HID, bf16, WS_HID) WSP(HB, bf16, WS_HB) WSP(RS, float, WS_RS) WSP(YA, bf16, WS_YA) WSP(YB, bf16, WS_YB) WSP(YM, bf16, WS_YM)
    WSP(MEMKV, bf16, WS_MEMKV) WSP(KCMP, bf16, WS_KCMP) WSP(VCMP, bf16, WS_VCMP) WSP(P, bf16, WS_P) WSP(DILO, bf16, WS_DILO) WSP(QKV, bf16, WS_QKV) WSP(DILL, float, WS_DILL)
#undef WSP
};

template <int PART>
DI void convert_layer(const LayerW& L, const WsPtrs& W, LAS unsigned char* lds, int bx, int G, int tid) {
    LAS float* scr = (LAS float*)lds; const int wave = tid >> 6, lane = tid & 63, gw = bx * NWAVES + wave, NGW = G * NWAVES;
    if constexpr (PART != 2) {
    { const float* s = L.f1g; conv_matrix2([=](int r) { return s + r; }, [](int n) { return (n >> 7) * 256 + (n & 127); }, FF, D, FF, W.wgu1(), scr, bx, G, tid, L.f1pre); }
    { const float* s = L.f1u; conv_matrix2([=](int r) { return s + r; }, [](int n) { return (n >> 7) * 256 + (n & 127) + 128; }, FF, D, FF, W.wgu1(), scr, bx, G, tid, L.f1pre); }
    { const float* s = L.f1d; conv_matrix([=](int r) { return s + r; }, D, FF, D, W.wd1(), scr, bx, G, tid); }
    { const float* s = L.win; conv_matrix([=](int r) -> const float* { if (r < C_QB) return s + r; if (r < C_GN) return s + (r - C_QB + SRC_QB); if (r < C_GN + 18) return s + (r - C_GN + SRC_GN); return nullptr; }, NIN, D, QP, W.win(), scr, bx, G, tid, L.mixpre); }
    { const float* s = L.wmkv; conv_matrix([=](int r) { return s + r; }, 1024, D, 1024, W.win() + (size_t)QP * D, scr, bx, G, tid, L.memg); }
    { const float* s = L.c1k; conv_matrix([=](int r) { return s + r; }, 256, 4096, 256, W.wc1k(), scr, bx, G, tid); }
    { const float* s = L.c1v; conv_matrix([=](int r) { return s + r; }, 256, 4096, 256, W.wc1v(), scr, bx, G, tid); }
    { const float* s = L.c2k; conv_matrix([=](int r) { return s + r; }, 128, 256, 128, W.wc2k(), scr, bx, G, tid); }
    { const float* s = L.c2v; conv_matrix([=](int r) { return s + r; }, 128, 256, 128, W.wc2v(), scr, bx, G, tid); }
    }
    if constexpr (PART != 1) {
    { const float* s = L.f2g; conv_matrix2([=](int r) { return s + r; }, [](int n) { return (n >> 7) * 256 + (n & 127); }, FF, D, FF, W.wgu2(), scr, bx, G, tid, L.f2pre); }
    { const float* s = L.f2u; conv_matrix2([=](int r) { return s + r; }, [](int n) { return (n >> 7) * 256 + (n & 127) + 128; }, FF, D, FF, W.wgu2(), scr, bx, G, tid, L.f2pre); }
    { const float* s = L.f2d; conv_matrix([=](int r) { return s + r; }, D, FF, D, W.wd2(), scr, bx, G, tid); }
    { const float* s = L.win; conv_matrix([=](int r) { return s + SRC_GATES + r; }, NIN, D, 3 * D, W.wgate(), scr, bx, G, tid, L.mixpre); }
    { const float* s = L.wupa; conv_matrix([=](int r) { return s + r; }, D, 768, D, W.wupa(), scr, bx, G, tid); }
    { const float* s = L.wupb; conv_matrix([=](int r) { return s + r; }, D, 256, D, W.wupb(), scr, bx, G, tid); }
    { const float* s = L.wupm; conv_matrix([=](int r) { return s + r; }, D, 512, D, W.wupm(), scr, bx, G, tid); }
    { const float* s = L.wout; conv_matrix([=](int r) { return s + r; }, D, D, D, W.wout(), scr, bx, G, tid); }
    }
    if constexpr (PART != 2)
    for (int it = gw; it < 512; it += NGW) { const int which = it >> 8, hid = it & 255; const float* pe = which ? L.pev : L.pek; const float* w1 = which ? L.c1v : L.c1k;
        float a = 0.f;
#pragma unroll 8
        for (int i = 0; i < 64; ++i) { const int k = lane + 64 * i; a += pe[k] * w1[(size_t)k * 256 + hid]; }
        a = wave_sum(a);
        if (lane == 0) W.cbias()[which * 256 + hid] = a; }
}

DI void norm_phase_first(const float* xbase, bf16* ubase, float* rs, int nrows, int gw, int NGW, int lane) {
    f32x4 v[8], vn[8];
    auto issue = [&](int m, f32x4 (&d)[8]) { const GAS f32x4* xr = (const GAS f32x4*)(xbase + (size_t)m * D) + lane;
#pragma unroll
        for (int j = 0; j < 8; ++j) d[j] = xr[64 * j]; };
    int m = gw;
    if (m < nrows) issue(m, v);
#pragma unroll 1
    for (; m < nrows; m += NGW) {
        if (m + NGW < nrows) issue(m + NGW, vn);
        __builtin_amdgcn_sched_barrier(0);
        float s = 0.f;
#pragma unroll
        for (int j = 0; j < 8; ++j) s += (v[j].x * v[j].x + v[j].y * v[j].y) + (v[j].z * v[j].z + v[j].w * v[j].w);
        const float r = 1.0f / sqrtf(wave_sum(s) * (1.0f / D) + EPS);
        if (lane == 0) rs[m] = r;
        GAS v2u* o8 = (GAS v2u*)(ubase + (size_t)m * D) + lane;
#pragma unroll
        for (int j = 0; j < 8; ++j) { v2u o; o.x = pk2(v[j].x, v[j].y); o.y = pk2(v[j].z, v[j].w); o8[64 * j] = o; }
#pragma unroll
        for (int j = 0; j < 8; ++j) v[j] = vn[j];
    }
}
template <bool HIN_F32, bool HOUT_F32>
DI void norm_phase_res(const void* hin, const bf16* fbuf, const float* gpost, float cs, void* hout, float* rs, int gw, int NGW, int lane) {
    f32x4 h[HIN_F32 ? 8 : 1], hn[HIN_F32 ? 8 : 1], hn2[HIN_F32 ? 8 : 1]; v2u hb[HIN_F32 ? 1 : 8], hbn[HIN_F32 ? 1 : 8], hbn2[HIN_F32 ? 1 : 8]; v2u fw[8], fwn[8], fwn2[8];
    f32x4 gpv[8];
    { const GAS f32x4* gp = (const GAS f32x4*)gpost + lane;
#pragma unroll
      for (int j = 0; j < 8; ++j) gpv[j] = gp[64 * j]; }
    auto issue = [&](int m, f32x4 (&hd)[HIN_F32 ? 8 : 1], v2u (&hbd)[HIN_F32 ? 1 : 8], v2u (&fd)[8]) { const GAS v2u* fr = (const GAS v2u*)(fbuf + (size_t)m * D) + lane;
        if constexpr (HIN_F32) { const GAS f32x4* hr = (const GAS f32x4*)((const float*)hin + (size_t)m * D) + lane;
#pragma unroll
            for (int j = 0; j < 8; ++j) { hd[j] = __builtin_nontemporal_load(hr + 64 * j); fd[j] = __builtin_nontemporal_load(fr + 64 * j); } }
        else { const GAS v2u* hr = (const GAS v2u*)((const bf16*)hin + (size_t)m * D) + lane;
#pragma unroll
            for (int j = 0; j < 8; ++j) { hbd[j] = __builtin_nontemporal_load(hr + 64 * j); fd[j] = __builtin_nontemporal_load(fr + 64 * j); } } };
    int m = gw;
    if (m < T) issue(m, h, hb, fw);
    if (m + NGW < T) issue(m + NGW, hn, hbn, fwn);
#pragma unroll 1
    for (; m < T; m += NGW) {
        const int mn = m + 2 * NGW;
        if (mn < T) issue(mn, hn2, hbn2, fwn2);
        __builtin_amdgcn_sched_barrier(0);
        f32x4 f[8]; float s0 = 0.f;
#pragma unroll
        for (int j = 0; j < 8; ++j) { f[j] = (f32x4){bflo(fw[j].x), bfhi(fw[j].x), bflo(fw[j].y), bfhi(fw[j].y)}; s0 += (f[j].x * f[j].x + f[j].y * f[j].y) + (f[j].z * f[j].z + f[j].w * f[j].w); }
        const float ra = cs / sqrtf(wave_sum(s0) * (1.0f / D) + EPS);
        float t0 = 0.f;
#pragma unroll
        for (int j = 0; j < 8; ++j) { const f32x4 gg = gpv[j]; f32x4 hv;
            if constexpr (HIN_F32) hv = h[j]; else hv = (f32x4){bflo(hb[j].x), bfhi(hb[j].x), bflo(hb[j].y), bfhi(hb[j].y)};
            f[j] = hv + f[j] * ra * gg; t0 += (f[j].x * f[j].x + f[j].y * f[j].y) + (f[j].z * f[j].z + f[j].w * f[j].w);
            if constexpr (HOUT_F32) { GAS f32x4* ho = (GAS f32x4*)((float*)hout + (size_t)m * D) + lane; __builtin_nontemporal_store(f[j], ho + 64 * j); }
            else { GAS v2u* ho = (GAS v2u*)((bf16*)hout + (size_t)m * D) + lane; v2u a; a.x = pk2(f[j].x, f[j].y); a.y = pk2(f[j].z, f[j].w); ho[64 * j] = a; } }
        if (rs) { const float qa = 1.0f / sqrtf(wave_sum(t0) * (1.0f / D) + EPS); if (lane == 0) rs[m] = qa; }
#pragma unroll
        for (int j = 0; j < 8; ++j) { if constexpr (HIN_F32) { h[j] = hn[j]; hn[j] = hn2[j]; } else { hb[j] = hbn[j]; hbn[j] = hbn2[j]; } fw[j] = fwn[j]; fwn[j] = fwn2[j]; }
    }
}
constexpr float NEGB = -1e30f;
struct LaneIx { int lane, r, h, q4, p4, blk; };
DI LaneIx lane_ix(int tid) { LaneIx L; L.lane = tid & 63; L.r = L.lane & 31; L.h = L.lane >> 5; const int i16 = L.lane & 15; L.q4 = i16 >> 2; L.p4 = i16 & 3; L.blk = (L.lane >> 4) & 1; return L; }
DI f32x16 mfma32(bf16x8 a, bf16x8 b, f32x16 c) { return __builtin_amdgcn_mfma_f32_32x32x16_bf16(a, b, c, 0, 0, 0); }
DI f32x16 zero16() { f32x16 z;
#pragma unroll
    for (int i = 0; i < 16; ++i) z[i] = 0.f;
    return z; }
template <int S> DI bf16x8 pack8(const f32x16& x) { typedef __bf16 bfv8 __attribute__((ext_vector_type(8))); bfv8 v;
#pragma unroll
    for (int j = 0; j < 8; ++j) v[j] = (__bf16)x[8 * S + j];
    return __builtin_bit_cast(bf16x8, v); }
DI s16x4 tr16(LAS const unsigned char* p) { return __builtin_amdgcn_ds_read_tr16_b64_v4i16((LAS s16x4*)p); }
DI bf16x8 cat4(s16x4 lo, s16x4 hi) { return __builtin_shufflevector(lo, hi, 0, 1, 2, 3, 4, 5, 6, 7); }
DI float alibi_slope(int i) { return exp2f(-8.0f * (float)(i + 1) / 18.0f); }

template <int DH> struct FlashSt { f32x16 o[DH / 32]; float m, l; };
template <int DH> DI void flash_init(FlashSt<DH>& st) {
#pragma unroll
    for (int d = 0; d < DH / 32; ++d) st.o[d] = zero16();
    st.m = NEGB; st.l = 0.f; }

template <int DH, int KSTR, int QR>
DI f32x16 qk32(const bf16x8 (&q)[QR], LAS const unsigned char* qx, LAS const unsigned char* Kb, const LaneIx& L) {
    bf16x8 kf[DH / 16], qt[DH / 16 - QR + 1];
#pragma unroll
    for (int ks = 0; ks < DH / 16; ++ks) kf[ks] = *(LAS const bf16x8*)(Kb + L.r * KSTR + (16 * ks + 8 * L.h) * 2);
#pragma unroll
    for (int ks = QR; ks < DH / 16; ++ks) qt[ks - QR] = *(LAS const bf16x8*)(qx + ((ks - QR) * 64 + L.lane) * 16);
    __builtin_amdgcn_sched_barrier(0);
    f32x16 s = zero16();
#pragma unroll
    for (int ks = 0; ks < DH / 16; ++ks) s = mfma32(kf[ks], ks < QR ? q[ks < QR ? ks : 0] : qt[ks < QR ? 0 : ks - QR], s);
    return s; }
constexpr float RESCALE_THR = 8.0f, SKIP_THR = 40.0f;
template <int DH, int KSTR, int VSTR, int QR, class OK>
DI void flash32(FlashSt<DH>& st, const bf16x8 (&q)[QR], LAS const unsigned char* qx, LAS const unsigned char* Kb, LAS const unsigned char* Vb, float c2, const LaneIx& L, bool allvalid, float bias0, float bstep, OK okfn) {
    f32x16 s = qk32<DH, KSTR, QR>(q, qx, Kb, L);
    asm volatile("" : "+v"(bstep));
    const float bl = bias0 + bstep * (float)(4 * L.h);
    float mx = NEGB;
    if (allvalid) {
#pragma unroll
        for (int i = 0; i < 16; ++i) { const float v = s[i] * c2 + (bstep * (float)((i & 3) + 8 * (i >> 2)) + bl); s[i] = v; mx = fmaxf(mx, v); }
    } else {
#pragma unroll
        for (int i = 0; i < 16; ++i) { const int kl = (i & 3) + 8 * (i >> 2) + 4 * L.h; const float v = okfn(kl) ? (s[i] * c2 + (bstep * (float)((i & 3) + 8 * (i >> 2)) + bl)) : NEGB; s[i] = v; mx = fmaxf(mx, v); }
    }
    mx = fmaxf(mx, __shfl_xor(mx, 32));
    if (__all(mx < st.m - SKIP_THR)) return;
    if (!__all(mx <= st.m + RESCALE_THR)) {
        const float mn = fmaxf(st.m, mx), alpha = ex2(st.m - mn);
        st.m = mn; st.l *= alpha;
#pragma unroll
        for (int d = 0; d < DH / 32; ++d)
#pragma unroll
            for (int i = 0; i < 16; ++i) st.o[d][i] *= alpha;
    }
    const float mn = st.m;
    float ps = 0.f;
    if (allvalid) {
#pragma unroll
        for (int i = 0; i < 16; ++i) { const float p = ex2(s[i] - mn); s[i] = p; ps += p; }
    } else {
#pragma unroll
        for (int i = 0; i < 16; ++i) { const float p = (s[i] > -1e29f) ? ex2(s[i] - mn) : 0.f; s[i] = p; ps += p; }
    }
    st.l += ps;
    const bf16x8 p0 = pack8<0>(s), p1 = pack8<1>(s);
    { LAS const unsigned char* vp = Vb + (4 * L.h + L.q4) * VSTR + (16 * L.blk + 4 * L.p4) * 2;
      s16x4 vf[DH / 32][4];
#pragma unroll
      for (int d = 0; d < DH / 32; ++d) { vf[d][0] = tr16(vp + 64 * d); vf[d][1] = tr16(vp + 64 * d + 8 * VSTR); vf[d][2] = tr16(vp + 64 * d + 16 * VSTR); vf[d][3] = tr16(vp + 64 * d + 24 * VSTR); }
      __builtin_amdgcn_sched_barrier(0);
#pragma unroll
      for (int d = 0; d < DH / 32; ++d) { st.o[d] = mfma32(cat4(vf[d][0], vf[d][1]), p0, st.o[d]); st.o[d] = mfma32(cat4(vf[d][2], vf[d][3]), p1, st.o[d]); } }
}
template <int DH> DI float flash_l(const FlashSt<DH>& st) { return st.l + __shfl_xor(st.l, 32); }

template <int DH, int STR, int NR, class RF>
DI void stage_rows(LAS unsigned char* dst, RF rowptr, int tid) {
    constexpr int CPR = DH / 8, TOTAL = NR * CPR, NK = TOTAL / NTHREADS; static_assert(TOTAL % NTHREADS == 0, "stage_rows: chunk count");
    v4u v[NK]; bool okv[NK];
#pragma unroll
    for (int k = 0; k < NK; ++k) { const int id = tid + k * NTHREADS, row = id / CPR, ch = id % CPR; const bf16* p = rowptr(row, okv[k]); v[k] = *(const GAS v4u*)(p + ch * 8); }
#pragma unroll
    for (int k = 0; k < NK; ++k) { const int id = tid + k * NTHREADS, row = id / CPR, ch = id % CPR; const v4u z = (v4u){0u, 0u, 0u, 0u};
        *(LAS v4u*)(dst + row * STR + ch * 16) = okv[k] ? v[k] : z; }
}
template <int DH> DI void store_ot(const f32x16 (&o)[DH / 32], float sc, bf16* orow, const LaneIx& L) {
#pragma unroll
    for (int d = 0; d < DH / 32; ++d)
#pragma unroll
        for (int g4 = 0; g4 < 4; ++g4) { v2u w; w.x = pk2(o[d][4 * g4] * sc, o[d][4 * g4 + 1] * sc); w.y = pk2(o[d][4 * g4 + 2] * sc, o[d][4 * g4 + 3] * sc);
            *(GAS v2u*)(orow + 32 * d + 8 * g4 + 4 * L.h) = w; }
}

constexpr int K64STR = 144, V64STR = 192, K128STR = 272, V128STR = 320;
constexpr float C2_64 = 0.125f * LOG2E, C2_128 = 0.08838834764831845f * LOG2E;
DI void dil_unit(const WsPtrs& W, LAS unsigned char* lds, int idx, int tid, int wave, const LaneIx& L) {
    const int gi = idx >> 9; int rem = idx & 511; const int b = rem >> 8; rem &= 255; const int hd = rem >> 6; rem &= 63;
    const int dsh = 2 * gi, d = 1 << dsh, rs = rem & (d - 1), nt = rem >> dsh;
    const int n0 = nt * 256, nk0 = n0 - 128;
    const bf16* base = W.QKV() + (size_t)b * SEQ * QP + gi * 256 + hd * 64;
    LAS unsigned char* Kt = lds; LAS unsigned char* Vt = lds + 384 * K64STR;
    __syncthreads();
    stage_rows<64, K64STR, 384>(Kt, [&](int i, bool& ok) -> const bf16* { const int n = nk0 + i; ok = n >= 0; return base + (size_t)(((ok ? n : 0) << dsh) + rs) * QP + C_KB; }, tid);
    stage_rows<64, V64STR, 384>(Vt, [&](int i, bool& ok) -> const bf16* { const int n = nk0 + i; ok = n >= 0; return base + (size_t)(((ok ? n : 0) << dsh) + rs) * QP + C_VB; }, tid);
    __syncthreads();
    const int nq = n0 + 32 * wave + L.r, tq = (nq << dsh) + rs;
    const bf16* qrow = base + (size_t)tq * QP + C_QB;
    bf16x8 q[4];
#pragma unroll
    for (int ks = 0; ks < 4; ++ks) q[ks] = *(const GAS bf16x8*)(qrow + 16 * ks + 8 * L.h);
    const float sl2 = alibi_slope(6 * gi + (hd < 2 ? hd + 1 : hd + 2)) * LOG2E * (float)d;
    FlashSt<64> st; flash_init(st);
#pragma unroll 1
    for (int sb = 4; sb >= 0; --sb) { const int kb = 32 * wave + 32 * sb, relb = 128 - 32 * sb + L.r, nkb = nk0 + kb;
        flash32<64, K64STR, V64STR, 4>(st, q, nullptr, Kt + kb * K64STR, Vt + kb * V64STR, C2_64, L, sb >= 1 && sb <= 3 && nkb >= 0, -sl2 * (float)relb, sl2,
            [&](int kl) { const int rel = relb - kl; return rel >= 0 && rel <= 128 && (nkb + kl) >= 0; }); }
    const float l = flash_l(st), inv = 1.0f / l;
    const size_t orow = (size_t)gi * T + (size_t)b * SEQ + tq;
    store_ot<64>(st.o, inv, W.DILO() + orow * 256 + hd * 64, L);
    if (L.h == 0) W.DILL()[orow * 4 + hd] = st.m + log2f(l);
}
DI void dil_merge(const WsPtrs& W, int gtid, int gthreads) {
    for (int it = gtid; it < T * 32; it += gthreads) { const int row = it >> 5, ch = it & 31, hd = ch >> 3;
        const float l0 = W.DILL()[(size_t)row * 4 + hd], l1 = W.DILL()[((size_t)T + row) * 4 + hd], l2 = W.DILL()[((size_t)2 * T + row) * 4 + hd];
        const float mx = fmaxf(l0, fmaxf(l1, l2)); float w0 = ex2(l0 - mx), w1 = ex2(l1 - mx), w2 = ex2(l2 - mx); const float inv = 1.0f / (w0 + w1 + w2); w0 *= inv; w1 *= inv; w2 *= inv;
        const v4u a = *(const GAS v4u*)(W.DILO() + (size_t)row * 256 + ch * 8), bq = *(const GAS v4u*)(W.DILO() + ((size_t)T + row) * 256 + ch * 8), c = *(const GAS v4u*)(W.DILO() + ((size_t)2 * T + row) * 256 + ch * 8);
        v4u o;
        o.x = pk2(w0 * bflo(a.x) + w1 * bflo(bq.x) + w2 * bflo(c.x), w0 * bfhi(a.x) + w1 * bfhi(bq.x) + w2 * bfhi(c.x));
        o.y = pk2(w0 * bflo(a.y) + w1 * bflo(bq.y) + w2 * bflo(c.y), w0 * bfhi(a.y) + w1 * bfhi(bq.y) + w2 * bfhi(c.y));
        o.z = pk2(w0 * bflo(a.z) + w1 * bflo(bq.z) + w2 * bflo(c.z), w0 * bfhi(a.z) + w1 * bfhi(bq.z) + w2 * bfhi(c.z));
        o.w = pk2(w0 * bflo(a.w) + w1 * bflo(bq.w) + w2 * bflo(c.w), w0 * bfhi(a.w) + w1 * bfhi(bq.w) + w2 * bfhi(c.w));
        *(GAS v4u*)(W.YB() + (size_t)row * 256 + ch * 8) = o; }
}
DI void mem_unit(const WsPtrs& W, LAS unsigned char* lds, int idx, int tid, int wave, const LaneIx& L) {
    const int b = idx >> 8, hd = (idx >> 6) & 3, qt = idx & 63;
    const size_t row = (size_t)b * SEQ + 256 * qt + 32 * wave + L.r;
    const bf16* qrow = W.QKV() + row * QP + C_QM + hd * 128;
    bf16x8 q[8];
#pragma unroll
    for (int ks = 0; ks < 8; ++ks) q[ks] = *(const GAS bf16x8*)(qrow + 16 * ks + 8 * L.h);
    LAS unsigned char* Kt = lds; LAS unsigned char* Vt = lds + 128 * K128STR;
    FlashSt<128> st; flash_init(st);
#pragma unroll 1
    for (int half = 0; half < 2; ++half) {
        const bf16* kb = W.MEMKV() + (size_t)(b * MEML + 128 * half) * 1024 + hd * 128;
        __syncthreads();
        stage_rows<128, K128STR, 128>(Kt, [&](int i, bool& ok) -> const bf16* { ok = true; return kb + (size_t)i * 1024; }, tid);
        stage_rows<128, V128STR, 128>(Vt, [&](int i, bool& ok) -> const bf16* { ok = true; return kb + (size_t)i * 1024 + 512; }, tid);
        __syncthreads();
#pragma unroll 1
        for (int sb = 0; sb < 4; ++sb) flash32<128, K128STR, V128STR, 8>(st, q, nullptr, Kt + 32 * sb * K128STR, Vt + 32 * sb * V128STR, C2_128, L, true, 0.f, 0.f, [](int) { return true; });
    }
    const float l = flash_l(st);
    store_ot<128>(st.o, 1.0f / l, W.YM() + row * 512 + hd * 128, L);
}
DI void cmp_unit(const WsPtrs& W, LAS unsigned char* lds, int idx, int tid, int wave, const LaneIx& L) {
    const int which = idx >> 7, rg = idx & 127;
    const bf16* w1t = which ? W.wc1v() : W.wc1k(); const bf16* w2t = which ? W.wc2v() : W.wc2k();
    const int rho = 32 * rg + L.r, b = rho >> 11, c = (rho >> 1) & 1023, g = rho & 1;
    const bf16* src = W.QKV() + (size_t)b * SEQ * QP + (which ? C_VC : C_KC) + g * 128;
    f32x16 hid[8];
#pragma unroll
    for (int i = 0; i < 8; ++i) hid[i] = zero16();
    auto issue = [&](int j, bf16x8 (&af)[8], bf16x8& bf) { const int kt = 8 * wave + (j >> 2), ks = j & 3, pos = kt >> 1, e0 = (kt & 1) * 64; int tok = 16 * c + pos; tok = tok < SEQ ? tok : SEQ - 1;
        bf = *(const GAS bf16x8*)(src + (size_t)tok * QP + e0 + 8 * L.h + 16 * ks);
        const bf16* ap = w1t + (size_t)L.r * 4096 + 64 * kt + 8 * L.h + 16 * ks;
#pragma unroll
        for (int hb = 0; hb < 8; ++hb) af[hb] = *(const GAS bf16x8*)(ap + (size_t)(32 * hb) * 4096); };
    bf16x8 a0[8], a1[8], b0, b1;
    issue(0, a0, b0);
#pragma unroll 1
    for (int j = 0; j < 32; j += 2) {
        issue(j + 1, a1, b1);
        __builtin_amdgcn_sched_barrier(0);
#pragma unroll
        for (int hb = 0; hb < 8; ++hb) hid[hb] = mfma32(a0[hb], b0, hid[hb]);
        __builtin_amdgcn_sched_barrier(0);
        issue(j + 2 < 32 ? j + 2 : 31, a0, b0);
        __builtin_amdgcn_sched_barrier(0);
#pragma unroll
        for (int hb = 0; hb < 8; ++hb) hid[hb] = mfma32(a1[hb], b1, hid[hb]);
        __builtin_amdgcn_sched_barrier(0);
    }
    __syncthreads();
#pragma unroll
    for (int half = 4; half >= 1; half >>= 1) {
        if (wave >= half && wave < 2 * half) { LAS float* slot = (LAS float*)(lds + (wave - half) * 32768);
#pragma unroll
            for (int hb = 0; hb < 8; ++hb)
#pragma unroll
                for (int i = 0; i < 16; ++i) slot[(hb * 16 + i) * 64 + L.lane] = hid[hb][i]; }
        __syncthreads();
        if (wave < half) { const LAS float* slot = (const LAS float*)(lds + wave * 32768);
#pragma unroll
            for (int hb = 0; hb < 8; ++hb)
#pragma unroll
                for (int i = 0; i < 16; ++i) hid[hb][i] += slot[(hb * 16 + i) * 64 + L.lane]; }
        __syncthreads();
    }
    if (wave == 0) {
        const float* cb = W.cbias() + which * 256;
        bf16x8 ph[8][2];
#pragma unroll
        for (int hb = 0; hb < 8; ++hb) {
#pragma unroll
            for (int i = 0; i < 16; ++i) { const float v = hid[hb][i] + cb[32 * hb + (i & 3) + 8 * (i >> 2) + 4 * L.h]; hid[hb][i] = v * sigm(v); }
            ph[hb][0] = pack8<0>(hid[hb]); ph[hb][1] = pack8<1>(hid[hb]); }
        f32x16 out[4];
#pragma unroll
        for (int i = 0; i < 4; ++i) out[i] = zero16();
#pragma unroll
        for (int hb = 0; hb < 8; ++hb) { s16x4 wa[4][4];
#pragma unroll
            for (int ob = 0; ob < 4; ++ob) { const bf16* wr = w2t + (size_t)(32 * ob + L.r) * 256 + 32 * hb + 4 * L.h;
                wa[ob][0] = *(const GAS s16x4*)(wr); wa[ob][1] = *(const GAS s16x4*)(wr + 8); wa[ob][2] = *(const GAS s16x4*)(wr + 16); wa[ob][3] = *(const GAS s16x4*)(wr + 24); }
            __builtin_amdgcn_sched_barrier(0);
#pragma unroll
            for (int ob = 0; ob < 4; ++ob) { out[ob] = mfma32(cat4(wa[ob][0], wa[ob][1]), ph[hb][0], out[ob]); out[ob] = mfma32(cat4(wa[ob][2], wa[ob][3]), ph[hb][1], out[ob]); }
            __builtin_amdgcn_sched_barrier(0);
        }
        bf16* dst = (which ? W.VCMP() : W.KCMP()) + ((size_t)(b * 2 + g) * 1024 + c) * 128;
        store_ot<128>(out, 1.0f, dst, L);
        if (which == 0) {
            float ss = 0.f;
#pragma unroll
            for (int ob = 0; ob < 4; ++ob)
#pragma unroll
                for (int i = 0; i < 16; ++i) ss += out[ob][i] * out[ob][i];
            ss += __shfl_xor(ss, 32);
            if (L.h == 0) ((float*)(W.ws + WS_KNC))[(size_t)(b * 2 + g) * 1024 + c] = sqrtf(ss);
        }
    }
}
DI void key_norms(const WsPtrs& W, int gw, int NGW, int lane) {
#pragma unroll 1
    for (int wu = gw; wu < 2048; wu += NGW) { const int type = wu >> 10, b = (wu >> 9) & 1, g = (wu >> 8) & 1, j = wu & 255;
        const bf16* rp = W.QKV() + ((size_t)b * SEQ + 64 * j + lane) * QP + (type ? C_KW : C_KS) + g * 128;
        v4u x[16];
#pragma unroll
        for (int k = 0; k < 16; ++k) x[k] = *(const GAS v4u*)(rp + 8 * k);
        float ss = 0.f;
#pragma unroll
        for (int k = 0; k < 16; ++k) { ss += bflo(x[k].x) * bflo(x[k].x) + bfhi(x[k].x) * bfhi(x[k].x); ss += bflo(x[k].y) * bflo(x[k].y) + bfhi(x[k].y) * bfhi(x[k].y);
            ss += bflo(x[k].z) * bflo(x[k].z) + bfhi(x[k].z) * bfhi(x[k].z); ss += bflo(x[k].w) * bflo(x[k].w) + bfhi(x[k].w) * bfhi(x[k].w); }
#pragma unroll
        for (int o = 1; o < 64; o <<= 1) ss = fmaxf(ss, __shfl_xor(ss, o));
        if (lane == 0) ((float*)(W.ws + WS_KNS))[wu] = sqrtf(ss); }
}
constexpr int NSA_BUF = 64 * K128STR + 64 * V128STR;
constexpr int NSA_SEL_OFF = 2 * NSA_BUF, NSA_WUN_OFF = NSA_SEL_OFF + 8192, NSA_GUN_OFF = NSA_WUN_OFF + 256, NSA_LIST_OFF = NSA_GUN_OFF + 256, NSA_NLIST_OFF = NSA_LIST_OFF + 2048, NSA_QX_OFF = NSA_NLIST_OFF + 256, NSA_STAT_OFF = NSA_QX_OFF + 8 * 4096;
constexpr int NSA_PM_OFF = NSA_STAT_OFF + 3 * NTHREADS * 8;
constexpr int NSA_PMW_OFF = NSA_PM_OFF + 1024, NSA_PMC_OFF = NSA_PMW_OFF + 1024, NSA_VOTE_OFF = NSA_PMC_OFF + 64;
static_assert(NSA_VOTE_OFF + 64 <= RING_BYTES + 14336, "NSA LDS map");
#ifndef NSA_CUT
#define NSA_CUT 7
#endif
static_assert(256 * K128STR <= NSA_SEL_OFF, "step A stages 256 compressed keys at a time below the masks");
#define TOPN 13
typedef unsigned long long u64;
DI void top_insert(u64 (&tk)[TOPN], u64 c) {
#pragma unroll
    for (int k = 0; k < TOPN; ++k) { const u64 a = tk[k]; const bool gt = c > a; tk[k] = gt ? c : a; c = gt ? a : c; }
}
DI u64 top_key(float score, int j) { return ((u64)__builtin_bit_cast(unsigned, score) << 32) | (u64)(0xffffffffu - (unsigned)j); }
DI void nsa_unit(const WsPtrs& W, LAS unsigned char* lds, int idx, int tid, int wave, const LaneIx& L) {
    const int b = idx >> 7, g = (idx >> 6) & 1, qt = idx & 63;
    const int t0 = qt * 256, tw0 = t0 + 32 * wave, t = tw0 + L.r, cur = t >> 6;
    const bf16* qkvb = W.QKV() + (size_t)b * SEQ * QP;
    const bf16* kcmp = W.KCMP() + (size_t)(b * 2 + g) * 1024 * 128; const bf16* vcmp = W.VCMP() + (size_t)(b * 2 + g) * 1024 * 128;
    LAS unsigned char* Kt = lds; LAS unsigned char* Vt = lds + 64 * K128STR;
    LAS unsigned* selm = (LAS unsigned*)(lds + NSA_SEL_OFF); LAS unsigned* wun = (LAS unsigned*)(lds + NSA_WUN_OFF); LAS unsigned* gun = (LAS unsigned*)(lds + NSA_GUN_OFF);
    int n_c = t0 / 16 + 15; n_c = n_c < NCMP ? n_c : NCMP;
    const int ntile = (n_c + 63) >> 6, wave_cmax = t0 / 16 + 2 * wave;
    float sl2[3];
#pragma unroll
    for (int hh = 0; hh < 3; ++hh) sl2[hh] = alibi_slope(3 * (g * 3 + hh)) * LOG2E;
    if (tid == 0) { LAS unsigned* list = (LAS unsigned*)(lds + NSA_LIST_OFF); for (int i = 0; i < ntile; ++i) list[i] = (unsigned)(ntile - 1 - i); }
    if (wave < 2) { const float* kn = (const float*)(W.ws + WS_KNS) + (size_t)((wave * 2 + b) * 2 + g) * 256; const f32x4 v = *(const GAS f32x4*)(kn + 4 * L.lane);
        float p0 = v.x, p1 = fmaxf(p0, v.y), p2 = fmaxf(p1, v.z), p3 = fmaxf(p2, v.w), c = p3;
#pragma unroll
        for (int o = 1; o < 64; o <<= 1) { const float n = __shfl_up(c, o); if (L.lane >= o) c = fmaxf(c, n); }
        float ex = __shfl_up(c, 1); if (L.lane == 0) ex = 0.f;
        LAS float* pm = (LAS float*)(lds + (wave ? NSA_PMW_OFF : NSA_PM_OFF)) + 4 * L.lane;
        pm[0] = fmaxf(p0, ex); pm[1] = fmaxf(p1, ex); pm[2] = fmaxf(p2, ex); pm[3] = fmaxf(p3, ex); }
    if (wave == 2) { const float* knc = (const float*)(W.ws + WS_KNC) + (size_t)(b * 2 + g) * 1024; float pm = 0.f;
#pragma unroll 1
        for (int i = 0; i < ntile; ++i) { const int c = 64 * i + L.lane; float v = c < NCMP ? knc[c] : 0.f;
#pragma unroll
            for (int o = 1; o < 64; o <<= 1) v = fmaxf(v, __shfl_xor(v, o));
            pm = fmaxf(pm, v); if (L.lane == 0) ((LAS float*)(lds + NSA_PMC_OFF))[i] = pm; } }
    __syncthreads();
#pragma unroll 1
    for (int pass = 0; pass < 6; ++pass) { const int hh = pass < 3 ? pass : pass - 3;
        if (pass == 3) {
        const int tS = opaque_v(t), curS = tS >> 6; const LaneIx LS = lane_ix(opaque_v(tid));
        bf16x8 q3[3][8];
#pragma unroll
        for (int hh = 0; hh < 3; ++hh) { const bf16* qrow = qkvb + (size_t)tS * QP + C_QA + (g * 3 + hh) * 128;
#pragma unroll
            for (int ks = 0; ks < 8; ++ks) q3[hh][ks] = *(const GAS bf16x8*)(qrow + 16 * ks + 8 * LS.h); }
        float m3[3], inv3[3];
        { const LAS float* stf = (const LAS float*)(lds + NSA_STAT_OFF);
#pragma unroll
          for (int hh = 0; hh < 3; ++hh) { m3[hh] = stf[(hh * NTHREADS + tid) * 2]; const float lt = stf[(hh * NTHREADS + tid) * 2 + 1]; inv3[hh] = lt > 0.f ? 1.0f / lt : 0.f; } }
        u64 tk[TOPN];
#pragma unroll
        for (int k = 0; k < TOPN; ++k) tk[k] = 0ull;
        float carry = 0.f;
        float qn3[3];
#pragma unroll
        for (int hh = 0; hh < 3; ++hh) { float ss = 0.f;
#pragma unroll
            for (int ks = 0; ks < 8; ++ks)
#pragma unroll
                for (int j = 0; j < 8; ++j) { const float a = bf2f((bf16)q3[hh][ks][j]); ss += a * a; }
            qn3[hh] = sqrtf(ss + __shfl_xor(ss, 32)) * (C2_128 * 1.02f); }
        const int E = (t0 / 16 + 16 + 31) & ~31, NS = (E + 255) >> 8;
        auto skipfn = [&](int cbx) -> bool {
            const float T = tk[TOPN - 1] != 0ull ? __builtin_bit_cast(float, (unsigned)(tk[TOPN - 1] >> 32)) : -1.0f;
            const float kn = ((LAS const float*)(lds + NSA_PMC_OFF))[(cbx + 31) >> 6]; const int dm = tS - (16 * (cbx + 31) + 31); const float dmin = (float)(dm > 0 ? dm : 0);
            float ub = 0.f;
#pragma unroll
            for (int hh = 0; hh < 3; ++hh) ub += ex2(qn3[hh] * kn - sl2[hh] * dmin - m3[hh]) * inv3[hh];
            return __all(4.1f * ub < T); };
        float dfs = 0.f; int dfj = -1;
#pragma unroll 1
        for (int step = 0; step < NS * 8; ++step) {
            const bool ph1 = step < 8; const int sidx = ph1 ? NS - 1 : ((step - 8) >> 3), sub = step & 7, lo = E - 256 * (NS - sidx);
            if (sub == 0) {
                __syncthreads();
                stage_rows<128, K128STR, 256>(Kt, [&](int i, bool& ok) -> const bf16* { const int c = lo + i; ok = c >= 0 && c < NCMP; return kcmp + (size_t)(ok ? c : 0) * 128; }, opaque_v(tid));
                __syncthreads();
                if (!ph1 && sidx == 0) carry = 0.f;
            }
            const int cb = lo + 32 * sub;
            if (cb < 0 || cb > wave_cmax) continue;
            bool defer = false;
            if (!ph1) { const bool last = step == NS * 8 - 1; const bool skB = skipfn(cb); const bool skN = last ? false : skipfn(cb + 32);
                if (skB && skN) { carry = 0.f; continue; } }
            else defer = sub == 0 && NS >= 2;
            {
                const int dist0 = tS - (16 * cb + 31);
                f32x16 imp = zero16();
#pragma unroll
                for (int hh = 0; hh < 3; ++hh) { const f32x16 s = qk32<128, K128STR, 8>(q3[hh], nullptr, Kt + 32 * sub * K128STR, LS);
#pragma unroll
                    for (int i = 0; i < 16; ++i) { const int kl = (i & 3) + 8 * (i >> 2) + 4 * LS.h, dist = dist0 - 16 * kl;
                        const float p = dist >= 0 ? ex2(s[i] * C2_128 - sl2[hh] * (float)dist - m3[hh]) * inv3[hh] : 0.f; imp[i] += p; } }
                const float sx0 = __shfl_xor(imp[3], 32), sx1 = __shfl_xor(imp[7], 32), sx2 = __shfl_xor(imp[11], 32), sx3 = __shfl_xor(imp[15], 32), cx = __shfl_xor(carry, 32);
                float sc[4];
                sc[0] = 0.5f * (LS.h ? sx0 : cx) + imp[0] + imp[1] + imp[2] + 0.5f * imp[3];
                sc[1] = 0.5f * (LS.h ? sx1 : sx0) + imp[4] + imp[5] + imp[6] + 0.5f * imp[7];
                sc[2] = 0.5f * (LS.h ? sx2 : sx1) + imp[8] + imp[9] + imp[10] + 0.5f * imp[11];
                sc[3] = 0.5f * (LS.h ? sx3 : sx2) + imp[12] + imp[13] + imp[14] + 0.5f * imp[15];
                carry = imp[15];
                if (defer) { dfs = imp[0] + imp[1] + imp[2] + 0.5f * imp[3]; dfj = cb >> 2; }
#pragma unroll
                for (int g4 = 0; g4 < 4; ++g4) { const int j = (cb >> 2) + 2 * g4 + LS.h; bool ok = j >= 1 && j <= curS - 2; if (g4 == 0 && defer && LS.h == 0) ok = false; const u64 ck = ok ? top_key(sc[g4], j) : 0ull;
                    if (__any(ck > tk[TOPN - 1])) top_insert(tk, ck); }
            }
        }
        if (dfj >= 0) { const float cx = __shfl_xor(carry, 32); const float scd = 0.5f * cx + dfs;
            const bool ok = LS.h == 0 && dfj >= 1 && dfj <= curS - 2; const u64 ck = ok ? top_key(scd, dfj) : 0ull;
            if (__any(ck > tk[TOPN - 1])) top_insert(tk, ck); }
        { u64 pk[TOPN];
#pragma unroll
            for (int k = 0; k < TOPN; ++k) { const unsigned lo = (unsigned)__shfl_xor((int)(unsigned)tk[k], 32), hi = (unsigned)__shfl_xor((int)(unsigned)(tk[k] >> 32), 32); pk[k] = ((u64)hi << 32) | lo; }
#pragma unroll
            for (int k = 0; k < TOPN; ++k) top_insert(tk, pk[k]); }
        unsigned wsel[8];
#pragma unroll
        for (int wd = 0; wd < 8; ++wd) { unsigned v = (wd == 0) ? 1u : 0u; v |= ((curS >> 5) == wd) ? (1u << (curS & 31)) : 0u; if (curS >= 1) v |= (((curS - 1) >> 5) == wd) ? (1u << ((curS - 1) & 31)) : 0u; wsel[wd] = v; }
#pragma unroll
        for (int k = 0; k < TOPN; ++k) { const bool ok = tk[k] != 0ull; const unsigned jj = 0xffffffffu - (unsigned)tk[k]; const unsigned wj = jj >> 5, bit = 1u << (jj & 31);
#pragma unroll
            for (int wd = 0; wd < 8; ++wd) wsel[wd] |= (ok && wj == (unsigned)wd) ? bit : 0u; }
#pragma unroll
        for (int wd = 0; wd < 8; ++wd) { if (LS.h == 0) selm[(32 * wave + LS.r) * 8 + wd] = wsel[wd];
            unsigned u = wsel[wd]; u |= __shfl_xor(u, 1); u |= __shfl_xor(u, 2); u |= __shfl_xor(u, 4); u |= __shfl_xor(u, 8); u |= __shfl_xor(u, 16);
            if (LS.lane == 0) wun[wave * 8 + wd] = u; }
        __syncthreads();
        if (tid < 8) { unsigned u = 0; for (int w = 0; w < 8; ++w) u |= wun[w * 8 + tid]; gun[tid] = u; }
        __syncthreads();
        if (tid == 0) {
            LAS unsigned* list = (LAS unsigned*)(lds + NSA_LIST_OFF); int n = ntile;
            for (int wd = 7; wd >= 0; --wd) { unsigned wm = gun[wd]; while (wm) { const int bit = 31 - __builtin_clz(wm); wm &= ~(1u << bit); list[n++] = 0x10000u | (unsigned)(32 * wd + bit); } }
            *(LAS int*)(lds + NSA_NLIST_OFF + 4) = n;
            for (int i = 11; i >= 0; --i) if (t0 - 512 + 64 * i + 63 >= 0) list[n++] = 0x20000u | (unsigned)i;
            *(LAS int*)(lds + NSA_NLIST_OFF) = n; }
        __syncthreads();
        }
        const int head = g * 3 + hh; const float s2 = alibi_slope(3 * head) * LOG2E;
        const int tq = opaque_v(t);
        const bf16* trow = qkvb + (size_t)tq * QP;
        bf16x8 q[4];
        LAS unsigned char* qx = lds + NSA_QX_OFF + wave * 4096;
        const LaneIx Lq = lane_ix(opaque_v(tid));
#pragma unroll
        for (int ks = 0; ks < 4; ++ks) q[ks] = *(const GAS bf16x8*)(trow + C_QA + head * 128 + 16 * ks + 8 * Lq.h);
        float qss = 0.f;
        { bf16x8 qt4[4];
#pragma unroll
          for (int ks = 4; ks < 8; ++ks) qt4[ks - 4] = *(const GAS bf16x8*)(trow + C_QA + head * 128 + 16 * ks + 8 * Lq.h);
#pragma unroll
          for (int ks = 4; ks < 8; ++ks) *(LAS bf16x8*)(qx + ((ks - 4) * 64 + Lq.lane) * 16) = qt4[ks - 4];
#pragma unroll
          for (int ks = 0; ks < 4; ++ks)
#pragma unroll
              for (int j = 0; j < 8; ++j) { const float a = bf2f((bf16)q[ks][j]), c = bf2f((bf16)qt4[ks][j]); qss += a * a + c * c; } }
        const float qn = sqrtf(qss + __shfl_xor(qss, 32)) * (C2_128 * 1.02f);
        FlashSt<128> st; flash_init(st);
        const LAS unsigned* list = (const LAS unsigned*)(lds + NSA_LIST_OFF);
        const int e0 = pass < 3 ? 0 : ntile, nlist = pass < 3 ? ntile : __builtin_amdgcn_readfirstlane(*(const LAS int*)(lds + NSA_NLIST_OFF));
        v4u kreg[2], vreg[2];
        auto tile_geom = [&](unsigned e, const bf16*& kb, const bf16*& vb, int& pitch, int& r0, int& r1) {
            const int ty = (int)(e >> 16), ix = (int)(e & 0xffffu); r0 = 0; r1 = 64;
            if (ty == 0) { kb = kcmp + (size_t)(64 * ix) * 128; vb = vcmp + (size_t)(64 * ix) * 128; pitch = 128; r1 = NCMP - 64 * ix; }
            else if (ty == 1) { kb = qkvb + (size_t)(64 * ix) * QP + C_KS + g * 128; vb = kb + (C_VS - C_KS); pitch = QP; }
            else { const int tk0 = t0 - 512 + 64 * ix; kb = qkvb + (ptrdiff_t)tk0 * QP + C_KW + g * 128; vb = kb + (C_VW - C_KW); pitch = QP; r0 = -tk0; } };
        auto tile_load = [&](unsigned e, int tidx) {
            const bf16 *kb, *vb; int pitch, r0, r1; tile_geom(e, kb, vb, pitch, r0, r1);
#pragma unroll
            for (int k = 0; k < 2; ++k) { const int id = tidx + k * NTHREADS, row = id >> 4, ch = id & 15; const bool ok = row >= r0 && row < r1; const int rc = ok ? row : (r0 > 0 ? r0 : 0);
                kreg[k] = *(const GAS v4u*)(kb + (ptrdiff_t)rc * pitch + ch * 8); vreg[k] = *(const GAS v4u*)(vb + (ptrdiff_t)rc * pitch + ch * 8); } };
        auto tile_store = [&](unsigned e, int buf, int tidx) { LAS unsigned char* kt = lds + buf * NSA_BUF; LAS unsigned char* vt = kt + 64 * K128STR;
            const bf16 *kb, *vb; int pitch, r0, r1; tile_geom(e, kb, vb, pitch, r0, r1); const v4u z = (v4u){0u, 0u, 0u, 0u};
#pragma unroll
            for (int k = 0; k < 2; ++k) { const int id = tidx + k * NTHREADS, row = id >> 4, ch = id & 15; const bool ok = row >= r0 && row < r1;
                *(LAS v4u*)(kt + row * K128STR + ch * 16) = ok ? kreg[k] : z; *(LAS v4u*)(vt + row * V128STR + ch * 16) = ok ? vreg[k] : z; } };
        auto branch_done = [&](int ty) {
            const int tq2 = opaque_v(t);
            const int hq2 = opaque_v(tid) >> 5 & 1;
            const float gsel = sigm(bf2f(qkvb[(size_t)tq2 * QP + C_GN + head * 3 + ty]));
            const float lt = flash_l(st), sc = lt > 0.f ? gsel / lt : 0.f;
            float* yacc = (float*)W.F() + ((size_t)b * SEQ + tq2) * 768 + head * 128 + 4 * hq2;
            bf16* yo = W.YA() + ((size_t)b * SEQ + tq2) * 768 + head * 128 + 4 * hq2;
            f32x4 acc[4][4];
            if (ty != 0) {
#pragma unroll
                for (int d = 0; d < 4; ++d)
#pragma unroll
                    for (int g4 = 0; g4 < 4; ++g4) acc[d][g4] = *(const GAS f32x4*)(yacc + 32 * d + 8 * g4);
            } else {
#pragma unroll
                for (int d = 0; d < 4; ++d)
#pragma unroll
                    for (int g4 = 0; g4 < 4; ++g4) acc[d][g4] = (f32x4){0.f, 0.f, 0.f, 0.f};
            }
#pragma unroll
            for (int d = 0; d < 4; ++d)
#pragma unroll
                for (int g4 = 0; g4 < 4; ++g4) { f32x4 a = acc[d][g4];
                    a = (f32x4){a.x + st.o[d][4 * g4] * sc, a.y + st.o[d][4 * g4 + 1] * sc, a.z + st.o[d][4 * g4 + 2] * sc, a.w + st.o[d][4 * g4 + 3] * sc};
                    if (ty != 2) *(GAS f32x4*)(yacc + 32 * d + 8 * g4) = a; else { v2u w; w.x = pk2(a.x, a.y); w.y = pk2(a.z, a.w); *(GAS v2u*)(yo + 32 * d + 8 * g4) = w; } }
            flash_init(st); };
        __syncthreads();
        { const int tid0 = opaque_v(tid); const unsigned d0 = (unsigned)__builtin_amdgcn_readfirstlane((int)list[e0]); tile_load(d0, tid0); tile_store(d0, 0, tid0); }
        __syncthreads();
        int curty = pass < 3 ? 0 : 1;
        const int winstart = __builtin_amdgcn_readfirstlane(*(const LAS int*)(lds + NSA_NLIST_OFF + 4));
        LAS unsigned* votes = (LAS unsigned*)(lds + NSA_VOTE_OFF);
        bool fresh = true;
#pragma unroll 1
        for (int e = e0; e < nlist; ++e) {
            if (!fresh) {
                LAS const unsigned* vp = votes + ((e - 1 - e0) & 1) * 8; const v4u va = *(LAS const v4u*)vp, vb = *(LAS const v4u*)(vp + 4);
                const unsigned all8 = va.x & va.y & va.z & va.w & vb.x & vb.y & vb.z & vb.w;
                if (__builtin_amdgcn_readfirstlane((int)all8) != 0) {
                    const int en = curty == 0 ? nlist : (curty == 1 ? winstart : nlist);
                    if (en >= nlist) break;
                    e = en;
                    { const int tid0 = opaque_v(tid); const unsigned dj = (unsigned)__builtin_amdgcn_readfirstlane((int)list[e]); tile_load(dj, tid0); tile_store(dj, (e - e0) & 1, tid0); }
                    __syncthreads();
                    fresh = true;
                }
            }
            const unsigned de = (unsigned)__builtin_amdgcn_readfirstlane((int)list[e]);
            const int tide = opaque_v(tid); const LaneIx Le = lane_ix(tide);
            if (e + 1 < nlist) tile_load((unsigned)__builtin_amdgcn_readfirstlane((int)list[e + 1]), tide);
            __builtin_amdgcn_sched_barrier(0);
            const int ty = (int)(de >> 16), ix = (int)(de & 0xffffu);
            if (ty != curty) { branch_done(curty); curty = ty; }
            LAS const unsigned char* kt = lds + ((e - e0) & 1) * NSA_BUF; LAS const unsigned char* vt = kt + 64 * K128STR;
            bool selb = true; unsigned wu1 = 1u;
            if (ty == 1) { const int wd = ix >> 5, bit = ix & 31; wu1 = ((unsigned)__builtin_amdgcn_readfirstlane((int)wun[wave * 8 + wd]) >> bit) & 1u; selb = (selm[(32 * wave + Le.r) * 8 + wd] >> bit) & 1u; }
            const bool allsel = __all(selb);
#pragma unroll 1
            for (int sub = 1; sub >= 0; --sub) {
                int dist0, step, dmax, klmin; bool active, allv;
                if (ty == 0) { const int cb = 64 * ix + 32 * sub; active = cb <= wave_cmax; dist0 = t - (16 * cb + 31); step = 16; dmax = 0x7fffffff; klmin = 0; allv = tw0 - 16 * cb - 527 >= 0; }
                else if (ty == 1) { active = wu1 != 0u; dist0 = t - (64 * ix + 32 * sub); step = 1; dmax = 0x7fffffff; klmin = 0; allv = allsel && (tw0 - 64 * ix - 32 * sub - 31 >= 0); }
                else { const int tb = t0 - 512 + 64 * ix + 32 * sub; active = !(tb + 31 < tw0 - 511 || tb > tw0 + 31); dist0 = t - tb; step = 1; dmax = 512; klmin = -tb; allv = tb >= 0 && (tw0 - tb - 31 >= 0) && (tw0 + 31 - tb <= 511); }
                if (active)
                    flash32<128, K128STR, V128STR, 4>(st, q, qx, kt + 32 * sub * K128STR, vt + 32 * sub * V128STR, C2_128, Le, allv, -s2 * (float)dist0, s2 * (float)step,
                        [&](int kl) { const int dist = dist0 - step * kl; return selb && dist >= 0 && dist < dmax && kl >= klmin; });
            }
            { unsigned vote = 0u;
              if (e + 1 < nlist) { const unsigned dn = (unsigned)__builtin_amdgcn_readfirstlane((int)list[e + 1]);
                  if ((int)(dn >> 16) == ty && ((NSA_CUT >> ty) & 1)) {
                      float knr; int npos;
                      if (ty == 0) { knr = ((LAS const float*)(lds + NSA_PMC_OFF))[ix - 1]; npos = 1024 * ix + 15; }
                      else if (ty == 1) { const int jn = (int)(dn & 0xffffu); knr = ((LAS const float*)(lds + NSA_PM_OFF))[jn]; npos = 64 * jn + 63; }
                      else { const int bi = 4 * qt - 8 + ix - 1; knr = ((LAS const float*)(lds + NSA_PMW_OFF))[bi]; npos = 64 * bi + 63; }
                      const int dm = t - npos; const float dmin = (float)(dm > 0 ? dm : 0);
                      const bool okc = qn * knr - s2 * dmin < st.m - SKIP_THR;
                      vote = __all(okc) ? 1u : 0u; } }
              if (Le.lane == 0) votes[((e - e0) & 1) * 8 + wave] = vote; }
            fresh = false;
            __builtin_amdgcn_sched_barrier(0);
            if (e + 1 < nlist) tile_store((unsigned)__builtin_amdgcn_readfirstlane((int)list[e + 1]), (e + 1 - e0) & 1, opaque_v(tid));
            asm volatile("s_waitcnt lgkmcnt(0)" ::: "memory"); __builtin_amdgcn_s_barrier(); asm volatile("" ::: "memory");
        }
        if (pass < 3) { LAS float* stf = (LAS float*)(lds + NSA_STAT_OFF); stf[(hh * NTHREADS + tid) * 2] = st.m; stf[(hh * NTHREADS + tid) * 2 + 1] = flash_l(st); }
        branch_done(curty);
    }
}

#define XB_TMO      128
#define XB_XCNT(j)  (256  + 64 * (j))
#define XB_XSUB(j)  (1280 + 64 * (j))
#define XB_XGEN(j)  (2304 + 64 * (j))
#define XB_TOP      3328
#define XB_TOPGEN   3392
#define XCD_BAR_WORDS 3456
#define XB_SPIN_CAP (1u << 18)

__device__ __forceinline__ unsigned xb_ld(unsigned* p)              { return __hip_atomic_load(p, __ATOMIC_RELAXED, __HIP_MEMORY_SCOPE_AGENT); }
__device__ __forceinline__ unsigned xb_add(unsigned* p, unsigned v) { return __hip_atomic_fetch_add(p, v, __ATOMIC_RELAXED, __HIP_MEMORY_SCOPE_AGENT); }
__device__ __forceinline__ unsigned xb_xcc_id() { return (unsigned)__builtin_amdgcn_s_getreg((3 << 11) | 20) & 0xFu; }
#define XB_SPIN(cond, bar) do { unsigned _sp = 0; while (cond) { __builtin_amdgcn_s_sleep(1); \
    if ((++_sp & 255u) == 0u) { if (xb_ld(&(bar)[XB_TMO])) break; if (_sp > XB_SPIN_CAP) { atomicAdd(&(bar)[XB_TMO], 1u); break; } } } } while (0)

struct XcdBarrier {
    unsigned* bar; unsigned x;
    volatile LAS unsigned* st;
};

__device__ __forceinline__ XcdBarrier xcd_barrier_post(unsigned* bar, volatile LAS unsigned* st, int tid) {
    XcdBarrier b; b.bar = bar; b.x = xb_xcc_id(); b.st = st;
    if (tid == 0) (void)xb_add(&bar[XB_XCNT(b.x)], 1u);
    return b;
}
__device__ __forceinline__ void xcd_barrier_complete(unsigned* bar, unsigned x, unsigned& nloc, unsigned& nx) {
    const unsigned G = gridDim.x * gridDim.y * gridDim.z;
    unsigned sum, cnt, mine, sp = 0u;
    for (;;) {
        sum = 0u; cnt = 0u; mine = 0u;
#pragma unroll
        for (unsigned j = 0; j < 16; ++j) { const unsigned c = xb_ld(&bar[XB_XCNT(j)]); sum += c; cnt += (c > 0u) ? 1u : 0u; mine = (j == x) ? c : mine; }
        if (sum == G) break;
        __builtin_amdgcn_s_sleep(1);
        if ((++sp & 255u) == 0u) { if (xb_ld(&bar[XB_TMO])) break; if (sp > XB_SPIN_CAP) { atomicAdd(&bar[XB_TMO], 1u); break; } }
    }
    nloc = mine > 0u ? mine : 1u; nx = cnt > 0u ? cnt : 1u;
}

__device__ __forceinline__ void xcd_barrier(const XcdBarrier& b, int tid) {
    asm volatile("s_waitcnt vmcnt(0)" ::: "memory");
    __syncthreads();
    if (tid == 0) {
        unsigned* bar = b.bar;
        __builtin_amdgcn_s_waitcnt(0);
        unsigned nloc = b.st[0], nx = b.st[1];
        if (nloc == 0u) { xcd_barrier_complete(bar, b.x, nloc, nx); b.st[0] = nloc; b.st[1] = nx; }
        const unsigned old = xb_add(&bar[XB_XSUB(b.x)], 1u);
        const unsigned gen = old / nloc;
        if (old + 1u == (gen + 1u) * nloc) {
            __builtin_amdgcn_fence(__ATOMIC_RELEASE, "agent");
            asm volatile("s_waitcnt vmcnt(0)" ::: "memory");
            const unsigned og = xb_add(&bar[XB_TOP], 1u);
            const unsigned tg = og / nx;
            if (og + 1u == (tg + 1u) * nx) xb_add(&bar[XB_TOPGEN], 1u);
            else XB_SPIN(xb_ld(&bar[XB_TOPGEN]) == tg, bar);
            __builtin_amdgcn_fence(__ATOMIC_ACQUIRE, "agent");
            xb_add(&bar[XB_XGEN(b.x)], 1u);
            asm volatile("s_waitcnt vmcnt(0)" ::: "memory");
        } else {
            XB_SPIN(xb_ld(&bar[XB_XGEN(b.x)]) == gen, bar);
            __builtin_amdgcn_fence(__ATOMIC_ACQUIRE, "agent");
            asm volatile("s_waitcnt vmcnt(0)" ::: "memory");
        }
    }
    __syncthreads();
}

constexpr int NCONVQ = 256;
constexpr int NPL = 14;
constexpr int NPH = 1 + NPL * DEPTH;
struct Args { const float* in[27]; float* out; unsigned char* ws; int ph_lo, ph_hi; };
static_assert(sizeof(Args) == 27 * 8 + 8 + 8 + 8, "Args has no padding");

typedef __attribute__((address_space(4))) const unsigned long long* kargp_t;
DI kargp_t kargs_opaque() { const unsigned long long v = (unsigned long long)__builtin_amdgcn_kernarg_segment_ptr(); unsigned lo = (unsigned)v, hi = (unsigned)(v >> 32);
    asm volatile("" : "+s"(lo), "+s"(hi)); return (kargp_t)(((unsigned long long)hi << 32) | lo); }
DI const float* kin(kargp_t kp, int i) { return (const float*)kp[i]; }
DI LayerW layer_w(kargp_t kp, int l) {
    LayerW L;
    L.f1pre = kin(kp, 2) + (size_t)l * D; L.f1g = kin(kp, 3) + (size_t)l * D * FF; L.f1u = kin(kp, 4) + (size_t)l * D * FF; L.f1d = kin(kp, 5) + (size_t)l * FF * D; L.f1post = kin(kp, 6) + (size_t)l * D;
    L.mixpre = kin(kp, 7) + (size_t)l * D; L.win = kin(kp, 8) + (size_t)l * D * NIN; L.pek = kin(kp, 9) + (size_t)l * 4096; L.pev = kin(kp, 10) + (size_t)l * 4096;
    L.c1k = kin(kp, 11) + (size_t)l * 4096 * 256; L.c2k = kin(kp, 12) + (size_t)l * 256 * 128; L.c1v = kin(kp, 13) + (size_t)l * 4096 * 256; L.c2v = kin(kp, 14) + (size_t)l * 256 * 128;
    L.memg = kin(kp, 15) + (size_t)l * D; L.wmkv = kin(kp, 16) + (size_t)l * D * 1024; L.wupa = kin(kp, 17) + (size_t)l * 768 * D; L.wupb = kin(kp, 18) + (size_t)l * 256 * D; L.wupm = kin(kp, 19) + (size_t)l * 512 * D;
    L.wout = kin(kp, 20) + (size_t)l * D * D; L.mixpost = kin(kp, 21) + (size_t)l * D; L.f2pre = kin(kp, 22) + (size_t)l * D; L.f2g = kin(kp, 23) + (size_t)l * D * FF; L.f2u = kin(kp, 24) + (size_t)l * D * FF;
    L.f2d = kin(kp, 25) + (size_t)l * FF * D; L.f2post = kin(kp, 26) + (size_t)l * D;
    return L;
}

__global__ void __launch_bounds__(NTHREADS, 2) mk_fwd(Args args) {
    extern __shared__ __attribute__((aligned(16))) unsigned char lds_raw[];
    LAS unsigned char* lds = (LAS unsigned char*)lds_raw;
    const int G = gridDim.x, bx = blockIdx.x;
    const int wave0 = __builtin_amdgcn_readfirstlane((int)threadIdx.x >> 6);
#define MK_TID() (wave0 * 64 + lane_id_v())
    { const int tid0 = MK_TID();
      for (int u = tid0; u < (LDS_BYTES - LDSCTL_OFF) / 4; u += NTHREADS) ((LAS unsigned*)(lds + LDSCTL_OFF))[u] = 0u; }
    __syncthreads();
#if MK_ONE_LAUNCH
    XcdBarrier bar = xcd_barrier_post((unsigned*)((unsigned char*)kargs_opaque()[28] + WS_CTL) + CW_BAR, (volatile LAS unsigned*)(lds + MISC_OFF + 32), MK_TID());
#define GRID_BAR() xcd_barrier(bar, MK_TID())
#else
#define GRID_BAR() do { } while (0)
#endif
    const int lo = args.ph_lo, hi = args.ph_hi;
#define IN(k) (lo <= (k) && (k) < hi)
#define SEAM(k) do { if (IN(k) && IN((k) + 1)) GRID_BAR(); } while (0)
#ifndef PROBE_MASK
#define PROBE_MASK 0
#endif
#define PH_BEGIN(k) {
#define PH_END(k) }
#define PHASE_VIEWS() const kargp_t kp = kargs_opaque(); WsPtrs W; W.ws = (unsigned char*)kp[28]; float* const outp = (float*)kp[27]; (void)outp; const int tid = opaque_v(MK_TID()), lane = tid & 63, wave = wave0; \
    const int bxp = opaque_s(bx), Gp = opaque_s(G); const int gw = bxp * NWAVES + wave, NGW = Gp * NWAVES; (void)lane; (void)gw; (void)NGW; (void)W

    if (IN(0)) { PHASE_VIEWS();
        const LayerW L0 = layer_w(kp, 0);
        convert_layer<1>(L0, W, lds, bxp, Gp, tid);
        const float* x = kin(kp, 0);
        norm_phase_first(x, (bf16*)outp, W.RS(), T, gw, NGW, lane);
    }
    SEAM(0);
#pragma unroll 1
    for (int l = 0; l < DEPTH; ++l) {
        const int pb = 1 + NPL * l;
        if (IN(pb + 0)) { PH_BEGIN(0) PHASE_VIEWS(); pg8::Gemm g{(const bf16*)outp, W.wgu1(), T, 2 * FF, D}; pg8::StaticOrder S; S.init(T, 2 * FF, Gp, bxp); pg8::EpiSwiGLU E{W.HID(), FF, W.RS()};
            pg8::gemm_phase<pg8::EpiSwiGLU, pg8::StaticOrder, true, true>(lds, g, S, E, tid); PH_END(0) }
        SEAM(pb + 0);
        if (IN(pb + 1)) { PH_BEGIN(1) PHASE_VIEWS(); pg8::Gemm g{W.HID(), W.wd1(), T, D, FF}; pg8::StaticOrder S; S.init(T, D, Gp, bxp, 2); S.rev = 1; pg8::EpiBf16 E{W.F(), D, 1 << 30, 0, nullptr, 0, nullptr};
            pg8::gemm_phase<pg8::EpiBf16, pg8::StaticOrder, true, true>(lds, g, S, E, tid); PH_END(1) }
        SEAM(pb + 1);
        if (IN(pb + 2)) { PHASE_VIEWS(); const LayerW LW = layer_w(kp, opaque_s(l));
            bf16* hA = (bf16*)outp; const float* mem = kin(kp, 1);
            norm_phase_res<false, false>(hA, W.F(), LW.f1post, 0.5f, hA, W.RS(), gw, NGW, lane);
            norm_phase_first(mem, hA + (size_t)T * D, W.RS() + T, BATCH * MEML, gw, NGW, lane);
        }
        SEAM(pb + 2);
        if (IN(pb + 3)) { PH_BEGIN(3) PHASE_VIEWS(); pg8::Gemm g{(const bf16*)outp, W.win(), TM, NWIN, D}; pg8::OrderPlusExtra S; S.init(T, QP, Gp, bxp); S.nextra = 8; S.pm0 = T / 256; S.pn0 = QP / 256; S.ncx = 4;
            pg8::EpiBf16 E{W.QKV(), QP, T / 256, QP / 256, W.MEMKV(), 1024, W.RS()};
            pg8::gemm_phase<pg8::EpiBf16, pg8::OrderPlusExtra, true, true>(lds, g, S, E, tid); PH_END(3) }
        SEAM(pb + 3);
        if (IN(pb + 4)) { PH_BEGIN(4) PHASE_VIEWS();
#pragma unroll 1
            for (int it = bxp; it < 256; it += Gp) { const int tidu = opaque_v(MK_TID()); const LaneIx LX = lane_ix(tidu); cmp_unit(W, lds, it, tidu, wave, LX); }
            key_norms(W, gw, NGW, lane);
            __syncthreads();
        PH_END(4) }
        SEAM(pb + 4);
        if (IN(pb + 5)) { PH_BEGIN(5) PHASE_VIEWS();
#pragma unroll 1
            for (int it = bxp; it < 256; it += Gp) { const int tidu = opaque_v(MK_TID()); const LaneIx LX = lane_ix(tidu); nsa_unit(W, lds, ((it & 7) << 5) | ((it >> 3) & 31), tidu, wave, LX); }
            gu32* qhead = (gu32*)(W.ws + WS_CTL) + CW_QUEUE + 64 * opaque_s(l);
            volatile LAS int* qslot = (volatile LAS int*)(lds + MISC_OFF + 64);
#pragma unroll 1
            for (;;) {
                __syncthreads();
                if (MK_TID() == 0) *qslot = (int)__hip_atomic_fetch_add(qhead, 1u, RLX_AGENT);
                __syncthreads();
                int it = __builtin_amdgcn_readfirstlane(*qslot);
                const int nca = (l == 0) ? NCONVQ : 0, ncb = (l + 1 < DEPTH) ? NCONVQ : 0, ncv = nca + ncb;
                if (it >= ncv + 512 + 1536) break;
                const int tidu = opaque_v(MK_TID());
                if (it < nca) { const LayerW LC = layer_w(kp, opaque_s(l)); convert_layer<2>(LC, W, lds, it, NCONVQ, tidu); continue; }
                if (it < ncv) { const LayerW LN = layer_w(kp, opaque_s(l + 1)); convert_layer<1>(LN, W, lds, it - nca, NCONVQ, tidu); continue; }
                it -= ncv;
                const LaneIx LX = lane_ix(tidu);
                if (it < 512) mem_unit(W, lds, it, tidu, wave, LX); else dil_unit(W, lds, it - 512, tidu, wave, LX);
            }
            __syncthreads();
        PH_END(5) }
        SEAM(pb + 5);
        if (IN(pb + 6)) { PH_BEGIN(6) PHASE_VIEWS();
            dil_merge(W, bxp * NTHREADS + tid, Gp * NTHREADS);
            { pg8::Gemm g{W.YA(), W.wupa(), T, D, 768}; pg8::StaticOrder S; S.init(T, D, Gp, bxp); pg8::EpiBf16 E{W.P(), D, 1 << 30, 0, nullptr, 0, nullptr}; pg8::gemm_phase<pg8::EpiBf16, pg8::StaticOrder, true, true>(lds, g, S, E, tid); }
            { pg8::Gemm g{W.YM(), W.wupm(), T, D, 512}; pg8::StaticOrder S; S.init(T, D, Gp, bxp); pg8::EpiBf16 E{W.P() + (size_t)2 * T * D, D, 1 << 30, 0, nullptr, 0, nullptr}; pg8::gemm_phase<pg8::EpiBf16, pg8::StaticOrder, true, true>(lds, g, S, E, tid); }
        PH_END(6) }
        SEAM(pb + 6);
        if (IN(pb + 7)) { PH_BEGIN(7) PHASE_VIEWS();
            { pg8::Gemm g{W.YB(), W.wupb(), T, D, 256}; pg8::StaticOrder S; S.init(T, D, Gp, bxp); pg8::EpiBf16 E{W.P() + (size_t)T * D, D, 1 << 30, 0, nullptr, 0, nullptr}; pg8::gemm_phase<pg8::EpiBf16, pg8::StaticOrder, true, true>(lds, g, S, E, tid); }
        PH_END(7) }
        SEAM(pb + 7);
        if (IN(pb + 8)) { PHASE_VIEWS(); pg8::Gemm g{(const bf16*)outp, W.wgate(), T, 3 * D, D}; pg8::OrderTriple S; S.init(T, D, Gp, bxp); pg8::EpiGateMerge E{W.P(), (size_t)T * D, D, W.RS()};
            pg8::gemm_phase<pg8::EpiGateMerge, pg8::OrderTriple, true, true>(lds, g, S, E, tid); }
        SEAM(pb + 8);
        if (IN(pb + 9)) { PH_BEGIN(9) PHASE_VIEWS(); pg8::Gemm g{W.P(), W.wout(), T, D, D}; pg8::StaticOrder S; S.init(T, D, Gp, bxp); pg8::EpiBf16 E{W.F(), D, 1 << 30, 0, nullptr, 0, nullptr};
            pg8::gemm_phase<pg8::EpiBf16, pg8::StaticOrder, true, true>(lds, g, S, E, tid); PH_END(9) }
        SEAM(pb + 9);
        if (IN(pb + 10)) { PHASE_VIEWS(); const LayerW LW = layer_w(kp, opaque_s(l));
            norm_phase_res<false, false>((const bf16*)outp, W.F(), LW.mixpost, 1.0f, W.HB(), W.RS(), gw, NGW, lane);
        }
        SEAM(pb + 10);
        if (IN(pb + 11)) { PH_BEGIN(11) PHASE_VIEWS(); pg8::Gemm g{W.HB(), W.wgu2(), T, 2 * FF, D}; pg8::StaticOrder S; S.init(T, 2 * FF, Gp, bxp); pg8::EpiSwiGLU E{W.HID(), FF, W.RS()};
            pg8::gemm_phase<pg8::EpiSwiGLU, pg8::StaticOrder, true, true>(lds, g, S, E, tid); PH_END(11) }
        SEAM(pb + 11);
        if (IN(pb + 12)) { PH_BEGIN(12) PHASE_VIEWS(); pg8::Gemm g{W.HID(), W.wd2(), T, D, FF}; pg8::StaticOrder S; S.init(T, D, Gp, bxp, 2); S.rev = 1; pg8::EpiBf16 E{W.F(), D, 1 << 30, 0, nullptr, 0, nullptr};
            pg8::gemm_phase<pg8::EpiBf16, pg8::StaticOrder, true, true>(lds, g, S, E, tid); PH_END(12) }
        SEAM(pb + 12);
        if (IN(pb + 13)) { PHASE_VIEWS(); const LayerW LW = layer_w(kp, opaque_s(l));
            const bool more = (l + 1 < DEPTH);
            const LayerW LN = layer_w(kp, opaque_s(more ? l + 1 : l));
            if (more) norm_phase_res<false, false>(W.HB(), W.F(), LW.f2post, 0.5f, (bf16*)outp, W.RS(), gw, NGW, lane);
            else norm_phase_res<false, true>(W.HB(), W.F(), LW.f2post, 0.5f, outp, nullptr, gw, NGW, lane);
            if (more) { __syncthreads(); convert_layer<2>(LN, W, lds, bxp, Gp, tid); }
        }
        SEAM(pb + 13);
    }
#undef IN
#undef SEAM
}

extern "C" void kernel_launch(void* const* d_in, const int* in_sizes, int n_in, void* d_out, int out_size, void* d_ws, size_t ws_size, hipStream_t stream) {
    static int grid = 0;
    if (grid == 0) {
        if (n_in != 27 || in_sizes[0] != T * D || out_size != T * D || ws_size < WS_END) { fprintf(stderr, "kernel_launch: unexpected shapes (n_in %d, in0 %d, out %d, ws %zu, need %zu); nothing launched\n", n_in, n_in > 0 ? in_sizes[0] : -1, out_size, ws_size, (size_t)WS_END); grid = -1; return; }
        int dev = 0, cus = 0, per_cu = 0;
        if (hipGetDevice(&dev) != hipSuccess || hipDeviceGetAttribute(&cus, hipDeviceAttributeMultiprocessorCount, dev) != hipSuccess) { grid = -1; return; }
        if (hipFuncSetAttribute((const void*)mk_fwd, hipFuncAttributeMaxDynamicSharedMemorySize, LDS_BYTES) != hipSuccess) { fprintf(stderr, "kernel_launch: hipFuncSetAttribute failed\n"); grid = -1; return; }
        if (hipOccupancyMaxActiveBlocksPerMultiprocessor(&per_cu, (const void*)mk_fwd, NTHREADS, LDS_BYTES) != hipSuccess || per_cu < 1) fprintf(stderr, "kernel_launch: note: occupancy query reports %d\n", per_cu);
        (void)hipGetLastError();
        grid = cus;
    }
    if (grid < 0) return;
    if (hipMemsetAsync((char*)d_ws + WS_CTL, 0, CTL_ZERO_BYTES, stream) != hipSuccess) return;
    Args a{};
    for (int i = 0; i < 27; ++i) a.in[i] = (const float*)d_in[i];
    a.out = (float*)d_out; a.ws = (unsigned char*)d_ws;
#if MK_ONE_LAUNCH
    a.ph_lo = 0; a.ph_hi = NPH;
    hipLaunchKernelGGL(mk_fwd, dim3(grid), dim3(NTHREADS), LDS_BYTES, stream, a);
#else
    for (int p = 0; p < NPH; ++p) { a.ph_lo = p; a.ph_hi = p + 1; const int reps = ((p >= 1 && ((PROBE_MASK >> ((p - 1) % NPL)) & 1)) || (p == 0 && ((PROBE_MASK >> 13) & 1))) ? 2 : 1;
        for (int r = 0; r < reps; ++r) hipLaunchKernelGGL(mk_fwd, dim3(grid), dim3(NTHREADS), LDS_BYTES, stream, a); }
#endif
}
```

```cpp
#include <hip/hip_runtime.h>
#include <cstdio>
#include <cstdint>

#ifndef MK_ONE_LAUNCH
#define MK_ONE_LAUNCH 1
#endif

namespace pg8 {
#define PG8_LAS __attribute__((address_space(3)))
typedef unsigned short bf16_t;
typedef short bf16x8 __attribute__((ext_vector_type(8)));
typedef float f32x4 __attribute__((ext_vector_type(4)));
typedef unsigned u32x4 __attribute__((ext_vector_type(4)));
constexpr int BM = 256, BK = 64, HALF = 128, HTB = HALF * BK * 2  , STAGE_BYTES = 8 * HTB, NXCD = 8;

__host__ __device__ __forceinline__ int lds_byte(int r, int c) { const int st = (r >> 4) * 2 + (c >> 5), rr = r & 15, cc = c & 31, ob = rr * 64 + cc * 2; return st * 1024 + (ob ^ (((ob >> 9) & 1) << 5)); }
__host__ __device__ __forceinline__ void stage_rc(int b, int& R, int& C) { const int st = b / 1024, sb = b % 1024, swz = sb ^ (((sb >> 9) & 1) << 5); R = (st >> 1) * 16 + swz / 64; C = (st & 1) * 32 + (swz % 64) / 2; }
__host__ __device__ __forceinline__ int perm32(int rho) { const int n = rho >> 4, i = rho & 15; return 8 * (i >> 2) + 4 * n + (i & 3); }

struct Unit { int pm, pn; };
struct Gemm { const bf16_t* A; const bf16_t* Bt; int M, N, K; };

struct StaticOrder {
    int nM, nN, nwg, G, c, WGM, rev;
    __host__ __device__ void init(int M, int N, int G_, int c_, int wgm = 4) { nM = M / BM; nN = N / BM; nwg = nM * nN; G = G_; c = c_; WGM = wgm; rev = 0; }
    __host__ __device__ bool map(long L, Unit& u) const {
        if (L >= nwg) return false;
        int wgid = (int)L; { const int q = nwg / NXCD, r = nwg % NXCD, xcd = wgid % NXCD, off = wgid / NXCD; wgid = (xcd < r ? xcd * (q + 1) : r * (q + 1) + (xcd - r) * q) + off; }
        const int nig = WGM * nN, gid = wgid / nig, fm = gid * WGM, gsz = (nM - fm) < WGM ? (nM - fm) : WGM;
        u.pm = fm + ((wgid % nig) % gsz); u.pn = (wgid % nig) / gsz; if (rev) u.pm = nM - 1 - u.pm; return true;
    }
    __host__ __device__ bool next(int i, Unit& u) const { return map((long)i * G + c, u); }
    __device__ __forceinline__ void a_ready(const Unit&) const {}
    __device__ __forceinline__ void done(const Unit&) const {}
};
template <class Epi, class Sched, bool ALIGN_EPI = false, bool SP2 = false>
__device__ __forceinline__ void gemm_phase(PG8_LAS unsigned char* lds, const Gemm g, const Sched& S, const Epi& E, int tid_in) {
    int tid_ = tid_in; asm volatile("" : "+v"(tid_));
    const int tid = tid_, wid = __builtin_amdgcn_readfirstlane(tid >> 6), lane = tid & 63, wr = wid >> 2, wc = wid & 3, fr = lane & 15, fq = lane >> 4;
    const int K = g.K, nt = K / BK;
    unsigned voffA[2], voffB[2];
#pragma unroll
    for (int i = 0; i < 2; ++i) { int R, C; stage_rc(tid * 16 + i * 8192, R, C); const int Rb = Epi::PERM ? ((R & ~31) + perm32(R & 31)) : R;
        voffA[i] = (unsigned)(R * K + C) * 2u; voffB[i] = (unsigned)(Rb * K + C) * 2u; }
    const size_t kstep = (size_t)(BK * 2);
    const size_t hstep = (size_t)HALF * K * 2;
    const size_t tstep = 2 * hstep;
    const unsigned ldsw = (unsigned)wid * 1024u;
    const int aoff = lds_byte(wr * 64 + fr, fq * 8), boff = lds_byte(wc * 32 + fr, fq * 8);
#define PG8_SA(b, h) (((b) * 2 + (h)) * HTB)
#define PG8_SB(b, h) ((4 + (b) * 2 + (h)) * HTB)
#define PG8_STAGE(bufoff, gbase, voff) do { _Pragma("unroll") for (int _i = 0; _i < 2; ++_i) \
        __builtin_amdgcn_global_load_lds((const unsigned*)((const char*)(gbase) + (voff)[_i]), (PG8_LAS unsigned*)(lds + (bufoff) + ldsw + _i * 8192), 16, 0, 0); } while (0)
#define PG8_LDA(dst, b, h) do { _Pragma("unroll") for (int m = 0; m < 4; ++m) _Pragma("unroll") for (int k = 0; k < 2; ++k) dst[m][k] = *(const PG8_LAS bf16x8*)(lds + PG8_SA(b, h) + aoff + m * 2048 + k * 1024); } while (0)
#define PG8_LDB(dst, b, h) do { _Pragma("unroll") for (int n = 0; n < 2; ++n) _Pragma("unroll") for (int k = 0; k < 2; ++k) dst[n][k] = *(const PG8_LAS bf16x8*)(lds + PG8_SB(b, h) + boff + n * 2048 + k * 1024); } while (0)
#define PG8_MMA(ai, bj, At, Bt) do { __builtin_amdgcn_s_setprio(1); _Pragma("unroll") for (int m = 0; m < 4; ++m) _Pragma("unroll") for (int n = 0; n < 2; ++n) _Pragma("unroll") for (int k = 0; k < 2; ++k) \
        acc[ai][bj][m][n] = __builtin_amdgcn_mfma_f32_16x16x32_bf16(Bt[n][k], At[m][k], acc[ai][bj][m][n], 0, 0, 0); __builtin_amdgcn_s_setprio(0); } while (0)
#define PG8_WAIT_V(n) asm volatile("s_waitcnt vmcnt(" #n ")" ::: "memory")
#define PG8_WAIT_L(n) asm volatile("s_waitcnt lgkmcnt(" #n ")" ::: "memory")
#define PG8_BAR __builtin_amdgcn_s_barrier()
#define PG8_SCHED __builtin_amdgcn_sched_barrier(0)
    Unit cur, nxt; int ui = 0;
    if (!S.next(0, cur)) return;
    f32x4 acc[2][2][4][2];
#pragma unroll
    for (int a = 0; a < 2; ++a)
#pragma unroll
        for (int b = 0; b < 2; ++b)
#pragma unroll
            for (int m = 0; m < 4; ++m)
#pragma unroll
                for (int n = 0; n < 2; ++n) acc[a][b][m][n] = (f32x4){0.f, 0.f, 0.f, 0.f};
    bf16x8 At[4][2], B0[2][2], B1[2][2];
    const char* cA = (const char*)g.A + (size_t)cur.pm * tstep; const char* cB = (const char*)g.Bt + (size_t)cur.pn * tstep;
    S.a_ready(cur);
    if constexpr (SP2) {
        PG8_STAGE(PG8_SB(0, 0), cB, voffB); PG8_STAGE(PG8_SB(0, 1), cB + hstep, voffB); PG8_STAGE(PG8_SA(0, 0), cA, voffA); PG8_STAGE(PG8_SA(0, 1), cA + hstep, voffA);
        if (wr == 1) PG8_BAR;
        PG8_WAIT_V(2); PG8_BAR;
        PG8_STAGE(PG8_SB(1, 0), cB + kstep, voffB); PG8_STAGE(PG8_SA(1, 0), cA + kstep, voffA); PG8_STAGE(PG8_SB(1, 1), cB + hstep + kstep, voffB);
        PG8_WAIT_V(6); PG8_BAR;
    } else {
        PG8_STAGE(PG8_SB(0, 0), cB, voffB); PG8_STAGE(PG8_SA(0, 0), cA, voffA); PG8_STAGE(PG8_SB(0, 1), cB + hstep, voffB); PG8_STAGE(PG8_SA(0, 1), cA + hstep, voffA);
        if (wr == 1) PG8_BAR;
        PG8_WAIT_V(4); PG8_BAR;
        PG8_STAGE(PG8_SB(1, 0), cB + kstep, voffB); PG8_STAGE(PG8_SA(1, 0), cA + kstep, voffA); PG8_STAGE(PG8_SB(1, 1), cB + hstep + kstep, voffB);
        PG8_WAIT_V(6); PG8_BAR;
    }
    for (;;) {
        const bool has_next = S.next(ui + 1, nxt);
        const typename Epi::Pre pre = E.prefetch(cur, wr, fr);
        const char* nA = has_next ? (const char*)g.A + (size_t)nxt.pm * tstep : cA; const char* nB = has_next ? (const char*)g.Bt + (size_t)nxt.pn * tstep : cB;
        for (int t = 0; t < nt; t += 2) {
            const bool last = (t == nt - 2);
            const char* a1 = cA + (size_t)(t + 1) * kstep;
            const char* a2 = last ? nA : cA + (size_t)(t + 2) * kstep; const char* b2 = last ? nB : cB + (size_t)(t + 2) * kstep;
            const char* a3 = a2 + kstep; const char* b3 = b2 + kstep;
            if (last && has_next) S.a_ready(nxt);
            if constexpr (SP2) {
            PG8_LDB(B0, 0, 0); PG8_LDB(B1, 0, 1); PG8_SCHED; PG8_LDA(At, 0, 0); PG8_STAGE(PG8_SA(1, 1), a1 + hstep, voffA);
            PG8_WAIT_V(8); PG8_WAIT_L(0); PG8_BAR; PG8_MMA(0, 0, At, B0); PG8_MMA(0, 1, At, B1); PG8_BAR; PG8_SCHED;
            PG8_LDA(At, 0, 1); PG8_STAGE(PG8_SB(0, 0), b2, voffB); PG8_STAGE(PG8_SB(0, 1), b2 + hstep, voffB); PG8_STAGE(PG8_SA(0, 0), a2, voffA);
            PG8_WAIT_V(8); PG8_WAIT_L(0); PG8_BAR; PG8_MMA(1, 0, At, B0); PG8_MMA(1, 1, At, B1); PG8_BAR; PG8_SCHED;
            PG8_LDB(B0, 1, 0); PG8_LDB(B1, 1, 1); PG8_SCHED; PG8_LDA(At, 1, 0); PG8_STAGE(PG8_SA(0, 1), a2 + hstep, voffA);
            PG8_WAIT_V(8); PG8_WAIT_L(0); PG8_BAR; PG8_MMA(0, 0, At, B0); PG8_MMA(0, 1, At, B1); PG8_BAR; PG8_SCHED;
            PG8_LDA(At, 1, 1); PG8_STAGE(PG8_SB(1, 0), b3, voffB); PG8_STAGE(PG8_SB(1, 1), b3 + hstep, voffB); PG8_STAGE(PG8_SA(1, 0), a3, voffA);
            PG8_WAIT_V(8); PG8_WAIT_L(0); PG8_BAR; PG8_MMA(1, 0, At, B0); PG8_MMA(1, 1, At, B1); PG8_BAR; PG8_SCHED;
            } else {
            PG8_LDB(B0, 0, 0); PG8_SCHED; PG8_LDA(At, 0, 0); PG8_STAGE(PG8_SA(1, 1), a1 + hstep, voffA);
            PG8_WAIT_L(8); PG8_BAR; PG8_WAIT_L(0); PG8_MMA(0, 0, At, B0); PG8_BAR; PG8_SCHED;
            PG8_LDB(B1, 0, 1); PG8_STAGE(PG8_SB(0, 0), b2, voffB);
            PG8_BAR; PG8_WAIT_L(0); PG8_MMA(0, 1, At, B1); PG8_BAR;
            PG8_LDA(At, 0, 1); PG8_STAGE(PG8_SA(0, 0), a2, voffA);
            PG8_BAR; PG8_WAIT_L(0); PG8_MMA(1, 0, At, B0); PG8_BAR; PG8_SCHED;
            PG8_STAGE(PG8_SB(0, 1), b2 + hstep, voffB);
            PG8_WAIT_V(6); PG8_BAR; PG8_MMA(1, 1, At, B1); PG8_BAR;
            PG8_LDB(B0, 1, 0); PG8_SCHED; PG8_LDA(At, 1, 0); PG8_STAGE(PG8_SA(0, 1), a2 + hstep, voffA);
            PG8_WAIT_L(8); PG8_BAR; PG8_WAIT_L(0); PG8_MMA(0, 0, At, B0); PG8_BAR; PG8_SCHED;
            PG8_LDB(B1, 1, 1); PG8_STAGE(PG8_SB(1, 0), b3, voffB);
            PG8_BAR; PG8_WAIT_L(0); PG8_MMA(0, 1, At, B1); PG8_BAR;
            PG8_LDA(At, 1, 1); PG8_STAGE(PG8_SA(1, 0), a3, voffA);
            PG8_BAR; PG8_WAIT_L(0); PG8_MMA(1, 0, At, B0); PG8_BAR; PG8_SCHED;
            PG8_STAGE(PG8_SB(1, 1), b3 + hstep, voffB);
            PG8_WAIT_V(6); PG8_BAR; PG8_MMA(1, 1, At, B1); PG8_BAR;
            }
        }
        if constexpr (ALIGN_EPI) { if (wr == 0) PG8_BAR; }
        if constexpr (!Epi::AFTER_DRAIN) { E(acc, cur, wr, wc, fr, fq, pre); S.done(cur); }
        if (!has_next) break;
#pragma unroll
        for (int a = 0; a < 2; ++a)
#pragma unroll
            for (int b = 0; b < 2; ++b)
#pragma unroll
                for (int m = 0; m < 4; ++m)
#pragma unroll
                    for (int n = 0; n < 2; ++n) acc[a][b][m][n] = (f32x4){0.f, 0.f, 0.f, 0.f};
        cur = nxt; cA = nA; cB = nB; ++ui;
        if constexpr (ALIGN_EPI) { if (wr == 1) PG8_BAR; }
    }
    PG8_WAIT_V(0);
    if constexpr (!ALIGN_EPI) { if (wr == 0) PG8_BAR; }
    PG8_BAR;
    if constexpr (Epi::AFTER_DRAIN) { E.fused(acc, cur, wr, wc, fr, fq, lds, wid, lane); S.done(cur); }
#undef PG8_SA
#undef PG8_SB
#undef PG8_STAGE
#undef PG8_LDA
#undef PG8_LDB
#undef PG8_MMA
#undef PG8_WAIT_V
#undef PG8_WAIT_L
#undef PG8_BAR
#undef PG8_SCHED
}
__device__ __forceinline__ unsigned cvt_pk_bf16(float lo, float hi) { typedef __bf16 bf2 __attribute__((ext_vector_type(2))); bf2 v; v[0] = (__bf16)lo; v[1] = (__bf16)hi; return __builtin_bit_cast(unsigned, v); }
__device__ __forceinline__ float bf_lo(unsigned w) { return __builtin_bit_cast(float, w << 16); }
__device__ __forceinline__ float bf_hi(unsigned w) { return __builtin_bit_cast(float, w & 0xffff0000u); }
__device__ __forceinline__ float sigmoid_f(float x) { return __builtin_amdgcn_rcpf(1.0f + __builtin_amdgcn_exp2f(-1.4426950408889634f * x)); }

struct RowScale { float r[2][4]; };
__device__ __forceinline__ RowScale load_row_scale(const float* R, int row0) { RowScale p;
#pragma unroll
    for (int ai = 0; ai < 2; ++ai)
#pragma unroll
        for (int m = 0; m < 4; ++m) p.r[ai][m] = R ? R[row0 + ai * HALF + m * 16] : 1.0f;
    return p; }
struct EpiBf16 {
    static constexpr bool PERM = true, AFTER_DRAIN = false;
    bf16_t* O; int ldc; int pm_split, pn_split; bf16_t* O2; int ldc2; const float* R;
    typedef RowScale Pre;
    __device__ __forceinline__ Pre prefetch(const Unit& u, int wr, int fr) const { return load_row_scale(R, u.pm * BM + wr * 64 + fr); }
    __device__ __forceinline__ void operator()(const f32x4 (&acc)[2][2][4][2], const Unit& u, int wr, int wc, int fr, int fq, const Pre& pre) const {
        bf16_t* base = O; int ld = ldc, pm = u.pm, pn = u.pn;
        if (pm >= pm_split) { base = O2; ld = ldc2; pm -= pm_split; pn -= pn_split; }
        const int row0 = pm * BM + wr * 64 + fr, col0 = pn * BM + wc * 32 + 8 * fq;
#pragma unroll
        for (int ai = 0; ai < 2; ++ai)
#pragma unroll
            for (int m = 0; m < 4; ++m) { bf16_t* rowp = base + (size_t)(row0 + ai * HALF + m * 16) * ld + col0;
#pragma unroll
                for (int bj = 0; bj < 2; ++bj) { const f32x4 v0 = acc[ai][bj][m][0] * pre.r[ai][m], v1 = acc[ai][bj][m][1] * pre.r[ai][m];
                    u32x4 w; w.x = cvt_pk_bf16(v0[0], v0[1]); w.y = cvt_pk_bf16(v0[2], v0[3]); w.z = cvt_pk_bf16(v1[0], v1[1]); w.w = cvt_pk_bf16(v1[2], v1[3]);
                    *(u32x4*)(rowp + bj * HALF) = w; } }
    }
};
struct EpiSwiGLU {
    static constexpr bool PERM = true, AFTER_DRAIN = false;
    bf16_t* O; int ldc; const float* R;
    typedef RowScale Pre;
    __device__ __forceinline__ Pre prefetch(const Unit& u, int wr, int fr) const { return load_row_scale(R, u.pm * BM + wr * 64 + fr); }
    __device__ __forceinline__ void operator()(const f32x4 (&acc)[2][2][4][2], const Unit& u, int wr, int wc, int fr, int fq, const Pre& pre) const {
        const int row0 = u.pm * BM + wr * 64 + fr, col0 = u.pn * HALF + wc * 32 + 8 * fq;
#pragma unroll
        for (int ai = 0; ai < 2; ++ai)
#pragma unroll
            for (int m = 0; m < 4; ++m) { bf16_t* rowp = O + (size_t)(row0 + ai * HALF + m * 16) * ldc + col0;
                float o[8];
#pragma unroll
                for (int n = 0; n < 2; ++n)
#pragma unroll
                    for (int j = 0; j < 4; ++j) { const float g = acc[ai][0][m][n][j] * pre.r[ai][m], up = acc[ai][1][m][n][j] * pre.r[ai][m]; o[4 * n + j] = g * sigmoid_f(g) * up; }
                u32x4 w; w.x = cvt_pk_bf16(o[0], o[1]); w.y = cvt_pk_bf16(o[2], o[3]); w.z = cvt_pk_bf16(o[4], o[5]); w.w = cvt_pk_bf16(o[6], o[7]);
                *(u32x4*)rowp = w; }
    }
};
struct EpiGateMerge {
    static constexpr bool PERM = true, AFTER_DRAIN = false;
    bf16_t* P; size_t pstride; int ldc; const float* R;
    typedef RowScale Pre;
    __device__ __forceinline__ Pre prefetch(const Unit& u, int wr, int fr) const { return load_row_scale(R, u.pm * BM + wr * 64 + fr); }
    __device__ __forceinline__ void operator()(const f32x4 (&acc)[2][2][4][2], const Unit& u, int wr, int wc, int fr, int fq, const Pre& pre) const {
        const int x = u.pn >> 3, pt = u.pn & 7;
        const int row0 = u.pm * BM + wr * 64 + fr, col0 = pt * BM + wc * 32 + 8 * fq;
        const bf16_t* Px = P + (size_t)x * pstride;
#pragma unroll
        for (int ai = 0; ai < 2; ++ai) {
            u32x4 pw[4][2], mw[4][2];
#pragma unroll
            for (int m = 0; m < 4; ++m)
#pragma unroll
                for (int bj = 0; bj < 2; ++bj) { const size_t off = (size_t)(row0 + ai * HALF + m * 16) * ldc + col0 + bj * HALF;
                    pw[m][bj] = *(const u32x4*)(Px + off); mw[m][bj] = (u32x4){0u, 0u, 0u, 0u}; if (x > 0) mw[m][bj] = *(const u32x4*)(P + off); }
#pragma unroll
            for (int m = 0; m < 4; ++m)
#pragma unroll
                for (int bj = 0; bj < 2; ++bj) { const size_t off = (size_t)(row0 + ai * HALF + m * 16) * ldc + col0 + bj * HALF;
                    const f32x4 v0 = acc[ai][bj][m][0] * pre.r[ai][m], v1 = acc[ai][bj][m][1] * pre.r[ai][m]; const u32x4 p = pw[m][bj], q = mw[m][bj];
                    float o[8];
                    o[0] = sigmoid_f(v0[0]) * bf_lo(p.x) + bf_lo(q.x); o[1] = sigmoid_f(v0[1]) * bf_hi(p.x) + bf_hi(q.x); o[2] = sigmoid_f(v0[2]) * bf_lo(p.y) + bf_lo(q.y); o[3] = sigmoid_f(v0[3]) * bf_hi(p.y) + bf_hi(q.y);
                    o[4] = sigmoid_f(v1[0]) * bf_lo(p.z) + bf_lo(q.z); o[5] = sigmoid_f(v1[1]) * bf_hi(p.z) + bf_hi(q.z); o[6] = sigmoid_f(v1[2]) * bf_lo(p.w) + bf_lo(q.w); o[7] = sigmoid_f(v1[3]) * bf_hi(p.w) + bf_hi(q.w);
                    u32x4 w; w.x = cvt_pk_bf16(o[0], o[1]); w.y = cvt_pk_bf16(o[2], o[3]); w.z = cvt_pk_bf16(o[4], o[5]); w.w = cvt_pk_bf16(o[6], o[7]);
                    *(u32x4*)(P + off) = w; }
        }
    }
};
struct OrderPlusExtra : StaticOrder {
    int nextra, pm0, pn0, ncx;
    __device__ bool next(int i, Unit& u) const { const long L = (long)i * G + c; if (L < nwg) return map(L, u);
        const long e = L - nwg; if (e >= nextra) return false; u.pm = pm0 + (int)(e / ncx); u.pn = pn0 + (int)(e % ncx); return true; }
};
struct OrderTriple : StaticOrder {
    __device__ bool next(int i, Unit& u) const { const int i3 = i / 3, x = i - 3 * i3; if (!map((long)i3 * G + c, u)) return false; u.pn += 8 * x; return true; }
};
}
constexpr int D = 2048, BATCH = 2, SEQ = 16384, T = BATCH * SEQ, DEPTH = 2, MEML = 256, FF = 5504;
constexpr int TM = T + BATCH * MEML;
constexpr int NIN = 11282;
constexpr float EPS = 1e-6f;
constexpr float LOG2E = 1.4426950408889634f;
constexpr int QP = 5376;
constexpr int C_QA = 0, C_KC = 768, C_VC = 1024, C_KS = 1280, C_VS = 1536, C_KW = 1792, C_VW = 2048, C_QB = 2304, C_KB = 3072, C_VB = 3840, C_QM = 4608, C_GN = 5120;
constexpr int SRC_GN = 2304, SRC_QB = 2322, SRC_GATES = 5138;
constexpr int NWIN = QP + 1024;
constexpr int NCMP = 1023;

constexpr size_t MiB = 1u << 20;
constexpr size_t WS_CTL = 0, CTL_ZERO_BYTES = 1 * MiB;
constexpr size_t SZ_WGU = (size_t)2 * FF * D * 2, SZ_WD = (size_t)D * FF * 2;
constexpr size_t WS_WGU1 = 1 * MiB, WS_WD1 = WS_WGU1 + SZ_WGU, WS_WGU2 = WS_WD1 + SZ_WD, WS_WD2 = WS_WGU2 + SZ_WGU;
constexpr size_t WS_WIN = WS_WD2 + SZ_WD, WS_WGATE = WS_WIN + (size_t)NWIN * D * 2;
constexpr size_t WS_WC1K = WS_WGATE + (size_t)3 * D * D * 2, WS_WC1V = WS_WC1K + 2 * MiB, WS_WC2K = WS_WC1V + 2 * MiB, WS_WC2V = WS_WC2K + 65536;
constexpr size_t WS_CBIAS = WS_WC2V + 65536;
constexpr size_t WS_WUPA = WS_CBIAS + 65536, WS_WUPB = WS_WUPA + (size_t)D * 768 * 2, WS_WUPM = WS_WUPB + (size_t)D * 256 * 2, WS_WOUT = WS_WUPM + (size_t)D * 512 * 2;
constexpr size_t WS_U = WS_WOUT + (size_t)D * D * 2;
constexpr size_t WS_R2 = WS_U + (size_t)TM * D * 2;
constexpr size_t WS_F = WS_R2;
constexpr size_t WS_HID = WS_F + (size_t)T * D * 2;
constexpr size_t WS_YA = WS_HID, WS_YB = WS_YA + (size_t)T * 768 * 2, WS_YM = WS_YB + (size_t)T * 256 * 2;
constexpr size_t WS_MEMKV = WS_YM + (size_t)T * 512 * 2;
constexpr size_t WS_KCMP = WS_MEMKV + 1 * MiB, WS_VCMP = WS_KCMP + 1 * MiB;
constexpr size_t WS_DILL = WS_VCMP + 1 * MiB;
constexpr size_t WS_P = WS_DILL + 2 * MiB;
constexpr size_t WS_DILO = WS_P;
constexpr size_t WS_QKV = WS_DILO + (size_t)3 * T * 256 * 2;
constexpr size_t WS_QKV_END = WS_QKV + (size_t)(T + 64) * QP * 2;
constexpr size_t WS_P_END = WS_P + (size_t)3 * T * D * 2;
constexpr size_t WS_HID_END = WS_HID + (size_t)T * FF * 2;
constexpr size_t WS_HB = WS_HID_END;
static_assert(WS_HB + (size_t)T * D * 2 <= WS_P_END, "WS_HB must fit in the dead P region");
constexpr size_t WS_END = (WS_QKV_END > WS_P_END ? (WS_QKV_END > WS_HID_END ? WS_QKV_END : WS_HID_END) : (WS_P_END > WS_HID_END ? WS_P_END : WS_HID_END));
static_assert(WS_END < (size_t)1040 * MiB, "workspace map exceeds the guaranteed d_ws size");
constexpr int CW_TMO = 0;
constexpr int CW_BAR = 4096;
constexpr int CW_QUEUE = 16384;
constexpr size_t WS_KNS = WS_CTL + 262144;
constexpr size_t WS_RS = WS_CTL + 524288;
constexpr size_t WS_KNC = WS_KNS + 16384;

constexpr int NWAVES = 8, NTHREADS = NWAVES * 64;
constexpr int RING_BYTES = 131072;
constexpr int LDSCTL_OFF = 145408, MISC_OFF = LDSCTL_OFF + 320;
constexpr int LDS_BYTES = 147456;

#define GAS __attribute__((address_space(1)))
#define LAS __attribute__((address_space(3)))
#define DI __device__ __forceinline__
typedef unsigned short bf16;
typedef unsigned v4u __attribute__((ext_vector_type(4)));
typedef unsigned v2u __attribute__((ext_vector_type(2)));
typedef float f32x4 __attribute__((ext_vector_type(4)));
typedef float f32x16 __attribute__((ext_vector_type(16)));
typedef short bf16x8 __attribute__((ext_vector_type(8)));
typedef short s16x4 __attribute__((ext_vector_type(4)));
typedef GAS unsigned gu32;
#define RLX_AGENT __ATOMIC_RELAXED, __HIP_MEMORY_SCOPE_AGENT
#define LDS_WAIT() asm volatile("s_waitcnt lgkmcnt(0)" ::: "memory")
#define VM_WAIT() asm volatile("s_waitcnt vmcnt(0)" ::: "memory")
DI unsigned pk2(float lo, float hi) { return pg8::cvt_pk_bf16(lo, hi); }
DI float bflo(unsigned w) { return __builtin_bit_cast(float, w << 16); }
DI float bfhi(unsigned w) { return __builtin_bit_cast(float, w & 0xffff0000u); }
DI float bf2f(bf16 v) { return __builtin_bit_cast(float, (unsigned)v << 16); }
DI float ex2(float x) { return __builtin_amdgcn_exp2f(x); }
DI float sigm(float x) { return __builtin_amdgcn_rcpf(1.0f + ex2(-LOG2E * x)); }
DI float wave_sum(float v) {
#pragma unroll
    for (int o = 1; o < 64; o <<= 1) v += __shfl_xor(v, o);
    return v;
}
DI unsigned char* opaque_p(unsigned char* p) { unsigned long long v = (unsigned long long)p; unsigned lo = (unsigned)v, hi = (unsigned)(v >> 32); asm volatile("" : "+s"(lo), "+s"(hi)); return (unsigned char*)(((unsigned long long)hi << 32) | lo); }
DI int opaque_v(int v) { asm volatile("" : "+v"(v)); return v; }
DI int opaque_s(int v) { asm volatile("" : "+s"(v)); return v; }
DI int lane_id_v() { int l; asm volatile("v_mbcnt_lo_u32_b32 %0, -1, 0\n\tv_mbcnt_hi_u32_b32 %0, -1, %0" : "=&v"(l)); return l; }
typedef float f32x2g __attribute__((ext_vector_type(2)));
template <class F, class R>
DI void conv_matrix2(F colptr, R drow, int pitch, int K, int nrows, bf16* WT, LAS float* scr, int bx, int G, int tid, const float* gain = nullptr) {
    const int nkb = K / 64, nnb = nrows / 128, nitems = nnb * nkb, wave = tid >> 6, lane = tid & 63;
    f32x2g v[8], w[8], x2[8], y2[8];
    auto issue = [&](int item, f32x2g (&dst)[8]) { const int kb = item / nnb, nb = item - kb * nnb; const float* cp = colptr(128 * nb + 2 * lane);
        const float* cq = cp ? cp : colptr(0);
#pragma unroll
        for (int i = 0; i < 8; ++i) { const f32x2g x = *(const GAS f32x2g*)(cq + (size_t)(64 * kb + 8 * wave + i) * pitch); dst[i] = cp ? x : (f32x2g){0.f, 0.f}; } };
    auto issue_c = [&](int item, f32x2g (&dst)[8]) { issue(item < nitems ? item : nitems - 1, dst); };
    int it = bx;
    if (it < nitems) { issue_c(it, v); issue_c(it + G, w); issue_c(it + 2 * G, x2); }
#pragma unroll 1
    for (; it < nitems; it += G) {
        issue_c(it + 3 * G, y2);
        __builtin_amdgcn_sched_barrier(0);
        const int kb = it / nnb, nb = it - kb * nnb, k0 = 64 * kb, d0 = drow(128 * nb);
#pragma unroll
        for (int i = 0; i < 8; ++i) { const float gk = gain ? gain[k0 + 8 * wave + i] : 1.0f;
            scr[(8 * wave + i) * 129 + 2 * lane] = v[i].x * gk; scr[(8 * wave + i) * 129 + 2 * lane + 1] = v[i].y * gk; }
        __syncthreads();
        const int c = lane & 7;
#pragma unroll
        for (int j = 0; j < 2; ++j) { const int n = 16 * wave + (lane >> 3) + 8 * j; const LAS float* s = scr + (8 * c) * 129 + n;
            v4u o; o.x = pk2(s[0 * 129], s[1 * 129]); o.y = pk2(s[2 * 129], s[3 * 129]); o.z = pk2(s[4 * 129], s[5 * 129]); o.w = pk2(s[6 * 129], s[7 * 129]);
            *(GAS v4u*)(WT + (size_t)(d0 + n) * K + k0 + 8 * c) = o; }
        __syncthreads();
#pragma unroll
        for (int i = 0; i < 8; ++i) { v[i] = w[i]; w[i] = x2[i]; x2[i] = y2[i]; }
    }
}
template <class F>
DI void conv_matrix(F colptr, int pitch, int K, int nrows, bf16* WT, LAS float* scr, int bx, int G, int tid, const float* gain = nullptr) { conv_matrix2(colptr, [](int n) { return n; }, pitch, K, nrows, WT, scr, bx, G, tid, gain); }

struct LayerW {
    const float *f1pre, *f1g, *f1u, *f1d, *f1post, *mixpre, *win, *pek, *pev, *c1k, *c2k, *c1v, *c2v, *memg, *wmkv, *wupa, *wupb, *wupm, *wout, *mixpost, *f2pre, *f2g, *f2u, *f2d, *f2post;
};
struct WsPtrs {
    unsigned char* ws;
#define WSP(name, type, off) DI type* name() const { return (type*)(ws + (off)); }
    WSP(wgu1, bf16, WS_WGU1) WSP(wd1, bf16, WS_WD1) WSP(wgu2, bf16, WS_WGU2) WSP(wd2, bf16, WS_WD2) WSP(win, bf16, WS_WIN) WSP(wgate, bf16, WS_WGATE)
    WSP(wc1k, bf16, WS_WC1K) WSP(wc1v, bf16, WS_WC1V) WSP(wc2k, bf16, WS_WC2K) WSP(wc2v, bf16, WS_WC2V) WSP(cbias, float, WS_CBIAS)
    WSP(wupa, bf16, WS_WUPA) WSP(wupb, bf16, WS_WUPB) WSP(wupm, bf16, WS_WUPM) WSP(wout, bf16, WS_WOUT)
    WSP(U, bf16, WS_U) WSP(F, bf16, WS_F) WSP(HID, bf16, WS_HID) WSP(HB, bf16, WS_HB) WSP(RS, float, WS_RS) WSP(YA, bf16, WS_YA) WSP(YB, bf16, WS_YB) WSP(YM, bf16, WS_YM)
    WSP(MEMKV, bf16, WS_MEMKV) WSP(KCMP, bf16, WS_KCMP) WSP(VCMP, bf16, WS_VCMP) WSP(P, bf16, WS_P) WSP(DILO, bf16, WS_DILO) WSP(QKV, bf16, WS_QKV) WSP(DILL, float, WS_DILL)
#undef WSP
};

template <int PART>
DI void convert_layer(const LayerW& L, const WsPtrs& W, LAS unsigned char* lds, int bx, int G, int tid) {
    LAS float* scr = (LAS float*)lds; const int wave = tid >> 6, lane = tid & 63, gw = bx * NWAVES + wave, NGW = G * NWAVES;
    if constexpr (PART != 2) {
    { const float* s = L.f1g; conv_matrix2([=](int r) { return s + r; }, [](int n) { return (n >> 7) * 256 + (n & 127); }, FF, D, FF, W.wgu1(), scr, bx, G, tid, L.f1pre); }
    { const float* s = L.f1u; conv_matrix2([=](int r) { return s + r; }, [](int n) { return (n >> 7) * 256 + (n & 127) + 128; }, FF, D, FF, W.wgu1(), scr, bx, G, tid, L.f1pre); }
    { const float* s = L.f1d; conv_matrix([=](int r) { return s + r; }, D, FF, D, W.wd1(), scr, bx, G, tid); }
    { const float* s = L.win; conv_matrix([=](int r) -> const float* { if (r < C_QB) return s + r; if (r < C_GN) return s + (r - C_QB + SRC_QB); if (r < C_GN + 18) return s + (r - C_GN + SRC_GN); return nullptr; }, NIN, D, QP, W.win(), scr, bx, G, tid, L.mixpre); }
    { const float* s = L.wmkv; conv_matrix([=](int r) { return s + r; }, 1024, D, 1024, W.win() + (size_t)QP * D, scr, bx, G, tid, L.memg); }
    { const float* s = L.c1k; conv_matrix([=](int r) { return s + r; }, 256, 4096, 256, W.wc1k(), scr, bx, G, tid); }
    { const float* s = L.c1v; conv_matrix([=](int r) { return s + r; }, 256, 4096, 256, W.wc1v(), scr, bx, G, tid); }
    { const float* s = L.c2k; conv_matrix([=](int r) { return s + r; }, 128, 256, 128, W.wc2k(), scr, bx, G, tid); }
    { const float* s = L.c2v; conv_matrix([=](int r) { return s + r; }, 128, 256, 128, W.wc2v(), scr, bx, G, tid); }
    }
    if constexpr (PART != 1) {
    { const float* s = L.f2g; conv_matrix2([=](int r) { return s + r; }, [](int n) { return (n >> 7) * 256 + (n & 127); }, FF, D, FF, W.wgu2(), scr, bx, G, tid, L.f2pre); }
    { const float* s = L.f2u; conv_matrix2([=](int r) { return s + r; }, [](int n) { return (n >> 7) * 256 + (n & 127) + 128; }, FF, D, FF, W.wgu2(), scr, bx, G, tid, L.f2pre); }
    { const float* s = L.f2d; conv_matrix([=](int r) { return s + r; }, D, FF, D, W.wd2(), scr, bx, G, tid); }
    { const float* s = L.win; conv_matrix([=](int r) { return s + SRC_GATES + r; }, NIN, D, 3 * D, W.wgate(), scr, bx, G, tid, L.mixpre); }
    { const float* s = L.wupa; conv_matrix([=](int r) { return s + r; }, D, 768, D, W.wupa(), scr, bx, G, tid); }
    { const float* s = L.wupb; conv_matrix([=](int r) { return s + r; }, D, 256, D, W.wupb(), scr, bx, G, tid); }
    { const float* s = L.wupm; conv_matrix([=](int r) { return s + r; }, D, 512, D, W.wupm(), scr, bx, G, tid); }
    { const float* s = L.wout; conv_matrix([=](int r) { return s + r; }, D, D, D, W.wout(), scr, bx, G, tid); }
    }
    if constexpr (PART != 2)
    for (int it = gw; it < 512; it += NGW) { const int which = it >> 8, hid = it & 255; const float* pe = which ? L.pev : L.pek; const float* w1 = which ? L.c1v : L.c1k;
        float a = 0.f;
#pragma unroll 8
        for (int i = 0; i < 64; ++i) { const int k = lane + 64 * i; a += pe[k] * w1[(size_t)k * 256 + hid]; }
        a = wave_sum(a);
        if (lane == 0) W.cbias()[which * 256 + hid] = a; }
}

DI void norm_phase_first(const float* xbase, bf16* ubase, float* rs, int nrows, int gw, int NGW, int lane) {
    f32x4 v[8], vn[8];
    auto issue = [&](int m, f32x4 (&d)[8]) { const GAS f32x4* xr = (const GAS f32x4*)(xbase + (size_t)m * D) + lane;
#pragma unroll
        for (int j = 0; j < 8; ++j) d[j] = xr[64 * j]; };
    int m = gw;
    if (m < nrows) issue(m, v);
#pragma unroll 1
    for (; m < nrows; m += NGW) {
        if (m + NGW < nrows) issue(m + NGW, vn);
        __builtin_amdgcn_sched_barrier(0);
        float s = 0.f;
#pragma unroll
        for (int j = 0; j < 8; ++j) s += (v[j].x * v[j].x + v[j].y * v[j].y) + (v[j].z * v[j].z + v[j].w * v[j].w);
        const float r = 1.0f / sqrtf(wave_sum(s) * (1.0f / D) + EPS);
        if (lane == 0) rs[m] = r;
        GAS v2u* o8 = (GAS v2u*)(ubase + (size_t)m * D) + lane;
#pragma unroll
        for (int j = 0; j < 8; ++j) { v2u o; o.x = pk2(v[j].x, v[j].y); o.y = pk2(v[j].z, v[j].w); o8[64 * j] = o; }
#pragma unroll
        for (int j = 0; j < 8; ++j) v[j] = vn[j];
    }
}
template <bool HIN_F32, bool HOUT_F32>
DI void norm_phase_res(const void* hin, const bf16* fbuf, const float* gpost, float cs, void* hout, float* rs, int gw, int NGW, int lane) {
    f32x4 h[HIN_F32 ? 8 : 1], hn[HIN_F32 ? 8 : 1], hn2[HIN_F32 ? 8 : 1]; v2u hb[HIN_F32 ? 1 : 8], hbn[HIN_F32 ? 1 : 8], hbn2[HIN_F32 ? 1 : 8]; v2u fw[8], fwn[8], fwn2[8];
    f32x4 gpv[8];
    { const GAS f32x4* gp = (const GAS f32x4*)gpost + lane;
#pragma unroll
      for (int j = 0; j < 8; ++j) gpv[j] = gp[64 * j]; }
    auto issue = [&](int m, f32x4 (&hd)[HIN_F32 ? 8 : 1], v2u (&hbd)[HIN_F32 ? 1 : 8], v2u (&fd)[8]) { const GAS v2u* fr = (const GAS v2u*)(fbuf + (size_t)m * D) + lane;
        if constexpr (HIN_F32) { const GAS f32x4* hr = (const GAS f32x4*)((const float*)hin + (size_t)m * D) + lane;
#pragma unroll
            for (int j = 0; j < 8; ++j) { hd[j] = __builtin_nontemporal_load(hr + 64 * j); fd[j] = __builtin_nontemporal_load(fr + 64 * j); } }
        else { const GAS v2u* hr = (const GAS v2u*)((const bf16*)hin + (size_t)m * D) + lane;
#pragma unroll
            for (int j = 0; j < 8; ++j) { hbd[j] = __builtin_nontemporal_load(hr + 64 * j); fd[j] = __builtin_nontemporal_load(fr + 64 * j); } } };
    int m = gw;
    if (m < T) issue(m, h, hb, fw);
    if (m + NGW < T) issue(m + NGW, hn, hbn, fwn);
#pragma unroll 1
    for (; m < T; m += NGW) {
        const int mn = m + 2 * NGW;
        if (mn < T) issue(mn, hn2, hbn2, fwn2);
        __builtin_amdgcn_sched_barrier(0);
        f32x4 f[8]; float s0 = 0.f;
#pragma unroll
        for (int j = 0; j < 8; ++j) { f[j] = (f32x4){bflo(fw[j].x), bfhi(fw[j].x), bflo(fw[j].y), bfhi(fw[j].y)}; s0 += (f[j].x * f[j].x + f[j].y * f[j].y) + (f[j].z * f[j].z + f[j].w * f[j].w); }
        const float ra = cs / sqrtf(wave_sum(s0) * (1.0f / D) + EPS);
        float t0 = 0.f;
#pragma unroll
        for (int j = 0; j < 8; ++j) { const f32x4 gg = gpv[j]; f32x4 hv;
            if constexpr (HIN_F32) hv = h[j]; else hv = (f32x4){bflo(hb[j].x), bfhi(hb[j].x), bflo(hb[j].y), bfhi(hb[j].y)};
            f[j] = hv + f[j] * ra * gg; t0 += (f[j].x * f[j].x + f[j].y * f[j].y) + (f[j].z * f[j].z + f[j].w * f[j].w);
            if constexpr (HOUT_F32) { GAS f32x4* ho = (GAS f32x4*)((float*)hout + (size_t)m * D) + lane; __builtin_nontemporal_store(f[j], ho + 64 * j); }
            else { GAS v2u* ho = (GAS v2u*)((bf16*)hout + (size_t)m * D) + lane; v2u a; a.x = pk2(f[j].x, f[j].y); a.y = pk2(f[j].z, f[j].w); ho[64 * j] = a; } }
        if (rs) { const float qa = 1.0f / sqrtf(wave_sum(t0) * (1.0f / D) + EPS); if (lane == 0) rs[m] = qa; }
#pragma unroll
        for (int j = 0; j < 8; ++j) { if constexpr (HIN_F32) { h[j] = hn[j]; hn[j] = hn2[j]; } else { hb[j] = hbn[j]; hbn[j] = hbn2[j]; } fw[j] = fwn[j]; fwn[j] = fwn2[j]; }
    }
}
constexpr float NEGB = -1e30f;
struct LaneIx { int lane, r, h, q4, p4, blk; };
DI LaneIx lane_ix(int tid) { LaneIx L; L.lane = tid & 63; L.r = L.lane & 31; L.h = L.lane >> 5; const int i16 = L.lane & 15; L.q4 = i16 >> 2; L.p4 = i16 & 3; L.blk = (L.lane >> 4) & 1; return L; }
DI f32x16 mfma32(bf16x8 a, bf16x8 b, f32x16 c) { return __builtin_amdgcn_mfma_f32_32x32x16_bf16(a, b, c, 0, 0, 0); }
DI f32x16 zero16() { f32x16 z;
#pragma unroll
    for (int i = 0; i < 16; ++i) z[i] = 0.f;
    return z; }
template <int S> DI bf16x8 pack8(const f32x16& x) { typedef __bf16 bfv8 __attribute__((ext_vector_type(8))); bfv8 v;
#pragma unroll
    for (int j = 0; j < 8; ++j) v[j] = (__bf16)x[8 * S + j];
    return __builtin_bit_cast(bf16x8, v); }
DI s16x4 tr16(LAS const unsigned char* p) { return __builtin_amdgcn_ds_read_tr16_b64_v4i16((LAS s16x4*)p); }
DI bf16x8 cat4(s16x4 lo, s16x4 hi) { return __builtin_shufflevector(lo, hi, 0, 1, 2, 3, 4, 5, 6, 7); }
DI float alibi_slope(int i) { return exp2f(-8.0f * (float)(i + 1) / 18.0f); }

template <int DH> struct FlashSt { f32x16 o[DH / 32]; float m, l; };
template <int DH> DI void flash_init(FlashSt<DH>& st) {
#pragma unroll
    for (int d = 0; d < DH / 32; ++d) st.o[d] = zero16();
    st.m = NEGB; st.l = 0.f; }

template <int DH, int KSTR, int QR>
DI f32x16 qk32(const bf16x8 (&q)[QR], LAS const unsigned char* qx, LAS const unsigned char* Kb, const LaneIx& L) {
    bf16x8 kf[DH / 16], qt[DH / 16 - QR + 1];
#pragma unroll
    for (int ks = 0; ks < DH / 16; ++ks) kf[ks] = *(LAS const bf16x8*)(Kb + L.r * KSTR + (16 * ks + 8 * L.h) * 2);
#pragma unroll
    for (int ks = QR; ks < DH / 16; ++ks) qt[ks - QR] = *(LAS const bf16x8*)(qx + ((ks - QR) * 64 + L.lane) * 16);
    __builtin_amdgcn_sched_barrier(0);
    f32x16 s = zero16();
#pragma unroll
    for (int ks = 0; ks < DH / 16; ++ks) s = mfma32(kf[ks], ks < QR ? q[ks < QR ? ks : 0] : qt[ks < QR ? 0 : ks - QR], s);
    return s; }
constexpr float RESCALE_THR = 8.0f, SKIP_THR = 32.0f;
template <int DH, int KSTR, int VSTR, int QR, class OK>
DI void flash32(FlashSt<DH>& st, const bf16x8 (&q)[QR], LAS const unsigned char* qx, LAS const unsigned char* Kb, LAS const unsigned char* Vb, float c2, const LaneIx& L, bool allvalid, float bias0, float bstep, OK okfn) {
    f32x16 s = qk32<DH, KSTR, QR>(q, qx, Kb, L);
    asm volatile("" : "+v"(bstep));
    const float bl = bias0 + bstep * (float)(4 * L.h);
    float mx = NEGB;
    if (allvalid) {
#pragma unroll
        for (int i = 0; i < 16; ++i) { const float v = s[i] * c2 + (bstep * (float)((i & 3) + 8 * (i >> 2)) + bl); s[i] = v; mx = fmaxf(mx, v); }
    } else {
#pragma unroll
        for (int i = 0; i < 16; ++i) { const int kl = (i & 3) + 8 * (i >> 2) + 4 * L.h; const float v = okfn(kl) ? (s[i] * c2 + (bstep * (float)((i & 3) + 8 * (i >> 2)) + bl)) : NEGB; s[i] = v; mx = fmaxf(mx, v); }
    }
    mx = fmaxf(mx, __shfl_xor(mx, 32));
    if (__all(mx < st.m - SKIP_THR)) return;
    if (!__all(mx <= st.m + RESCALE_THR)) {
        const float mn = fmaxf(st.m, mx), alpha = ex2(st.m - mn);
        st.m = mn; st.l *= alpha;
#pragma unroll
        for (int d = 0; d < DH / 32; ++d)
#pragma unroll
            for (int i = 0; i < 16; ++i) st.o[d][i] *= alpha;
    }
    const float mn = st.m;
    float ps = 0.f;
    if (allvalid) {
#pragma unroll
        for (int i = 0; i < 16; ++i) { const float p = ex2(s[i] - mn); s[i] = p; ps += p; }
    } else {
#pragma unroll
        for (int i = 0; i < 16; ++i) { const float p = (s[i] > -1e29f) ? ex2(s[i] - mn) : 0.f; s[i] = p; ps += p; }
    }
    st.l += ps;
    const bf16x8 p0 = pack8<0>(s), p1 = pack8<1>(s);
    { LAS const unsigned char* vp = Vb + (4 * L.h + L.q4) * VSTR + (16 * L.blk + 4 * L.p4) * 2;
      s16x4 vf[DH / 32][4];
#pragma unroll
      for (int d = 0; d < DH / 32; ++d) { vf[d][0] = tr16(vp + 64 * d); vf[d][1] = tr16(vp + 64 * d + 8 * VSTR); vf[d][2] = tr16(vp + 64 * d + 16 * VSTR); vf[d][3] = tr16(vp + 64 * d + 24 * VSTR); }
      __builtin_amdgcn_sched_barrier(0);
#pragma unroll
      for (int d = 0; d < DH / 32; ++d) { st.o[d] = mfma32(cat4(vf[d][0], vf[d][1]), p0, st.o[d]); st.o[d] = mfma32(cat4(vf[d][2], vf[d][3]), p1, st.o[d]); } }
}
template <int DH> DI float flash_l(const FlashSt<DH>& st) { return st.l + __shfl_xor(st.l, 32); }

template <int DH, int STR, int NR, class RF>
DI void stage_rows(LAS unsigned char* dst, RF rowptr, int tid) {
    constexpr int CPR = DH / 8, TOTAL = NR * CPR, NK = TOTAL / NTHREADS; static_assert(TOTAL % NTHREADS == 0, "stage_rows: chunk count");
    v4u v[NK]; bool okv[NK];
#pragma unroll
    for (int k = 0; k < NK; ++k) { const int id = tid + k * NTHREADS, row = id / CPR, ch = id % CPR; const bf16* p = rowptr(row, okv[k]); v[k] = *(const GAS v4u*)(p + ch * 8); }
#pragma unroll
    for (int k = 0; k < NK; ++k) { const int id = tid + k * NTHREADS, row = id / CPR, ch = id % CPR; const v4u z = (v4u){0u, 0u, 0u, 0u};
        *(LAS v4u*)(dst + row * STR + ch * 16) = okv[k] ? v[k] : z; }
}
template <int DH> DI void store_ot(const f32x16 (&o)[DH / 32], float sc, bf16* orow, const LaneIx& L) {
#pragma unroll
    for (int d = 0; d < DH / 32; ++d)
#pragma unroll
        for (int g4 = 0; g4 < 4; ++g4) { v2u w; w.x = pk2(o[d][4 * g4] * sc, o[d][4 * g4 + 1] * sc); w.y = pk2(o[d][4 * g4 + 2] * sc, o[d][4 * g4 + 3] * sc);
            *(GAS v2u*)(orow + 32 * d + 8 * g4 + 4 * L.h) = w; }
}

constexpr int K64STR = 144, V64STR = 192, K128STR = 272, V128STR = 320;
constexpr float C2_64 = 0.125f * LOG2E, C2_128 = 0.08838834764831845f * LOG2E;
DI void dil_unit(const WsPtrs& W, LAS unsigned char* lds, int idx, int tid, int wave, const LaneIx& L) {
    const int gi = idx >> 9; int rem = idx & 511; const int b = rem >> 8; rem &= 255; const int hd = rem >> 6; rem &= 63;
    const int dsh = 2 * gi, d = 1 << dsh, rs = rem & (d - 1), nt = rem >> dsh;
    const int n0 = nt * 256, nk0 = n0 - 128;
    const bf16* base = W.QKV() + (size_t)b * SEQ * QP + gi * 256 + hd * 64;
    LAS unsigned char* Kt = lds; LAS unsigned char* Vt = lds + 384 * K64STR;
    __syncthreads();
    stage_rows<64, K64STR, 384>(Kt, [&](int i, bool& ok) -> const bf16* { const int n = nk0 + i; ok = n >= 0; return base + (size_t)(((ok ? n : 0) << dsh) + rs) * QP + C_KB; }, tid);
    stage_rows<64, V64STR, 384>(Vt, [&](int i, bool& ok) -> const bf16* { const int n = nk0 + i; ok = n >= 0; return base + (size_t)(((ok ? n : 0) << dsh) + rs) * QP + C_VB; }, tid);
    __syncthreads();
    const int nq = n0 + 32 * wave + L.r, tq = (nq << dsh) + rs;
    const bf16* qrow = base + (size_t)tq * QP + C_QB;
    bf16x8 q[4];
#pragma unroll
    for (int ks = 0; ks < 4; ++ks) q[ks] = *(const GAS bf16x8*)(qrow + 16 * ks + 8 * L.h);
    const float sl2 = alibi_slope(6 * gi + (hd < 2 ? hd + 1 : hd + 2)) * LOG2E * (float)d;
    FlashSt<64> st; flash_init(st);
#pragma unroll 1
    for (int sb = 4; sb >= 0; --sb) { const int kb = 32 * wave + 32 * sb, relb = 128 - 32 * sb + L.r, nkb = nk0 + kb;
        flash32<64, K64STR, V64STR, 4>(st, q, nullptr, Kt + kb * K64STR, Vt + kb * V64STR, C2_64, L, sb >= 1 && sb <= 3 && nkb >= 0, -sl2 * (float)relb, sl2,
            [&](int kl) { const int rel = relb - kl; return rel >= 0 && rel <= 128 && (nkb + kl) >= 0; }); }
    const float l = flash_l(st), inv = 1.0f / l;
    const size_t orow = (size_t)gi * T + (size_t)b * SEQ + tq;
    store_ot<64>(st.o, inv, W.DILO() + orow * 256 + hd * 64, L);
    if (L.h == 0) W.DILL()[orow * 4 + hd] = st.m + log2f(l);
}
DI void dil_merge(const WsPtrs& W, int gtid, int gthreads) {
    for (int it = gtid; it < T * 32; it += gthreads) { const int row = it >> 5, ch = it & 31, hd = ch >> 3;
        const float l0 = W.DILL()[(size_t)row * 4 + hd], l1 = W.DILL()[((size_t)T + row) * 4 + hd], l2 = W.DILL()[((size_t)2 * T + row) * 4 + hd];
        const float mx = fmaxf(l0, fmaxf(l1, l2)); float w0 = ex2(l0 - mx), w1 = ex2(l1 - mx), w2 = ex2(l2 - mx); const float inv = 1.0f / (w0 + w1 + w2); w0 *= inv; w1 *= inv; w2 *= inv;
        const v4u a = *(const GAS v4u*)(W.DILO() + (size_t)row * 256 + ch * 8), bq = *(const GAS v4u*)(W.DILO() + ((size_t)T + row) * 256 + ch * 8), c = *(const GAS v4u*)(W.DILO() + ((size_t)2 * T + row) * 256 + ch * 8);
        v4u o;
        o.x = pk2(w0 * bflo(a.x) + w1 * bflo(bq.x) + w2 * bflo(c.x), w0 * bfhi(a.x) + w1 * bfhi(bq.x) + w2 * bfhi(c.x));
        o.y = pk2(w0 * bflo(a.y) + w1 * bflo(bq.y) + w2 * bflo(c.y), w0 * bfhi(a.y) + w1 * bfhi(bq.y) + w2 * bfhi(c.y));
        o.z = pk2(w0 * bflo(a.z) + w1 * bflo(bq.z) + w2 * bflo(c.z), w0 * bfhi(a.z) + w1 * bfhi(bq.z) + w2 * bfhi(c.z));
        o.w = pk2(w0 * bflo(a.w) + w1 * bflo(bq.w) + w2 * bflo(c.w), w0 * bfhi(a.w) + w1 * bfhi(bq.w) + w2 * bfhi(c.w));
        *(GAS v4u*)(W.YB() + (size_t)row * 256 + ch * 8) = o; }
}
DI void mem_unit(const WsPtrs& W, LAS unsigned char* lds, int idx, int tid, int wave, const LaneIx& L) {
    const int b = idx >> 8, hd = (idx >> 6) & 3, qt = idx & 63;
    const size_t row = (size_t)b * SEQ + 256 * qt + 32 * wave + L.r;
    const bf16* qrow = W.QKV() + row * QP + C_QM + hd * 128;
    bf16x8 q[8];
#pragma unroll
    for (int ks = 0; ks < 8; ++ks) q[ks] = *(const GAS bf16x8*)(qrow + 16 * ks + 8 * L.h);
    LAS unsigned char* Kt = lds; LAS unsigned char* Vt = lds + 128 * K128STR;
    FlashSt<128> st; flash_init(st);
#pragma unroll 1
    for (int half = 0; half < 2; ++half) {
        const bf16* kb = W.MEMKV() + (size_t)(b * MEML + 128 * half) * 1024 + hd * 128;
        __syncthreads();
        stage_rows<128, K128STR, 128>(Kt, [&](int i, bool& ok) -> const bf16* { ok = true; return kb + (size_t)i * 1024; }, tid);
        stage_rows<128, V128STR, 128>(Vt, [&](int i, bool& ok) -> const bf16* { ok = true; return kb + (size_t)i * 1024 + 512; }, tid);
        __syncthreads();
#pragma unroll 1
        for (int sb = 0; sb < 4; ++sb) flash32<128, K128STR, V128STR, 8>(st, q, nullptr, Kt + 32 * sb * K128STR, Vt + 32 * sb * V128STR, C2_128, L, true, 0.f, 0.f, [](int) { return true; });
    }
    const float l = flash_l(st);
    store_ot<128>(st.o, 1.0f / l, W.YM() + row * 512 + hd * 128, L);
}
DI void cmp_unit(const WsPtrs& W, LAS unsigned char* lds, int idx, int tid, int wave, const LaneIx& L) {
    const int which = idx >> 7, rg = idx & 127;
    const bf16* w1t = which ? W.wc1v() : W.wc1k(); const bf16* w2t = which ? W.wc2v() : W.wc2k();
    const int rho = 32 * rg + L.r, b = rho >> 11, c = (rho >> 1) & 1023, g = rho & 1;
    const bf16* src = W.QKV() + (size_t)b * SEQ * QP + (which ? C_VC : C_KC) + g * 128;
    f32x16 hid[8];
#pragma unroll
    for (int i = 0; i < 8; ++i) hid[i] = zero16();
    auto issue = [&](int j, bf16x8 (&af)[8], bf16x8& bf) { const int kt = 8 * wave + (j >> 2), ks = j & 3, pos = kt >> 1, e0 = (kt & 1) * 64; int tok = 16 * c + pos; tok = tok < SEQ ? tok : SEQ - 1;
        bf = *(const GAS bf16x8*)(src + (size_t)tok * QP + e0 + 8 * L.h + 16 * ks);
        const bf16* ap = w1t + (size_t)L.r * 4096 + 64 * kt + 8 * L.h + 16 * ks;
#pragma unroll
        for (int hb = 0; hb < 8; ++hb) af[hb] = *(const GAS bf16x8*)(ap + (size_t)(32 * hb) * 4096); };
    bf16x8 a0[8], a1[8], b0, b1;
    issue(0, a0, b0);
#pragma unroll 1
    for (int j = 0; j < 32; j += 2) {
        issue(j + 1, a1, b1);
        __builtin_amdgcn_sched_barrier(0);
#pragma unroll
        for (int hb = 0; hb < 8; ++hb) hid[hb] = mfma32(a0[hb], b0, hid[hb]);
        __builtin_amdgcn_sched_barrier(0);
        issue(j + 2 < 32 ? j + 2 : 31, a0, b0);
        __builtin_amdgcn_sched_barrier(0);
#pragma unroll
        for (int hb = 0; hb < 8; ++hb) hid[hb] = mfma32(a1[hb], b1, hid[hb]);
        __builtin_amdgcn_sched_barrier(0);
    }
    __syncthreads();
#pragma unroll
    for (int half = 4; half >= 1; half >>= 1) {
        if (wave >= half && wave < 2 * half) { LAS float* slot = (LAS float*)(lds + (wave - half) * 32768);
#pragma unroll
            for (int hb = 0; hb < 8; ++hb)
#pragma unroll
                for (int i = 0; i < 16; ++i) slot[(hb * 16 + i) * 64 + L.lane] = hid[hb][i]; }
        __syncthreads();
        if (wave < half) { const LAS float* slot = (const LAS float*)(lds + wave * 32768);
#pragma unroll
            for (int hb = 0; hb < 8; ++hb)
#pragma unroll
                for (int i = 0; i < 16; ++i) hid[hb][i] += slot[(hb * 16 + i) * 64 + L.lane]; }
        __syncthreads();
    }
    if (wave == 0) {
        const float* cb = W.cbias() + which * 256;
        bf16x8 ph[8][2];
#pragma unroll
        for (int hb = 0; hb < 8; ++hb) {
#pragma unroll
            for (int i = 0; i < 16; ++i) { const float v = hid[hb][i] + cb[32 * hb + (i & 3) + 8 * (i >> 2) + 4 * L.h]; hid[hb][i] = v * sigm(v); }
            ph[hb][0] = pack8<0>(hid[hb]); ph[hb][1] = pack8<1>(hid[hb]); }
        f32x16 out[4];
#pragma unroll
        for (int i = 0; i < 4; ++i) out[i] = zero16();
#pragma unroll
        for (int hb = 0; hb < 8; ++hb) { s16x4 wa[4][4];
#pragma unroll
            for (int ob = 0; ob < 4; ++ob) { const bf16* wr = w2t + (size_t)(32 * ob + L.r) * 256 + 32 * hb + 4 * L.h;
                wa[ob][0] = *(const GAS s16x4*)(wr); wa[ob][1] = *(const GAS s16x4*)(wr + 8); wa[ob][2] = *(const GAS s16x4*)(wr + 16); wa[ob][3] = *(const GAS s16x4*)(wr + 24); }
            __builtin_amdgcn_sched_barrier(0);
#pragma unroll
            for (int ob = 0; ob < 4; ++ob) { out[ob] = mfma32(cat4(wa[ob][0], wa[ob][1]), ph[hb][0], out[ob]); out[ob] = mfma32(cat4(wa[ob][2], wa[ob][3]), ph[hb][1], out[ob]); }
            __builtin_amdgcn_sched_barrier(0);
        }
        bf16* dst = (which ? W.VCMP() : W.KCMP()) + ((size_t)(b * 2 + g) * 1024 + c) * 128;
        store_ot<128>(out, 1.0f, dst, L);
        if (which == 0) {
            float ss = 0.f;
#pragma unroll
            for (int ob = 0; ob < 4; ++ob)
#pragma unroll
                for (int i = 0; i < 16; ++i) ss += out[ob][i] * out[ob][i];
            ss += __shfl_xor(ss, 32);
            if (L.h == 0) ((float*)(W.ws + WS_KNC))[(size_t)(b * 2 + g) * 1024 + c] = sqrtf(ss);
        }
    }
}
DI void key_norms(const WsPtrs& W, int gw, int NGW, int lane) {
#pragma unroll 1
    for (int wu = gw; wu < 2048; wu += NGW) { const int type = wu >> 10, b = (wu >> 9) & 1, g = (wu >> 8) & 1, j = wu & 255;
        const bf16* rp = W.QKV() + ((size_t)b * SEQ + 64 * j + lane) * QP + (type ? C_KW : C_KS) + g * 128;
        v4u x[16];
#pragma unroll
        for (int k = 0; k < 16; ++k) x[k] = *(const GAS v4u*)(rp + 8 * k);
        float ss = 0.f;
#pragma unroll
        for (int k = 0; k < 16; ++k) { ss += bflo(x[k].x) * bflo(x[k].x) + bfhi(x[k].x) * bfhi(x[k].x); ss += bflo(x[k].y) * bflo(x[k].y) + bfhi(x[k].y) * bfhi(x[k].y);
            ss += bflo(x[k].z) * bflo(x[k].z) + bfhi(x[k].z) * bfhi(x[k].z); ss += bflo(x[k].w) * bflo(x[k].w) + bfhi(x[k].w) * bfhi(x[k].w); }
#pragma unroll
        for (int o = 1; o < 64; o <<= 1) ss = fmaxf(ss, __shfl_xor(ss, o));
        if (lane == 0) ((float*)(W.ws + WS_KNS))[wu] = sqrtf(ss); }
}
constexpr int NSA_BUF = 64 * K128STR + 64 * V128STR;
constexpr int NSA_SEL_OFF = 2 * NSA_BUF, NSA_WUN_OFF = NSA_SEL_OFF + 8192, NSA_GUN_OFF = NSA_WUN_OFF + 256, NSA_LIST_OFF = NSA_GUN_OFF + 256, NSA_NLIST_OFF = NSA_LIST_OFF + 2048, NSA_QX_OFF = NSA_NLIST_OFF + 256, NSA_STAT_OFF = NSA_QX_OFF + 8 * 4096;
constexpr int NSA_PM_OFF = NSA_STAT_OFF + 3 * NTHREADS * 8;
constexpr int NSA_PMW_OFF = NSA_PM_OFF + 1024, NSA_PMC_OFF = NSA_PMW_OFF + 1024, NSA_VOTE_OFF = NSA_PMC_OFF + 64;
static_assert(NSA_VOTE_OFF + 64 <= RING_BYTES + 14336, "NSA LDS map");
#ifndef NSA_CUT
#define NSA_CUT 7
#endif
static_assert(256 * K128STR <= NSA_SEL_OFF, "step A stages 256 compressed keys at a time below the masks");
#define TOPN 13
typedef unsigned long long u64;
DI void top_insert(u64 (&tk)[TOPN], u64 c) {
#pragma unroll
    for (int k = 0; k < TOPN; ++k) { const u64 a = tk[k]; const bool gt = c > a; tk[k] = gt ? c : a; c = gt ? a : c; }
}
DI u64 top_key(float score, int j) { return ((u64)__builtin_bit_cast(unsigned, score) << 32) | (u64)(0xffffffffu - (unsigned)j); }
DI void nsa_unit(const WsPtrs& W, LAS unsigned char* lds, int idx, int tid, int wave, const LaneIx& L) {
    const int b = idx >> 7, g = (idx >> 6) & 1, qt = idx & 63;
    const int t0 = qt * 256, tw0 = t0 + 32 * wave, t = tw0 + L.r, cur = t >> 6;
    const bf16* qkvb = W.QKV() + (size_t)b * SEQ * QP;
    const bf16* kcmp = W.KCMP() + (size_t)(b * 2 + g) * 1024 * 128; const bf16* vcmp = W.VCMP() + (size_t)(b * 2 + g) * 1024 * 128;
    LAS unsigned char* Kt = lds; LAS unsigned char* Vt = lds + 64 * K128STR;
    LAS unsigned* selm = (LAS unsigned*)(lds + NSA_SEL_OFF); LAS unsigned* wun = (LAS unsigned*)(lds + NSA_WUN_OFF); LAS unsigned* gun = (LAS unsigned*)(lds + NSA_GUN_OFF);
    int n_c = t0 / 16 + 15; n_c = n_c < NCMP ? n_c : NCMP;
    const int ntile = (n_c + 63) >> 6, wave_cmax = t0 / 16 + 2 * wave;
    float sl2[3];
#pragma unroll
    for (int hh = 0; hh < 3; ++hh) sl2[hh] = alibi_slope(3 * (g * 3 + hh)) * LOG2E;
    if (tid == 0) { LAS unsigned* list = (LAS unsigned*)(lds + NSA_LIST_OFF); for (int i = 0; i < ntile; ++i) list[i] = (unsigned)(ntile - 1 - i); }
    if (wave < 2) { const float* kn = (const float*)(W.ws + WS_KNS) + (size_t)((wave * 2 + b) * 2 + g) * 256; const f32x4 v = *(const GAS f32x4*)(kn + 4 * L.lane);
        float p0 = v.x, p1 = fmaxf(p0, v.y), p2 = fmaxf(p1, v.z), p3 = fmaxf(p2, v.w), c = p3;
#pragma unroll
        for (int o = 1; o < 64; o <<= 1) { const float n = __shfl_up(c, o); if (L.lane >= o) c = fmaxf(c, n); }
        float ex = __shfl_up(c, 1); if (L.lane == 0) ex = 0.f;
        LAS float* pm = (LAS float*)(lds + (wave ? NSA_PMW_OFF : NSA_PM_OFF)) + 4 * L.lane;
        pm[0] = fmaxf(p0, ex); pm[1] = fmaxf(p1, ex); pm[2] = fmaxf(p2, ex); pm[3] = fmaxf(p3, ex); }
    if (wave == 2) { const float* knc = (const float*)(W.ws + WS_KNC) + (size_t)(b * 2 + g) * 1024; float pm = 0.f;
#pragma unroll 1
        for (int i = 0; i < ntile; ++i) { const int c = 64 * i + L.lane; float v = c < NCMP ? knc[c] : 0.f;
#pragma unroll
            for (int o = 1; o < 64; o <<= 1) v = fmaxf(v, __shfl_xor(v, o));
            pm = fmaxf(pm, v); if (L.lane == 0) ((LAS float*)(lds + NSA_PMC_OFF))[i] = pm; } }
    __syncthreads();
#pragma unroll 1
    for (int pass = 0; pass < 6; ++pass) { const int hh = pass < 3 ? pass : pass - 3;
        if (pass == 3) {
        const int tS = opaque_v(t), curS = tS >> 6; const LaneIx LS = lane_ix(opaque_v(tid));
        bf16x8 q3[3][8];
#pragma unroll
        for (int hh = 0; hh < 3; ++hh) { const bf16* qrow = qkvb + (size_t)tS * QP + C_QA + (g * 3 + hh) * 128;
#pragma unroll
            for (int ks = 0; ks < 8; ++ks) q3[hh][ks] = *(const GAS bf16x8*)(qrow + 16 * ks + 8 * LS.h); }
        float m3[3], inv3[3];
        { const LAS float* stf = (const LAS float*)(lds + NSA_STAT_OFF);
#pragma unroll
          for (int hh = 0; hh < 3; ++hh) { m3[hh] = stf[(hh * NTHREADS + tid) * 2]; const float lt = stf[(hh * NTHREADS + tid) * 2 + 1]; inv3[hh] = lt > 0.f ? 1.0f / lt : 0.f; } }
        u64 tk[TOPN];
#pragma unroll
        for (int k = 0; k < TOPN; ++k) tk[k] = 0ull;
        float carry = 0.f;
        float qn3[3];
#pragma unroll
        for (int hh = 0; hh < 3; ++hh) { float ss = 0.f;
#pragma unroll
            for (int ks = 0; ks < 8; ++ks)
#pragma unroll
                for (int j = 0; j < 8; ++j) { const float a = bf2f((bf16)q3[hh][ks][j]); ss += a * a; }
            qn3[hh] = sqrtf(ss + __shfl_xor(ss, 32)) * (C2_128 * 1.02f); }
        const int E = (t0 / 16 + 16 + 31) & ~31, NS = (E + 255) >> 8;
        auto skipfn = [&](int cbx) -> bool {
            const float T = tk[TOPN - 1] != 0ull ? __builtin_bit_cast(float, (unsigned)(tk[TOPN - 1] >> 32)) : -1.0f;
            const float kn = ((LAS const float*)(lds + NSA_PMC_OFF))[(cbx + 31) >> 6]; const int dm = tS - (16 * (cbx + 31) + 31); const float dmin = (float)(dm > 0 ? dm : 0);
            float ub = 0.f;
#pragma unroll
            for (int hh = 0; hh < 3; ++hh) ub += ex2(qn3[hh] * kn - sl2[hh] * dmin - m3[hh]) * inv3[hh];
            return __all(4.1f * ub < T); };
        float dfs = 0.f; int dfj = -1;
#pragma unroll 1
        for (int step = 0; step < NS * 8; ++step) {
            const bool ph1 = step < 8; const int sidx = ph1 ? NS - 1 : ((step - 8) >> 3), sub = step & 7, lo = E - 256 * (NS - sidx);
            if (sub == 0) {
                __syncthreads();
                stage_rows<128, K128STR, 256>(Kt, [&](int i, bool& ok) -> const bf16* { const int c = lo + i; ok = c >= 0 && c < NCMP; return kcmp + (size_t)(ok ? c : 0) * 128; }, opaque_v(tid));
                __syncthreads();
                if (!ph1 && sidx == 0) carry = 0.f;
            }
            const int cb = lo + 32 * sub;
            if (cb < 0 || cb > wave_cmax) continue;
            bool defer = false;
            if (!ph1) { const bool last = step == NS * 8 - 1; const bool skB = skipfn(cb); const bool skN = last ? false : skipfn(cb + 32);
                if (skB && skN) { carry = 0.f; continue; } }
            else defer = sub == 0 && NS >= 2;
            {
                const int dist0 = tS - (16 * cb + 31);
                f32x16 imp = zero16();
#pragma unroll
                for (int hh = 0; hh < 3; ++hh) { const f32x16 s = qk32<128, K128STR, 8>(q3[hh], nullptr, Kt + 32 * sub * K128STR, LS);
#pragma unroll
                    for (int i = 0; i < 16; ++i) { const int kl = (i & 3) + 8 * (i >> 2) + 4 * LS.h, dist = dist0 - 16 * kl;
                        const float p = dist >= 0 ? ex2(s[i] * C2_128 - sl2[hh] * (float)dist - m3[hh]) * inv3[hh] : 0.f; imp[i] += p; } }
                const float sx0 = __shfl_xor(imp[3], 32), sx1 = __shfl_xor(imp[7], 32), sx2 = __shfl_xor(imp[11], 32), sx3 = __shfl_xor(imp[15], 32), cx = __shfl_xor(carry, 32);
                float sc[4];
                sc[0] = 0.5f * (LS.h ? sx0 : cx) + imp[0] + imp[1] + imp[2] + 0.5f * imp[3];
                sc[1] = 0.5f * (LS.h ? sx1 : sx0) + imp[4] + imp[5] + imp[6] + 0.5f * imp[7];
                sc[2] = 0.5f * (LS.h ? sx2 : sx1) + imp[8] + imp[9] + imp[10] + 0.5f * imp[11];
                sc[3] = 0.5f * (LS.h ? sx3 : sx2) + imp[12] + imp[13] + imp[14] + 0.5f * imp[15];
                carry = imp[15];
                if (defer) { dfs = imp[0] + imp[1] + imp[2] + 0.5f * imp[3]; dfj = cb >> 2; }
#pragma unroll
                for (int g4 = 0; g4 < 4; ++g4) { const int j = (cb >> 2) + 2 * g4 + LS.h; bool ok = j >= 1 && j <= curS - 2; if (g4 == 0 && defer && LS.h == 0) ok = false; const u64 ck = ok ? top_key(sc[g4], j) : 0ull;
                    if (__any(ck > tk[TOPN - 1])) top_insert(tk, ck); }
            }
        }
        if (dfj >= 0) { const float cx = __shfl_xor(carry, 32); const float scd = 0.5f * cx + dfs;
            const bool ok = LS.h == 0 && dfj >= 1 && dfj <= curS - 2; const u64 ck = ok ? top_key(scd, dfj) : 0ull;
            if (__any(ck > tk[TOPN - 1])) top_insert(tk, ck); }
        { u64 pk[TOPN];
#pragma unroll
            for (int k = 0; k < TOPN; ++k) { const unsigned lo = (unsigned)__shfl_xor((int)(unsigned)tk[k], 32), hi = (unsigned)__shfl_xor((int)(unsigned)(tk[k] >> 32), 32); pk[k] = ((u64)hi << 32) | lo; }
#pragma unroll
            for (int k = 0; k < TOPN; ++k) top_insert(tk, pk[k]); }
        unsigned wsel[8];
#pragma unroll
        for (int wd = 0; wd < 8; ++wd) { unsigned v = (wd == 0) ? 1u : 0u; v |= ((curS >> 5) == wd) ? (1u << (curS & 31)) : 0u; if (curS >= 1) v |= (((curS - 1) >> 5) == wd) ? (1u << ((curS - 1) & 31)) : 0u; wsel[wd] = v; }
#pragma unroll
        for (int k = 0; k < TOPN; ++k) { const bool ok = tk[k] != 0ull; const unsigned jj = 0xffffffffu - (unsigned)tk[k]; const unsigned wj = jj >> 5, bit = 1u << (jj & 31);
#pragma unroll
            for (int wd = 0; wd < 8; ++wd) wsel[wd] |= (ok && wj == (unsigned)wd) ? bit : 0u; }
#pragma unroll
        for (int wd = 0; wd < 8; ++wd) { if (LS.h == 0) selm[(32 * wave + LS.r) * 8 + wd] = wsel[wd];
            unsigned u = wsel[wd]; u |= __shfl_xor(u, 1); u |= __shfl_xor(u, 2); u |= __shfl_xor(u, 4); u |= __shfl_xor(u, 8); u |= __shfl_xor(u, 16);
            if (LS.lane == 0) wun[wave * 8 + wd] = u; }
        __syncthreads();
        if (tid < 8) { unsigned u = 0; for (int w = 0; w < 8; ++w) u |= wun[w * 8 + tid]; gun[tid] = u; }
        __syncthreads();
        if (tid == 0) {
            LAS unsigned* list = (LAS unsigned*)(lds + NSA_LIST_OFF); int n = ntile;
            for (int wd = 7; wd >= 0; --wd) { unsigned wm = gun[wd]; while (wm) { const int bit = 31 - __builtin_clz(wm); wm &= ~(1u << bit); list[n++] = 0x10000u | (unsigned)(32 * wd + bit); } }
            *(LAS int*)(lds + NSA_NLIST_OFF + 4) = n;
            for (int i = 11; i >= 0; --i) if (t0 - 512 + 64 * i + 63 >= 0) list[n++] = 0x20000u | (unsigned)i;
            *(LAS int*)(lds + NSA_NLIST_OFF) = n; }
        __syncthreads();
        }
        const int head = g * 3 + hh; const float s2 = alibi_slope(3 * head) * LOG2E;
        const int tq = opaque_v(t);
        const bf16* trow = qkvb + (size_t)tq * QP;
        bf16x8 q[4];
        LAS unsigned char* qx = lds + NSA_QX_OFF + wave * 4096;
        const LaneIx Lq = lane_ix(opaque_v(tid));
#pragma unroll
        for (int ks = 0; ks < 4; ++ks) q[ks] = *(const GAS bf16x8*)(trow + C_QA + head * 128 + 16 * ks + 8 * Lq.h);
        float qss = 0.f;
        { bf16x8 qt4[4];
#pragma unroll
          for (int ks = 4; ks < 8; ++ks) qt4[ks - 4] = *(const GAS bf16x8*)(trow + C_QA + head * 128 + 16 * ks + 8 * Lq.h);
#pragma unroll
          for (int ks = 4; ks < 8; ++ks) *(LAS bf16x8*)(qx + ((ks - 4) * 64 + Lq.lane) * 16) = qt4[ks - 4];
#pragma unroll
          for (int ks = 0; ks < 4; ++ks)
#pragma unroll
              for (int j = 0; j < 8; ++j) { const float a = bf2f((bf16)q[ks][j]), c = bf2f((bf16)qt4[ks][j]); qss += a * a + c * c; } }
        const float qn = sqrtf(qss + __shfl_xor(qss, 32)) * (C2_128 * 1.02f);
        FlashSt<128> st; flash_init(st);
        const LAS unsigned* list = (const LAS unsigned*)(lds + NSA_LIST_OFF);
        const int e0 = pass < 3 ? 0 : ntile, nlist = pass < 3 ? ntile : __builtin_amdgcn_readfirstlane(*(const LAS int*)(lds + NSA_NLIST_OFF));
        v4u kreg[2], vreg[2];
        auto tile_geom = [&](unsigned e, const bf16*& kb, const bf16*& vb, int& pitch, int& r0, int& r1) {
            const int ty = (int)(e >> 16), ix = (int)(e & 0xffffu); r0 = 0; r1 = 64;
            if (ty == 0) { kb = kcmp + (size_t)(64 * ix) * 128; vb = vcmp + (size_t)(64 * ix) * 128; pitch = 128; r1 = NCMP - 64 * ix; }
            else if (ty == 1) { kb = qkvb + (size_t)(64 * ix) * QP + C_KS + g * 128; vb = kb + (C_VS - C_KS); pitch = QP; }
            else { const int tk0 = t0 - 512 + 64 * ix; kb = qkvb + (ptrdiff_t)tk0 * QP + C_KW + g * 128; vb = kb + (C_VW - C_KW); pitch = QP; r0 = -tk0; } };
        auto tile_load = [&](unsigned e, int tidx) {
            const bf16 *kb, *vb; int pitch, r0, r1; tile_geom(e, kb, vb, pitch, r0, r1);
#pragma unroll
            for (int k = 0; k < 2; ++k) { const int id = tidx + k * NTHREADS, row = id >> 4, ch = id & 15; const bool ok = row >= r0 && row < r1; const int rc = ok ? row : (r0 > 0 ? r0 : 0);
                kreg[k] = *(const GAS v4u*)(kb + (ptrdiff_t)rc * pitch + ch * 8); vreg[k] = *(const GAS v4u*)(vb + (ptrdiff_t)rc * pitch + ch * 8); } };
        auto tile_store = [&](unsigned e, int buf, int tidx) { LAS unsigned char* kt = lds + buf * NSA_BUF; LAS unsigned char* vt = kt + 64 * K128STR;
            const bf16 *kb, *vb; int pitch, r0, r1; tile_geom(e, kb, vb, pitch, r0, r1); const v4u z = (v4u){0u, 0u, 0u, 0u};
#pragma unroll
            for (int k = 0; k < 2; ++k) { const int id = tidx + k * NTHREADS, row = id >> 4, ch = id & 15; const bool ok = row >= r0 && row < r1;
                *(LAS v4u*)(kt + row * K128STR + ch * 16) = ok ? kreg[k] : z; *(LAS v4u*)(vt + row * V128STR + ch * 16) = ok ? vreg[k] : z; } };
        auto branch_done = [&](int ty) {
            const int tq2 = opaque_v(t);
            const int hq2 = opaque_v(tid) >> 5 & 1;
            const float gsel = sigm(bf2f(qkvb[(size_t)tq2 * QP + C_GN + head * 3 + ty]));
            const float lt = flash_l(st), sc = lt > 0.f ? gsel / lt : 0.f;
            float* yacc = (float*)W.F() + ((size_t)b * SEQ + tq2) * 768 + head * 128 + 4 * hq2;
            bf16* yo = W.YA() + ((size_t)b * SEQ + tq2) * 768 + head * 128 + 4 * hq2;
            f32x4 acc[4][4];
            if (ty != 0) {
#pragma unroll
                for (int d = 0; d < 4; ++d)
#pragma unroll
                    for (int g4 = 0; g4 < 4; ++g4) acc[d][g4] = *(const GAS f32x4*)(yacc + 32 * d + 8 * g4);
            } else {
#pragma unroll
                for (int d = 0; d < 4; ++d)
#pragma unroll
                    for (int g4 = 0; g4 < 4; ++g4) acc[d][g4] = (f32x4){0.f, 0.f, 0.f, 0.f};
            }
#pragma unroll
            for (int d = 0; d < 4; ++d)
#pragma unroll
                for (int g4 = 0; g4 < 4; ++g4) { f32x4 a = acc[d][g4];
                    a = (f32x4){a.x + st.o[d][4 * g4] * sc, a.y + st.o[d][4 * g4 + 1] * sc, a.z + st.o[d][4 * g4 + 2] * sc, a.w + st.o[d][4 * g4 + 3] * sc};
                    if (ty != 2) *(GAS f32x4*)(yacc + 32 * d + 8 * g4) = a; else { v2u w; w.x = pk2(a.x, a.y); w.y = pk2(a.z, a.w); *(GAS v2u*)(yo + 32 * d + 8 * g4) = w; } }
            flash_init(st); };
        __syncthreads();
        { const int tid0 = opaque_v(tid); const unsigned d0 = (unsigned)__builtin_amdgcn_readfirstlane((int)list[e0]); tile_load(d0, tid0); tile_store(d0, 0, tid0); }
        __syncthreads();
        int curty = pass < 3 ? 0 : 1;
        const int winstart = __builtin_amdgcn_readfirstlane(*(const LAS int*)(lds + NSA_NLIST_OFF + 4));
        LAS unsigned* votes = (LAS unsigned*)(lds + NSA_VOTE_OFF);
        bool fresh = true;
#pragma unroll 1
        for (int e = e0; e < nlist; ++e) {
            if (!fresh) {
                LAS const unsigned* vp = votes + ((e - 1 - e0) & 1) * 8; const v4u va = *(LAS const v4u*)vp, vb = *(LAS const v4u*)(vp + 4);
                const unsigned all8 = va.x & va.y & va.z & va.w & vb.x & vb.y & vb.z & vb.w;
                if (__builtin_amdgcn_readfirstlane((int)all8) != 0) {
                    const int en = curty == 0 ? nlist : (curty == 1 ? winstart : nlist);
                    if (en >= nlist) break;
                    e = en;
                    { const int tid0 = opaque_v(tid); const unsigned dj = (unsigned)__builtin_amdgcn_readfirstlane((int)list[e]); tile_load(dj, tid0); tile_store(dj, (e - e0) & 1, tid0); }
                    __syncthreads();
                    fresh = true;
                }
            }
            const unsigned de = (unsigned)__builtin_amdgcn_readfirstlane((int)list[e]);
            const int tide = opaque_v(tid); const LaneIx Le = lane_ix(tide);
            if (e + 1 < nlist) tile_load((unsigned)__builtin_amdgcn_readfirstlane((int)list[e + 1]), tide);
            __builtin_amdgcn_sched_barrier(0);
            const int ty = (int)(de >> 16), ix = (int)(de & 0xffffu);
            if (ty != curty) { branch_done(curty); curty = ty; }
            LAS const unsigned char* kt = lds + ((e - e0) & 1) * NSA_BUF; LAS const unsigned char* vt = kt + 64 * K128STR;
            bool selb = true; unsigned wu1 = 1u;
            if (ty == 1) { const int wd = ix >> 5, bit = ix & 31; wu1 = ((unsigned)__builtin_amdgcn_readfirstlane((int)wun[wave * 8 + wd]) >> bit) & 1u; selb = (selm[(32 * wave + Le.r) * 8 + wd] >> bit) & 1u; }
            const bool allsel = __all(selb);
#pragma unroll 1
            for (int sub = 1; sub >= 0; --sub) {
                int dist0, step, dmax, klmin; bool active, allv;
                if (ty == 0) { const int cb = 64 * ix + 32 * sub; active = cb <= wave_cmax; dist0 = t - (16 * cb + 31); step = 16; dmax = 0x7fffffff; klmin = 0; allv = tw0 - 16 * cb - 527 >= 0; }
                else if (ty == 1) { active = wu1 != 0u; dist0 = t - (64 * ix + 32 * sub); step = 1; dmax = 0x7fffffff; klmin = 0; allv = allsel && (tw0 - 64 * ix - 32 * sub - 31 >= 0); }
                else { const int tb = t0 - 512 + 64 * ix + 32 * sub; active = !(tb + 31 < tw0 - 511 || tb > tw0 + 31); dist0 = t - tb; step = 1; dmax = 512; klmin = -tb; allv = tb >= 0 && (tw0 - tb - 31 >= 0) && (tw0 + 31 - tb <= 511); }
                if (active)
                    flash32<128, K128STR, V128STR, 4>(st, q, qx, kt + 32 * sub * K128STR, vt + 32 * sub * V128STR, C2_128, Le, allv, -s2 * (float)dist0, s2 * (float)step,
                        [&](int kl) { const int dist = dist0 - step * kl; return selb && dist >= 0 && dist < dmax && kl >= klmin; });
            }
            { unsigned vote = 0u;
              if (e + 1 < nlist) { const unsigned dn = (unsigned)__builtin_amdgcn_readfirstlane((int)list[e + 1]);
                  if ((int)(dn >> 16) == ty && ((NSA_CUT >> ty) & 1)) {
                      float knr; int npos;
                      if (ty == 0) { knr = ((LAS const float*)(lds + NSA_PMC_OFF))[ix - 1]; npos = 1024 * ix + 15; }
                      else if (ty == 1) { const int jn = (int)(dn & 0xffffu); knr = ((LAS const float*)(lds + NSA_PM_OFF))[jn]; npos = 64 * jn + 63; }
                      else { const int bi = 4 * qt - 8 + ix - 1; knr = ((LAS const float*)(lds + NSA_PMW_OFF))[bi]; npos = 64 * bi + 63; }
                      const int dm = t - npos; const float dmin = (float)(dm > 0 ? dm : 0);
                      const bool okc = qn * knr - s2 * dmin < st.m - SKIP_THR;
                      vote = __all(okc) ? 1u : 0u; } }
              if (Le.lane == 0) votes[((e - e0) & 1) * 8 + wave] = vote; }
            fresh = false;
            __builtin_amdgcn_sched_barrier(0);
            if (e + 1 < nlist) tile_store((unsigned)__builtin_amdgcn_readfirstlane((int)list[e + 1]), (e + 1 - e0) & 1, opaque_v(tid));
            asm volatile("s_waitcnt lgkmcnt(0)" ::: "memory"); __builtin_amdgcn_s_barrier(); asm volatile("" ::: "memory");
        }
        if (pass < 3) { LAS float* stf = (LAS float*)(lds + NSA_STAT_OFF); stf[(hh * NTHREADS + tid) * 2] = st.m; stf[(hh * NTHREADS + tid) * 2 + 1] = flash_l(st); }
        branch_done(curty);
    }
}

#define XB_TMO      128
#define XB_XCNT(j)  (256  + 64 * (j))
#define XB_XSUB(j)  (1280 + 64 * (j))
#define XB_XGEN(j)  (2304 + 64 * (j))
#define XB_TOP      3328
#define XB_TOPGEN   3392
#define XCD_BAR_WORDS 3456
#define XB_SPIN_CAP (1u << 18)

__device__ __forceinline__ unsigned xb_ld(unsigned* p)              { return __hip_atomic_load(p, __ATOMIC_RELAXED, __HIP_MEMORY_SCOPE_AGENT); }
__device__ __forceinline__ unsigned xb_add(unsigned* p, unsigned v) { return __hip_atomic_fetch_add(p, v, __ATOMIC_RELAXED, __HIP_MEMORY_SCOPE_AGENT); }
__device__ __forceinline__ unsigned xb_xcc_id() { return (unsigned)__builtin_amdgcn_s_getreg((3 << 11) | 20) & 0xFu; }
#define XB_SPIN(cond, bar) do { unsigned _sp = 0; while (cond) { __builtin_amdgcn_s_sleep(1); \
    if ((++_sp & 255u) == 0u) { if (xb_ld(&(bar)[XB_TMO])) break; if (_sp > XB_SPIN_CAP) { atomicAdd(&(bar)[XB_TMO], 1u); break; } } } } while (0)

struct XcdBarrier {
    unsigned* bar; unsigned x;
    volatile LAS unsigned* st;
};

__device__ __forceinline__ XcdBarrier xcd_barrier_post(unsigned* bar, volatile LAS unsigned* st, int tid) {
    XcdBarrier b; b.bar = bar; b.x = xb_xcc_id(); b.st = st;
    if (tid == 0) (void)xb_add(&bar[XB_XCNT(b.x)], 1u);
    return b;
}
__device__ __forceinline__ void xcd_barrier_complete(unsigned* bar, unsigned x, unsigned& nloc, unsigned& nx) {
    const unsigned G = gridDim.x * gridDim.y * gridDim.z;
    unsigned sum, cnt, mine, sp = 0u;
    for (;;) {
        sum = 0u; cnt = 0u; mine = 0u;
#pragma unroll
        for (unsigned j = 0; j < 16; ++j) { const unsigned c = xb_ld(&bar[XB_XCNT(j)]); sum += c; cnt += (c > 0u) ? 1u : 0u; mine = (j == x) ? c : mine; }
        if (sum == G) break;
        __builtin_amdgcn_s_sleep(1);
        if ((++sp & 255u) == 0u) { if (xb_ld(&bar[XB_TMO])) break; if (sp > XB_SPIN_CAP) { atomicAdd(&bar[XB_TMO], 1u); break; } }
    }
    nloc = mine > 0u ? mine : 1u; nx = cnt > 0u ? cnt : 1u;
}

__device__ __forceinline__ void xcd_barrier(const XcdBarrier& b, int tid) {
    asm volatile("s_waitcnt vmcnt(0)" ::: "memory");
    __syncthreads();
    if (tid == 0) {
        unsigned* bar = b.bar;
        __builtin_amdgcn_s_waitcnt(0);
        unsigned nloc = b.st[0], nx = b.st[1];
        if (nloc == 0u) { xcd_barrier_complete(bar, b.x, nloc, nx); b.st[0] = nloc; b.st[1] = nx; }
        const unsigned old = xb_add(&bar[XB_XSUB(b.x)], 1u);
        const unsigned gen = old / nloc;
        if (old + 1u == (gen + 1u) * nloc) {
            __builtin_amdgcn_fence(__ATOMIC_RELEASE, "agent");
            asm volatile("s_waitcnt vmcnt(0)" ::: "memory");
            const unsigned og = xb_add(&bar[XB_TOP], 1u);
            const unsigned tg = og / nx;
            if (og + 1u == (tg + 1u) * nx) xb_add(&bar[XB_TOPGEN], 1u);
            else XB_SPIN(xb_ld(&bar[XB_TOPGEN]) == tg, bar);
            __builtin_amdgcn_fence(__ATOMIC_ACQUIRE, "agent");
            xb_add(&bar[XB_XGEN(b.x)], 1u);
            asm volatile("s_waitcnt vmcnt(0)" ::: "memory");
        } else {
            XB_SPIN(xb_ld(&bar[XB_XGEN(b.x)]) == gen, bar);
            __builtin_amdgcn_fence(__ATOMIC_ACQUIRE, "agent");
            asm volatile("s_waitcnt vmcnt(0)" ::: "memory");
        }
    }
    __syncthreads();
}

constexpr int NCONVQ = 256;
constexpr int NPL = 14;
constexpr int NPH = 1 + NPL * DEPTH;
struct Args { const float* in[27]; float* out; unsigned char* ws; int ph_lo, ph_hi; };
static_assert(sizeof(Args) == 27 * 8 + 8 + 8 + 8, "Args has no padding");

typedef __attribute__((address_space(4))) const unsigned long long* kargp_t;
DI kargp_t kargs_opaque() { const unsigned long long v = (unsigned long long)__builtin_amdgcn_kernarg_segment_ptr(); unsigned lo = (unsigned)v, hi = (unsigned)(v >> 32);
    asm volatile("" : "+s"(lo), "+s"(hi)); return (kargp_t)(((unsigned long long)hi << 32) | lo); }
DI const float* kin(kargp_t kp, int i) { return (const float*)kp[i]; }
DI LayerW layer_w(kargp_t kp, int l) {
    LayerW L;
    L.f1pre = kin(kp, 2) + (size_t)l * D; L.f1g = kin(kp, 3) + (size_t)l * D * FF; L.f1u = kin(kp, 4) + (size_t)l * D * FF; L.f1d = kin(kp, 5) + (size_t)l * FF * D; L.f1post = kin(kp, 6) + (size_t)l * D;
    L.mixpre = kin(kp, 7) + (size_t)l * D; L.win = kin(kp, 8) + (size_t)l * D * NIN; L.pek = kin(kp, 9) + (size_t)l * 4096; L.pev = kin(kp, 10) + (size_t)l * 4096;
    L.c1k = kin(kp, 11) + (size_t)l * 4096 * 256; L.c2k = kin(kp, 12) + (size_t)l * 256 * 128; L.c1v = kin(kp, 13) + (size_t)l * 4096 * 256; L.c2v = kin(kp, 14) + (size_t)l * 256 * 128;
    L.memg = kin(kp, 15) + (size_t)l * D; L.wmkv = kin(kp, 16) + (size_t)l * D * 1024; L.wupa = kin(kp, 17) + (size_t)l * 768 * D; L.wupb = kin(kp, 18) + (size_t)l * 256 * D; L.wupm = kin(kp, 19) + (size_t)l * 512 * D;
    L.wout = kin(kp, 20) + (size_t)l * D * D; L.mixpost = kin(kp, 21) + (size_t)l * D; L.f2pre = kin(kp, 22) + (size_t)l * D; L.f2g = kin(kp, 23) + (size_t)l * D * FF; L.f2u = kin(kp, 24) + (size_t)l * D * FF;
    L.f2d = kin(kp, 25) + (size_t)l * FF * D; L.f2post = kin(kp, 26) + (size_t)l * D;
    return L;
}

__global__ void __launch_bounds__(NTHREADS, 2) mk_fwd(Args args) {
    extern __shared__ __attribute__((aligned(16))) unsigned char lds_raw[];
    LAS unsigned char* lds = (LAS unsigned char*)lds_raw;
    const int G = gridDim.x, bx = blockIdx.x;
    const int wave0 = __builtin_amdgcn_readfirstlane((int)threadIdx.x >> 6);
#define MK_TID() (wave0 * 64 + lane_id_v())
    { const int tid0 = MK_TID();
      for (int u = tid0; u < (LDS_BYTES - LDSCTL_OFF) / 4; u += NTHREADS) ((LAS unsigned*)(lds + LDSCTL_OFF))[u] = 0u; }
    __syncthreads();
#if MK_ONE_LAUNCH
    XcdBarrier bar = xcd_barrier_post((unsigned*)((unsigned char*)kargs_opaque()[28] + WS_CTL) + CW_BAR, (volatile LAS unsigned*)(lds + MISC_OFF + 32), MK_TID());
#define GRID_BAR() xcd_barrier(bar, MK_TID())
#else
#define GRID_BAR() do { } while (0)
#endif
    const int lo = args.ph_lo, hi = args.ph_hi;
#define IN(k) (lo <= (k) && (k) < hi)
#define SEAM(k) do { if (IN(k) && IN((k) + 1)) GRID_BAR(); } while (0)
#ifndef PROBE_MASK
#define PROBE_MASK 0
#endif
#define PH_BEGIN(k) {
#define PH_END(k) }
#define PHASE_VIEWS() const kargp_t kp = kargs_opaque(); WsPtrs W; W.ws = (unsigned char*)kp[28]; float* const outp = (float*)kp[27]; (void)outp; const int tid = opaque_v(MK_TID()), lane = tid & 63, wave = wave0; \
    const int bxp = opaque_s(bx), Gp = opaque_s(G); const int gw = bxp * NWAVES + wave, NGW = Gp * NWAVES; (void)lane; (void)gw; (void)NGW; (void)W

    if (IN(0)) { PHASE_VIEWS();
        const LayerW L0 = layer_w(kp, 0);
        convert_layer<1>(L0, W, lds, bxp, Gp, tid);
        const float* x = kin(kp, 0);
        norm_phase_first(x, (bf16*)outp, W.RS(), T, gw, NGW, lane);
    }
    SEAM(0);
#pragma unroll 1
    for (int l = 0; l < DEPTH; ++l) {
        const int pb = 1 + NPL * l;
        if (IN(pb + 0)) { PH_BEGIN(0) PHASE_VIEWS(); pg8::Gemm g{(const bf16*)outp, W.wgu1(), T, 2 * FF, D}; pg8::StaticOrder S; S.init(T, 2 * FF, Gp, bxp); pg8::EpiSwiGLU E{W.HID(), FF, W.RS()};
            pg8::gemm_phase<pg8::EpiSwiGLU, pg8::StaticOrder, true, true>(lds, g, S, E, tid); PH_END(0) }
        SEAM(pb + 0);
        if (IN(pb + 1)) { PH_BEGIN(1) PHASE_VIEWS(); pg8::Gemm g{W.HID(), W.wd1(), T, D, FF}; pg8::StaticOrder S; S.init(T, D, Gp, bxp, 2); S.rev = 1; pg8::EpiBf16 E{W.F(), D, 1 << 30, 0, nullptr, 0, nullptr};
            pg8::gemm_phase<pg8::EpiBf16, pg8::StaticOrder, true, true>(lds, g, S, E, tid); PH_END(1) }
        SEAM(pb + 1);
        if (IN(pb + 2)) { PHASE_VIEWS(); const LayerW LW = layer_w(kp, opaque_s(l));
            bf16* hA = (bf16*)outp; const float* mem = kin(kp, 1);
            norm_phase_res<false, false>(hA, W.F(), LW.f1post, 0.5f, hA, W.RS(), gw, NGW, lane);
            norm_phase_first(mem, hA + (size_t)T * D, W.RS() + T, BATCH * MEML, gw, NGW, lane);
        }
        SEAM(pb + 2);
        if (IN(pb + 3)) { PH_BEGIN(3) PHASE_VIEWS(); pg8::Gemm g{(const bf16*)outp, W.win(), TM, NWIN, D}; pg8::OrderPlusExtra S; S.init(T, QP, Gp, bxp); S.nextra = 8; S.pm0 = T / 256; S.pn0 = QP / 256; S.ncx = 4;
            pg8::EpiBf16 E{W.QKV(), QP, T / 256, QP / 256, W.MEMKV(), 1024, W.RS()};
            pg8::gemm_phase<pg8::EpiBf16, pg8::OrderPlusExtra, true, true>(lds, g, S, E, tid); PH_END(3) }
        SEAM(pb + 3);
        if (IN(pb + 4)) { PH_BEGIN(4) PHASE_VIEWS();
#pragma unroll 1
            for (int it = bxp; it < 256; it += Gp) { const int tidu = opaque_v(MK_TID()); const LaneIx LX = lane_ix(tidu); cmp_unit(W, lds, it, tidu, wave, LX); }
            key_norms(W, gw, NGW, lane);
            __syncthreads();
        PH_END(4) }
        SEAM(pb + 4);
        if (IN(pb + 5)) { PH_BEGIN(5) PHASE_VIEWS();
#pragma unroll 1
            for (int it = bxp; it < 256; it += Gp) { const int tidu = opaque_v(MK_TID()); const LaneIx LX = lane_ix(tidu); nsa_unit(W, lds, ((it & 7) << 5) | ((it >> 3) & 31), tidu, wave, LX); }
            gu32* qhead = (gu32*)(W.ws + WS_CTL) + CW_QUEUE + 64 * opaque_s(l);
            volatile LAS int* qslot = (volatile LAS int*)(lds + MISC_OFF + 64);
#pragma unroll 1
            for (;;) {
                __syncthreads();
                if (MK_TID() == 0) *qslot = (int)__hip_atomic_fetch_add(qhead, 1u, RLX_AGENT);
                __syncthreads();
                int it = __builtin_amdgcn_readfirstlane(*qslot);
                const int nca = (l == 0) ? NCONVQ : 0, ncb = (l + 1 < DEPTH) ? NCONVQ : 0, ncv = nca + ncb;
                if (it >= ncv + 512 + 1536) break;
                const int tidu = opaque_v(MK_TID());
                if (it < nca) { const LayerW LC = layer_w(kp, opaque_s(l)); convert_layer<2>(LC, W, lds, it, NCONVQ, tidu); continue; }
                if (it < ncv) { const LayerW LN = layer_w(kp, opaque_s(l + 1)); convert_layer<1>(LN, W, lds, it - nca, NCONVQ, tidu); continue; }
                it -= ncv;
                const LaneIx LX = lane_ix(tidu);
                if (it < 512) mem_unit(W, lds, it, tidu, wave, LX); else dil_unit(W, lds, it - 512, tidu, wave, LX);
            }
            __syncthreads();
        PH_END(5) }
        SEAM(pb + 5);
        if (IN(pb + 6)) { PH_BEGIN(6) PHASE_VIEWS();
            dil_merge(W, bxp * NTHREADS + tid, Gp * NTHREADS);
            { pg8::Gemm g{W.YA(), W.wupa(), T, D, 768}; pg8::StaticOrder S; S.init(T, D, Gp, bxp); pg8::EpiBf16 E{W.P(), D, 1 << 30, 0, nullptr, 0, nullptr}; pg8::gemm_phase<pg8::EpiBf16, pg8::StaticOrder, true, true>(lds, g, S, E, tid); }
            { pg8::Gemm g{W.YM(), W.wupm(), T, D, 512}; pg8::StaticOrder S; S.init(T, D, Gp, bxp); pg8::EpiBf16 E{W.P() + (size_t)2 * T * D, D, 1 << 30, 0, nullptr, 0, nullptr}; pg8::gemm_phase<pg8::EpiBf16, pg8::StaticOrder, true, true>(lds, g, S, E, tid); }
        PH_END(6) }
        SEAM(pb + 6);
        if (IN(pb + 7)) { PH_BEGIN(7) PHASE_VIEWS();
            { pg8::Gemm g{W.YB(), W.wupb(), T, D, 256}; pg8::StaticOrder S; S.init(T, D, Gp, bxp); pg8::EpiBf16 E{W.P() + (size_t)T * D, D, 1 << 30, 0, nullptr, 0, nullptr}; pg8::gemm_phase<pg8::EpiBf16, pg8::StaticOrder, true, true>(lds, g, S, E, tid); }
        PH_END(7) }
        SEAM(pb + 7);
        if (IN(pb + 8)) { PHASE_VIEWS(); pg8::Gemm g{(const bf16*)outp, W.wgate(), T, 3 * D, D}; pg8::OrderTriple S; S.init(T, D, Gp, bxp); pg8::EpiGateMerge E{W.P(), (size_t)T * D, D, W.RS()};
            pg8::gemm_phase<pg8::EpiGateMerge, pg8::OrderTriple, true, true>(lds, g, S, E, tid); }
        SEAM(pb + 8);
        if (IN(pb + 9)) { PH_BEGIN(9) PHASE_VIEWS(); pg8::Gemm g{W.P(), W.wout(), T, D, D}; pg8::StaticOrder S; S.init(T, D, Gp, bxp); pg8::EpiBf16 E{W.F(), D, 1 << 30, 0, nullptr, 0, nullptr};
            pg8::gemm_phase<pg8::EpiBf16, pg8::StaticOrder, true, true>(lds, g, S, E, tid); PH_END(9) }
        SEAM(pb + 9);
        if (IN(pb + 10)) { PHASE_VIEWS(); const LayerW LW = layer_w(kp, opaque_s(l));
            norm_phase_res<false, false>((const bf16*)outp, W.F(), LW.mixpost, 1.0f, W.HB(), W.RS(), gw, NGW, lane);
        }
        SEAM(pb + 10);
        if (IN(pb + 11)) { PH_BEGIN(11) PHASE_VIEWS(); pg8::Gemm g{W.HB(), W.wgu2(), T, 2 * FF, D}; pg8::StaticOrder S; S.init(T, 2 * FF, Gp, bxp); pg8::EpiSwiGLU E{W.HID(), FF, W.RS()};
            pg8::gemm_phase<pg8::EpiSwiGLU, pg8::StaticOrder, true, true>(lds, g, S, E, tid); PH_END(11) }
        SEAM(pb + 11);
        if (IN(pb + 12)) { PH_BEGIN(12) PHASE_VIEWS(); pg8::Gemm g{W.HID(), W.wd2(), T, D, FF}; pg8::StaticOrder S; S.init(T, D, Gp, bxp, 2); S.rev = 1; pg8::EpiBf16 E{W.F(), D, 1 << 30, 0, nullptr, 0, nullptr};
            pg8::gemm_phase<pg8::EpiBf16, pg8::StaticOrder, true, true>(lds, g, S, E, tid); PH_END(12) }
        SEAM(pb + 12);
        if (IN(pb + 13)) { PHASE_VIEWS(); const LayerW LW = layer_w(kp, opaque_s(l));
            const bool more = (l + 1 < DEPTH);
            const LayerW LN = layer_w(kp, opaque_s(more ? l + 1 : l));
            if (more) norm_phase_res<false, false>(W.HB(), W.F(), LW.f2post, 0.5f, (bf16*)outp, W.RS(), gw, NGW, lane);
            else norm_phase_res<false, true>(W.HB(), W.F(), LW.f2post, 0.5f, outp, nullptr, gw, NGW, lane);
            if (more) { __syncthreads(); convert_layer<2>(LN, W, lds, bxp, Gp, tid); }
        }
        SEAM(pb + 13);
    }
#undef IN
#undef SEAM
}

extern "C" void kernel_launch(void* const* d_in, const int* in_sizes, int n_in, void* d_out, int out_size, void* d_ws, size_t ws_size, hipStream_t stream) {
    static int grid = 0;
    if (grid == 0) {
        if (n_in != 27 || in_sizes[0] != T * D || out_size != T * D || ws_size < WS_END) { fprintf(stderr, "kernel_launch: unexpected shapes (n_in %d, in0 %d, out %d, ws %zu, need %zu); nothing launched\n", n_in, n_in > 0 ? in_sizes[0] : -1, out_size, ws_size, (size_t)WS_END); grid = -1; return; }
        int dev = 0, cus = 0, per_cu = 0;
        if (hipGetDevice(&dev) != hipSuccess || hipDeviceGetAttribute(&cus, hipDeviceAttributeMultiprocessorCount, dev) != hipSuccess) { grid = -1; return; }
        if (hipFuncSetAttribute((const void*)mk_fwd, hipFuncAttributeMaxDynamicSharedMemorySize, LDS_BYTES) != hipSuccess) { fprintf(stderr, "kernel_launch: hipFuncSetAttribute failed\n"); grid = -1; return; }
        if (hipOccupancyMaxActiveBlocksPerMultiprocessor(&per_cu, (const void*)mk_fwd, NTHREADS, LDS_BYTES) != hipSuccess || per_cu < 1) fprintf(stderr, "kernel_launch: note: occupancy query reports %d\n", per_cu);
        (void)hipGetLastError();
        grid = cus;
    }
    if (grid < 0) return;
    if (hipMemsetAsync((char*)d_ws + WS_CTL, 0, CTL_ZERO_BYTES, stream) != hipSuccess) return;
    Args a{};
    for (int i = 0; i < 27; ++i) a.in[i] = (const float*)d_in[i];
    a.out = (float*)d_out; a.ws = (unsigned char*)d_ws;
#if MK_ONE_LAUNCH
    a.ph_lo = 0; a.ph_hi = NPH;
    hipLaunchKernelGGL(mk_fwd, dim3(grid), dim3(NTHREADS), LDS_BYTES, stream, a);
#else
    for (int p = 0; p < NPH; ++p) { a.ph_lo = p; a.ph_hi = p + 1; const int reps = ((p >= 1 && ((PROBE_MASK >> ((p - 1) % NPL)) & 1)) || (p == 0 && ((PROBE_MASK >> 13) & 1))) ? 2 : 1;
        for (int r = 0; r < reps; ++r) hipLaunchKernelGGL(mk_fwd, dim3(grid), dim3(NTHREADS), LDS_BYTES, stream, a); }
#endif
}
```

```cpp
#include <hip/hip_runtime.h>
#include <cstdio>
#include <cstdint>

#ifndef MK_ONE_LAUNCH
#define MK_ONE_LAUNCH 1
#endif

namespace pg8 {
#define PG8_LAS __attribute__((address_space(3)))
typedef unsigned short bf16_t;
typedef short bf16x8 __attribute__((ext_vector_type(8)));
typedef float f32x4 __attribute__((ext_vector_type(4)));
typedef unsigned u32x4 __attribute__((ext_vector_type(4)));
constexpr int BM = 256, BK = 64, HALF = 128, HTB = HALF * BK * 2  , STAGE_BYTES = 8 * HTB, NXCD = 8;

__host__ __device__ __forceinline__ int lds_byte(int r, int c) { const int st = (r >> 4) * 2 + (c >> 5), rr = r & 15, cc = c & 31, ob = rr * 64 + cc * 2; return st * 1024 + (ob ^ (((ob >> 9) & 1) << 5)); }
__host__ __device__ __forceinline__ void stage_rc(int b, int& R, int& C) { const int st = b / 1024, sb = b % 1024, swz = sb ^ (((sb >> 9) & 1) << 5); R = (st >> 1) * 16 + swz / 64; C = (st & 1) * 32 + (swz % 64) / 2; }
__host__ __device__ __forceinline__ int perm32(int rho) { const int n = rho >> 4, i = rho & 15; return 8 * (i >> 2) + 4 * n + (i & 3); }

struct Unit { int pm, pn; };
struct Gemm { const bf16_t* A; const bf16_t* Bt; int M, N, K; };

struct StaticOrder {
    int nM, nN, nwg, G, c, WGM, rev;
    __host__ __device__ void init(int M, int N, int G_, int c_, int wgm = 4) { nM = M / BM; nN = N / BM; nwg = nM * nN; G = G_; c = c_; WGM = wgm; rev = 0; }
    __host__ __device__ bool map(long L, Unit& u) const {
        if (L >= nwg) return false;
        int wgid = (int)L; { const int q = nwg / NXCD, r = nwg % NXCD, xcd = wgid % NXCD, off = wgid / NXCD; wgid = (xcd < r ? xcd * (q + 1) : r * (q + 1) + (xcd - r) * q) + off; }
        const int nig = WGM * nN, gid = wgid / nig, fm = gid * WGM, gsz = (nM - fm) < WGM ? (nM - fm) : WGM;
        u.pm = fm + ((wgid % nig) % gsz); u.pn = (wgid % nig) / gsz; if (rev) u.pm = nM - 1 - u.pm; return true;
    }
    __host__ __device__ bool next(int i, Unit& u) const { return map((long)i * G + c, u); }
    __device__ __forceinline__ void a_ready(const Unit&) const {}
    __device__ __forceinline__ void done(const Unit&) const {}
};
template <class Epi, class Sched, bool ALIGN_EPI = false, bool SP2 = false>
__device__ __forceinline__ void gemm_phase(PG8_LAS unsigned char* lds, const Gemm g, const Sched& S, const Epi& E, int tid_in) {
    int tid_ = tid_in; asm volatile("" : "+v"(tid_));
    const int tid = tid_, wid = __builtin_amdgcn_readfirstlane(tid >> 6), lane = tid & 63, wr = wid >> 2, wc = wid & 3, fr = lane & 15, fq = lane >> 4;
    const int K = g.K, nt = K / BK;
    unsigned voffA[2], voffB[2];
#pragma unroll
    for (int i = 0; i < 2; ++i) { int R, C; stage_rc(tid * 16 + i * 8192, R, C); const int Rb = Epi::PERM ? ((R & ~31) + perm32(R & 31)) : R;
        voffA[i] = (unsigned)(R * K + C) * 2u; voffB[i] = (unsigned)(Rb * K + C) * 2u; }
    const size_t kstep = (size_t)(BK * 2);
    const size_t hstep = (size_t)HALF * K * 2;
    const size_t tstep = 2 * hstep;
    const unsigned ldsw = (unsigned)wid * 1024u;
    const int aoff = lds_byte(wr * 64 + fr, fq * 8), boff = lds_byte(wc * 32 + fr, fq * 8);
#define PG8_SA(b, h) (((b) * 2 + (h)) * HTB)
#define PG8_SB(b, h) ((4 + (b) * 2 + (h)) * HTB)
#define PG8_STAGE(bufoff, gbase, voff) do { _Pragma("unroll") for (int _i = 0; _i < 2; ++_i) \
        __builtin_amdgcn_global_load_lds((const unsigned*)((const char*)(gbase) + (voff)[_i]), (PG8_LAS unsigned*)(lds + (bufoff) + ldsw + _i * 8192), 16, 0, 0); } while (0)
#define PG8_LDA(dst, b, h) do { _Pragma("unroll") for (int m = 0; m < 4; ++m) _Pragma("unroll") for (int k = 0; k < 2; ++k) dst[m][k] = *(const PG8_LAS bf16x8*)(lds + PG8_SA(b, h) + aoff + m * 2048 + k * 1024); } while (0)
#define PG8_LDB(dst, b, h) do { _Pragma("unroll") for (int n = 0; n < 2; ++n) _Pragma("unroll") for (int k = 0; k < 2; ++k) dst[n][k] = *(const PG8_LAS bf16x8*)(lds + PG8_SB(b, h) + boff + n * 2048 + k * 1024); } while (0)
#define PG8_MMA(ai, bj, At, Bt) do { __builtin_amdgcn_s_setprio(1); _Pragma("unroll") for (int m = 0; m < 4; ++m) _Pragma("unroll") for (int n = 0; n < 2; ++n) _Pragma("unroll") for (int k = 0; k < 2; ++k) \
        acc[ai][bj][m][n] = __builtin_amdgcn_mfma_f32_16x16x32_bf16(Bt[n][k], At[m][k], acc[ai][bj][m][n], 0, 0, 0); __builtin_amdgcn_s_setprio(0); } while (0)
#define PG8_WAIT_V(n) asm volatile("s_waitcnt vmcnt(" #n ")" ::: "memory")
#define PG8_WAIT_L(n) asm volatile("s_waitcnt lgkmcnt(" #n ")" ::: "memory")
#define PG8_BAR __builtin_amdgcn_s_barrier()
#define PG8_SCHED __builtin_amdgcn_sched_barrier(0)
    Unit cur, nxt; int ui = 0;
    if (!S.next(0, cur)) return;
    f32x4 acc[2][2][4][2];
#pragma unroll
    for (int a = 0; a < 2; ++a)
#pragma unroll
        for (int b = 0; b < 2; ++b)
#pragma unroll
            for (int m = 0; m < 4; ++m)
#pragma unroll
                for (int n = 0; n < 2; ++n) acc[a][b][m][n] = (f32x4){0.f, 0.f, 0.f, 0.f};
    bf16x8 At[4][2], B0[2][2], B1[2][2];
    const char* cA = (const char*)g.A + (size_t)cur.pm * tstep; const char* cB = (const char*)g.Bt + (size_t)cur.pn * tstep;
    S.a_ready(cur);
    if constexpr (SP2) {
        PG8_STAGE(PG8_SB(0, 0), cB, voffB); PG8_STAGE(PG8_SB(0, 1), cB + hstep, voffB); PG8_STAGE(PG8_SA(0, 0), cA, voffA); PG8_STAGE(PG8_SA(0, 1), cA + hstep, voffA);
        if (wr == 1) PG8_BAR;
        PG8_WAIT_V(2); PG8_BAR;
        PG8_STAGE(PG8_SB(1, 0), cB + kstep, voffB); PG8_STAGE(PG8_SA(1, 0), cA + kstep, voffA); PG8_STAGE(PG8_SB(1, 1), cB + hstep + kstep, voffB);
        PG8_WAIT_V(6); PG8_BAR;
    } else {
        PG8_STAGE(PG8_SB(0, 0), cB, voffB); PG8_STAGE(PG8_SA(0, 0), cA, voffA); PG8_STAGE(PG8_SB(0, 1), cB + hstep, voffB); PG8_STAGE(PG8_SA(0, 1), cA + hstep, voffA);
        if (wr == 1) PG8_BAR;
        PG8_WAIT_V(4); PG8_BAR;
        PG8_STAGE(PG8_SB(1, 0), cB + kstep, voffB); PG8_STAGE(PG8_SA(1, 0), cA + kstep, voffA); PG8_STAGE(PG8_SB(1, 1), cB + hstep + kstep, voffB);
        PG8_WAIT_V(6); PG8_BAR;
    }
    for (;;) {
        const bool has_next = S.next(ui + 1, nxt);
        const typename Epi::Pre pre = E.prefetch(cur, wr, fr);
        const char* nA = has_next ? (const char*)g.A + (size_t)nxt.pm * tstep : cA; const char* nB = has_next ? (const char*)g.Bt + (size_t)nxt.pn * tstep : cB;
        for (int t = 0; t < nt; t += 2) {
            const bool last = (t == nt - 2);
            const char* a1 = cA + (size_t)(t + 1) * kstep;
            const char* a2 = last ? nA : cA + (size_t)(t + 2) * kstep; const char* b2 = last ? nB : cB + (size_t)(t + 2) * kstep;
            const char* a3 = a2 + kstep; const char* b3 = b2 + kstep;
            if (last && has_next) S.a_ready(nxt);
            if constexpr (SP2) {
            PG8_LDB(B0, 0, 0); PG8_LDB(B1, 0, 1); PG8_SCHED; PG8_LDA(At, 0, 0); PG8_STAGE(PG8_SA(1, 1), a1 + hstep, voffA);
            PG8_WAIT_V(8); PG8_WAIT_L(0); PG8_BAR; PG8_MMA(0, 0, At, B0); PG8_MMA(0, 1, At, B1); PG8_BAR; PG8_SCHED;
            PG8_LDA(At, 0, 1); PG8_STAGE(PG8_SB(0, 0), b2, voffB); PG8_STAGE(PG8_SB(0, 1), b2 + hstep, voffB); PG8_STAGE(PG8_SA(0, 0), a2, voffA);
            PG8_WAIT_V(8); PG8_WAIT_L(0); PG8_BAR; PG8_MMA(1, 0, At, B0); PG8_MMA(1, 1, At, B1); PG8_BAR; PG8_SCHED;
            PG8_LDB(B0, 1, 0); PG8_LDB(B1, 1, 1); PG8_SCHED; PG8_LDA(At, 1, 0); PG8_STAGE(PG8_SA(0, 1), a2 + hstep, voffA);
            PG8_WAIT_V(8); PG8_WAIT_L(0); PG8_BAR; PG8_MMA(0, 0, At, B0); PG8_MMA(0, 1, At, B1); PG8_BAR; PG8_SCHED;
            PG8_LDA(At, 1, 1); PG8_STAGE(PG8_SB(1, 0), b3, voffB); PG8_STAGE(PG8_SB(1, 1), b3 + hstep, voffB); PG8_STAGE(PG8_SA(1, 0), a3, voffA);
            PG8_WAIT_V(8); PG8_WAIT_L(0); PG8_BAR; PG8_MMA(1, 0, At, B0); PG8_MMA(1, 1, At, B1); PG8_BAR; PG8_SCHED;
            } else {
            PG8_LDB(B0, 0, 0); PG8_SCHED; PG8_LDA(At, 0, 0); PG8_STAGE(PG8_SA(1, 1), a1 + hstep, voffA);
            PG8_WAIT_L(8); PG8_BAR; PG8_WAIT_L(0); PG8_MMA(0, 0, At, B0); PG8_BAR; PG8_SCHED;
            PG8_LDB(B1, 0, 1); PG8_STAGE(PG8_SB(0, 0), b2, voffB);
            PG8_BAR; PG8_WAIT_L(0); PG8_MMA(0, 1, At, B1); PG8_BAR;
            PG8_LDA(At, 0, 1); PG8_STAGE(PG8_SA(0, 0), a2, voffA);
            PG8_BAR; PG8_WAIT_L(0); PG8_MMA(1, 0, At, B0); PG8_BAR; PG8_SCHED;
            PG8_STAGE(PG8_SB(0, 1), b2 + hstep, voffB);
            PG8_WAIT_V(6); PG8_BAR; PG8_MMA(1, 1, At, B1); PG8_BAR;
            PG8_LDB(B0, 1, 0); PG8_SCHED; PG8_LDA(At, 1, 0); PG8_STAGE(PG8_SA(0, 1), a2 + hstep, voffA);
            PG8_WAIT_L(8); PG8_BAR; PG8_WAIT_L(0); PG8_MMA(0, 0, At, B0); PG8_BAR; PG8_SCHED;
            PG8_LDB(B1, 1, 1); PG8_STAGE(PG8_SB(1, 0), b3, voffB);
            PG8_BAR; PG8_WAIT_L(0); PG8_MMA(0, 1, At, B1); PG8_BAR;
            PG8_LDA(At, 1, 1); PG8_STAGE(PG8_SA(1, 0), a3, voffA);
            PG8_BAR; PG8_WAIT_L(0); PG8_MMA(1, 0, At, B0); PG8_BAR; PG8_SCHED;
            PG8_STAGE(PG8_SB(1, 1), b3 + hstep, voffB);
            PG8_WAIT_V(6); PG8_BAR; PG8_MMA(1, 1, At, B1); PG8_BAR;
            }
        }
        if constexpr (ALIGN_EPI) { if (wr == 0) PG8_BAR; }
        if constexpr (!Epi::AFTER_DRAIN) { E(acc, cur, wr, wc, fr, fq, pre); S.done(cur); }
        if (!has_next) break;
#pragma unroll
        for (int a = 0; a < 2; ++a)
#pragma unroll
            for (int b = 0; b < 2; ++b)
#pragma unroll
                for (int m = 0; m < 4; ++m)
#pragma unroll
                    for (int n = 0; n < 2; ++n) acc[a][b][m][n] = (f32x4){0.f, 0.f, 0.f, 0.f};
        cur = nxt; cA = nA; cB = nB; ++ui;
        if constexpr (ALIGN_EPI) { if (wr == 1) PG8_BAR; }
    }
    PG8_WAIT_V(0);
    if constexpr (!ALIGN_EPI) { if (wr == 0) PG8_BAR; }
    PG8_BAR;
    if constexpr (Epi::AFTER_DRAIN) { E.fused(acc, cur, wr, wc, fr, fq, lds, wid, lane); S.done(cur); }
#undef PG8_SA
#undef PG8_SB
#undef PG8_STAGE
#undef PG8_LDA
#undef PG8_LDB
#undef PG8_MMA
#undef PG8_WAIT_V
#undef PG8_WAIT_L
#undef PG8_BAR
#undef PG8_SCHED
}
__device__ __forceinline__ unsigned cvt_pk_bf16(float lo, float hi) { typedef __bf16 bf2 __attribute__((ext_vector_type(2))); bf2 v; v[0] = (__bf16)lo; v[1] = (__bf16)hi; return __builtin_bit_cast(unsigned, v); }
__device__ __forceinline__ float bf_lo(unsigned w) { return __builtin_bit_cast(float, w << 16); }
__device__ __forceinline__ float bf_hi(unsigned w) { return __builtin_bit_cast(float, w & 0xffff0000u); }
__device__ __forceinline__ float sigmoid_f(float x) { return __builtin_amdgcn_rcpf(1.0f + __builtin_amdgcn_exp2f(-1.4426950408889634f * x)); }

struct RowScale { float r[2][4]; };
__device__ __forceinline__ RowScale load_row_scale(const float* R, int row0) { RowScale p;
#pragma unroll
    for (int ai = 0; ai < 2; ++ai)
#pragma unroll
        for (int m = 0; m < 4; ++m) p.r[ai][m] = R ? R[row0 + ai * HALF + m * 16] : 1.0f;
    return p; }
struct EpiBf16 {
    static constexpr bool PERM = true, AFTER_DRAIN = false;
    bf16_t* O; int ldc; int pm_split, pn_split; bf16_t* O2; int ldc2; const float* R;
    typedef RowScale Pre;
    __device__ __forceinline__ Pre prefetch(const Unit& u, int wr, int fr) const { return load_row_scale(R, u.pm * BM + wr * 64 + fr); }
    __device__ __forceinline__ void operator()(const f32x4 (&acc)[2][2][4][2], const Unit& u, int wr, int wc, int fr, int fq, const Pre& pre) const {
        bf16_t* base = O; int ld = ldc, pm = u.pm, pn = u.pn;
        if (pm >= pm_split) { base = O2; ld = ldc2; pm -= pm_split; pn -= pn_split; }
        const int row0 = pm * BM + wr * 64 + fr, col0 = pn * BM + wc * 32 + 8 * fq;
#pragma unroll
        for (int ai = 0; ai < 2; ++ai)
#pragma unroll
            for (int m = 0; m < 4; ++m) { bf16_t* rowp = base + (size_t)(row0 + ai * HALF + m * 16) * ld + col0;
#pragma unroll
                for (int bj = 0; bj < 2; ++bj) { const f32x4 v0 = acc[ai][bj][m][0] * pre.r[ai][m], v1 = acc[ai][bj][m][1] * pre.r[ai][m];
                    u32x4 w; w.x = cvt_pk_bf16(v0[0], v0[1]); w.y = cvt_pk_bf16(v0[2], v0[3]); w.z = cvt_pk_bf16(v1[0], v1[1]); w.w = cvt_pk_bf16(v1[2], v1[3]);
                    *(u32x4*)(rowp + bj * HALF) = w; } }
    }
};
struct EpiSwiGLU {
    static constexpr bool PERM = true, AFTER_DRAIN = false;
    bf16_t* O; int ldc; const float* R;
    typedef RowScale Pre;
    __device__ __forceinline__ Pre prefetch(const Unit& u, int wr, int fr) const { return load_row_scale(R, u.pm * BM + wr * 64 + fr); }
    __device__ __forceinline__ void operator()(const f32x4 (&acc)[2][2][4][2], const Unit& u, int wr, int wc, int fr, int fq, const Pre& pre) const {
        const int row0 = u.pm * BM + wr * 64 + fr, col0 = u.pn * HALF + wc * 32 + 8 * fq;
#pragma unroll
        for (int ai = 0; ai < 2; ++ai)
#pragma unroll
            for (int m = 0; m < 4; ++m) { bf16_t* rowp = O + (size_t)(row0 + ai * HALF + m * 16) * ldc + col0;
                float o[8];
#pragma unroll
                for (int n = 0; n < 2; ++n)
#pragma unroll
                    for (int j = 0; j < 4; ++j) { const float g = acc[ai][0][m][n][j] * pre.r[ai][m], up = acc[ai][1][m][n][j] * pre.r[ai][m]; o[4 * n + j] = g * sigmoid_f(g) * up; }
                u32x4 w; w.x = cvt_pk_bf16(o[0], o[1]); w.y = cvt_pk_bf16(o[2], o[3]); w.z = cvt_pk_bf16(o[4], o[5]); w.w = cvt_pk_bf16(o[6], o[7]);
                *(u32x4*)rowp = w; }
    }
};
struct EpiGateMerge {
    static constexpr bool PERM = true, AFTER_DRAIN = false;
    bf16_t* P; size_t pstride; int ldc; const float* R;
    typedef RowScale Pre;
    __device__ __forceinline__ Pre prefetch(const Unit& u, int wr, int fr) const { return load_row_scale(R, u.pm * BM + wr * 64 + fr); }
    __device__ __forceinline__ void operator()(const f32x4 (&acc)[2][2][4][2], const Unit& u, int wr, int wc, int fr, int fq, const Pre& pre) const {
        const int x = u.pn >> 3, pt = u.pn & 7;
        const int row0 = u.pm * BM + wr * 64 + fr, col0 = pt * BM + wc * 32 + 8 * fq;
        const bf16_t* Px = P + (size_t)x * pstride;
#pragma unroll
        for (int ai = 0; ai < 2; ++ai) {
            u32x4 pw[4][2], mw[4][2];
#pragma unroll
            for (int m = 0; m < 4; ++m)
#pragma unroll
                for (int bj = 0; bj < 2; ++bj) { const size_t off = (size_t)(row0 + ai * HALF + m * 16) * ldc + col0 + bj * HALF;
                    pw[m][bj] = *(const u32x4*)(Px + off); mw[m][bj] = (u32x4){0u, 0u, 0u, 0u}; if (x > 0) mw[m][bj] = *(const u32x4*)(P + off); }
#pragma unroll
            for (int m = 0; m < 4; ++m)
#pragma unroll
                for (int bj = 0; bj < 2; ++bj) { const size_t off = (size_t)(row0 + ai * HALF + m * 16) * ldc + col0 + bj * HALF;
                    const f32x4 v0 = acc[ai][bj][m][0] * pre.r[ai][m], v1 = acc[ai][bj][m][1] * pre.r[ai][m]; const u32x4 p = pw[m][bj], q = mw[m][bj];
                    float o[8];
                    o[0] = sigmoid_f(v0[0]) * bf_lo(p.x) + bf_lo(q.x); o[1] = sigmoid_f(v0[1]) * bf_hi(p.x) + bf_hi(q.x); o[2] = sigmoid_f(v0[2]) * bf_lo(p.y) + bf_lo(q.y); o[3] = sigmoid_f(v0[3]) * bf_hi(p.y) + bf_hi(q.y);
                    o[4] = sigmoid_f(v1[0]) * bf_lo(p.z) + bf_lo(q.z); o[5] = sigmoid_f(v1[1]) * bf_hi(p.z) + bf_hi(q.z); o[6] = sigmoid_f(v1[2]) * bf_lo(p.w) + bf_lo(q.w); o[7] = sigmoid_f(v1[3]) * bf_hi(p.w) + bf_hi(q.w);
                    u32x4 w; w.x = cvt_pk_bf16(o[0], o[1]); w.y = cvt_pk_bf16(o[2], o[3]); w.z = cvt_pk_bf16(o[4], o[5]); w.w = cvt_pk_bf16(o[6], o[7]);
                    *(u32x4*)(P + off) = w; }
        }
    }
};
struct OrderPlusExtra : StaticOrder {
    int nextra, pm0, pn0, ncx;
    __device__ bool next(int i, Unit& u) const { const long L = (long)i * G + c; if (L < nwg) return map(L, u);
        const long e = L - nwg; if (e >= nextra) return false; u.pm = pm0 + (int)(e / ncx); u.pn = pn0 + (int)(e % ncx); return true; }
};
struct OrderTriple : StaticOrder {
    __device__ bool next(int i, Unit& u) const { const int i3 = i / 3, x = i - 3 * i3; if (!map((long)i3 * G + c, u)) return false; u.pn += 8 * x; return true; }
};
}
constexpr int D = 2048, BATCH = 2, SEQ = 16384, T = BATCH * SEQ, DEPTH = 2, MEML = 256, FF = 5504;
constexpr int TM = T + BATCH * MEML;
constexpr int NIN = 11282;
constexpr float EPS = 1e-6f;
constexpr float LOG2E = 1.4426950408889634f;
constexpr int QP = 5376;
constexpr int C_QA = 0, C_KC = 768, C_VC = 1024, C_KS = 1280, C_VS = 1536, C_KW = 1792, C_VW = 2048, C_QB = 2304, C_KB = 3072, C_VB = 3840, C_QM = 4608, C_GN = 5120;
constexpr int SRC_GN = 2304, SRC_QB = 2322, SRC_GATES = 5138;
constexpr int NWIN = QP + 1024;
constexpr int NCMP = 1023;

constexpr size_t MiB = 1u << 20;
constexpr size_t WS_CTL = 0, CTL_ZERO_BYTES = 1 * MiB;
constexpr size_t SZ_WGU = (size_t)2 * FF * D * 2, SZ_WD = (size_t)D * FF * 2;
constexpr size_t WS_WGU1 = 1 * MiB, WS_WD1 = WS_WGU1 + SZ_WGU, WS_WGU2 = WS_WD1 + SZ_WD, WS_WD2 = WS_WGU2 + SZ_WGU;
constexpr size_t WS_WIN = WS_WD2 + SZ_WD, WS_WGATE = WS_WIN + (size_t)NWIN * D * 2;
constexpr size_t WS_WC1K = WS_WGATE + (size_t)3 * D * D * 2, WS_WC1V = WS_WC1K + 2 * MiB, WS_WC2K = WS_WC1V + 2 * MiB, WS_WC2V = WS_WC2K + 65536;
constexpr size_t WS_CBIAS = WS_WC2V + 65536;
constexpr size_t WS_WUPA = WS_CBIAS + 65536, WS_WUPB = WS_WUPA + (size_t)D * 768 * 2, WS_WUPM = WS_WUPB + (size_t)D * 256 * 2, WS_WOUT = WS_WUPM + (size_t)D * 512 * 2;
constexpr size_t WS_U = WS_WOUT + (size_t)D * D * 2;
constexpr size_t WS_R2 = WS_U + (size_t)TM * D * 2;
constexpr size_t WS_F = WS_R2;
constexpr size_t WS_HID = WS_F + (size_t)T * D * 2;
constexpr size_t WS_YA = WS_HID, WS_YB = WS_YA + (size_t)T * 768 * 2, WS_YM = WS_YB + (size_t)T * 256 * 2;
constexpr size_t WS_MEMKV = WS_YM + (size_t)T * 512 * 2;
constexpr size_t WS_KCMP = WS_MEMKV + 1 * MiB, WS_VCMP = WS_KCMP + 1 * MiB;
constexpr size_t WS_DILL = WS_VCMP + 1 * MiB;
constexpr size_t WS_P = WS_DILL + 2 * MiB;
constexpr size_t WS_DILO = WS_P;
constexpr size_t WS_QKV = WS_DILO + (size_t)3 * T * 256 * 2;
constexpr size_t WS_QKV_END = WS_QKV + (size_t)(T + 64) * QP * 2;
constexpr size_t WS_P_END = WS_P + (size_t)3 * T * D * 2;
constexpr size_t WS_HID_END = WS_HID + (size_t)T * FF * 2;
constexpr size_t WS_HB = WS_HID_END;
static_assert(WS_HB + (size_t)T * D * 2 <= WS_P_END, "WS_HB must fit in the dead P region");
constexpr size_t WS_END = (WS_QKV_END > WS_P_END ? (WS_QKV_END > WS_HID_END ? WS_QKV_END : WS_HID_END) : (WS_P_END > WS_HID_END ? WS_P_END : WS_HID_END));
static_assert(WS_END < (size_t)1040 * MiB, "workspace map exceeds the guaranteed d_ws size");
constexpr int CW_TMO = 0;
constexpr int CW_BAR = 4096;
constexpr int CW_QUEUE = 16384;
constexpr size_t WS_KNS = WS_CTL + 262144;
constexpr size_t WS_RS = WS_CTL + 524288;
constexpr size_t WS_KNC = WS_KNS + 16384;

constexpr int NWAVES = 8, NTHREADS = NWAVES * 64;
constexpr int RING_BYTES = 131072;
constexpr int LDSCTL_OFF = 145408, MISC_OFF = LDSCTL_OFF + 320;
constexpr int LDS_BYTES = 147456;

#define GAS __attribute__((address_space(1)))
#define LAS __attribute__((address_space(3)))
#define DI __device__ __forceinline__
typedef unsigned short bf16;
typedef unsigned v4u __attribute__((ext_vector_type(4)));
typedef unsigned v2u __attribute__((ext_vector_type(2)));
typedef float f32x4 __attribute__((ext_vector_type(4)));
typedef float f32x16 __attribute__((ext_vector_type(16)));
typedef short bf16x8 __attribute__((ext_vector_type(8)));
typedef short s16x4 __attribute__((ext_vector_type(4)));
typedef GAS unsigned gu32;
#define RLX_AGENT __ATOMIC_RELAXED, __HIP_MEMORY_SCOPE_AGENT
#define LDS_WAIT() asm volatile("s_waitcnt lgkmcnt(0)" ::: "memory")
#define VM_WAIT() asm volatile("s_waitcnt vmcnt(0)" ::: "memory")
DI unsigned pk2(float lo, float hi) { return pg8::cvt_pk_bf16(lo, hi); }
DI float bflo(unsigned w) { return __builtin_bit_cast(float, w << 16); }
DI float bfhi(unsigned w) { return __builtin_bit_cast(float, w & 0xffff0000u); }
DI float bf2f(bf16 v) { return __builtin_bit_cast(float, (unsigned)v << 16); }
DI float ex2(float x) { return __builtin_amdgcn_exp2f(x); }
DI float sigm(float x) { return __builtin_amdgcn_rcpf(1.0f + ex2(-LOG2E * x)); }
DI float wave_sum(float v) {
#pragma unroll
    for (int o = 1; o < 64; o <<= 1) v += __shfl_xor(v, o);
    return v;
}
DI unsigned char* opaque_p(unsigned char* p) { unsigned long long v = (unsigned long long)p; unsigned lo = (unsigned)v, hi = (unsigned)(v >> 32); asm volatile("" : "+s"(lo), "+s"(hi)); return (unsigned char*)(((unsigned long long)hi << 32) | lo); }
DI int opaque_v(int v) { asm volatile("" : "+v"(v)); return v; }
DI int opaque_s(int v) { asm volatile("" : "+s"(v)); return v; }
DI int lane_id_v() { int l; asm volatile("v_mbcnt_lo_u32_b32 %0, -1, 0\n\tv_mbcnt_hi_u32_b32 %0, -1, %0" : "=&v"(l)); return l; }
typedef float f32x2g __attribute__((ext_vector_type(2)));
template <bool TILED = false, class F, class R>
DI void conv_matrix2(F colptr, R drow, int pitch, int K, int nrows, bf16* WT, LAS float* scr, int bx, int G, int tid, const float* gain = nullptr) {
    const int nkb = K / 64, nnb = nrows / 128, nitems = nnb * nkb, wave = tid >> 6, lane = tid & 63;
    f32x2g v[8], w[8], x2[8], y2[8];
    auto issue = [&](int item, f32x2g (&dst)[8]) { const int kb = item / nnb, nb = item - kb * nnb; const float* cp = colptr(128 * nb + 2 * lane);
        const float* cq = cp ? cp : colptr(0);
#pragma unroll
        for (int i = 0; i < 8; ++i) { const f32x2g x = *(const GAS f32x2g*)(cq + (size_t)(64 * kb + 8 * wave + i) * pitch); dst[i] = cp ? x : (f32x2g){0.f, 0.f}; } };
    auto issue_c = [&](int item, f32x2g (&dst)[8]) { issue(item < nitems ? item : nitems - 1, dst); };
    int it = bx;
    if (it < nitems) { issue_c(it, v); issue_c(it + G, w); issue_c(it + 2 * G, x2); }
#pragma unroll 1
    for (; it < nitems; it += G) {
        issue_c(it + 3 * G, y2);
        __builtin_amdgcn_sched_barrier(0);
        const int kb = it / nnb, nb = it - kb * nnb, k0 = 64 * kb, d0 = drow(128 * nb);
#pragma unroll
        for (int i = 0; i < 8; ++i) { const float gk = gain ? gain[k0 + 8 * wave + i] : 1.0f;
            scr[(8 * wave + i) * 129 + 2 * lane] = v[i].x * gk; scr[(8 * wave + i) * 129 + 2 * lane + 1] = v[i].y * gk; }
        __syncthreads();
        const int c = lane & 7;
#pragma unroll
        for (int j = 0; j < 2; ++j) { const int n = 16 * wave + (lane >> 3) + 8 * j; const LAS float* s = scr + (8 * c) * 129 + n;
            v4u o; o.x = pk2(s[0 * 129], s[1 * 129]); o.y = pk2(s[2 * 129], s[3 * 129]); o.z = pk2(s[4 * 129], s[5 * 129]); o.w = pk2(s[6 * 129], s[7 * 129]);
            if constexpr (TILED) { const int row = d0 + n; *(GAS v4u*)(WT + ((size_t)(((kb * 4 + (c >> 1)) * 8 + (row >> 5)) * 64 + (c & 1) * 32 + (row & 31))) * 8) = o; }
            else *(GAS v4u*)(WT + (size_t)(d0 + n) * K + k0 + 8 * c) = o; }
        __syncthreads();
#pragma unroll
        for (int i = 0; i < 8; ++i) { v[i] = w[i]; w[i] = x2[i]; x2[i] = y2[i]; }
    }
}
template <bool TILED = false, class F>
DI void conv_matrix(F colptr, int pitch, int K, int nrows, bf16* WT, LAS float* scr, int bx, int G, int tid, const float* gain = nullptr) { conv_matrix2<TILED>(colptr, [](int n) { return n; }, pitch, K, nrows, WT, scr, bx, G, tid, gain); }

struct LayerW {
    const float *f1pre, *f1g, *f1u, *f1d, *f1post, *mixpre, *win, *pek, *pev, *c1k, *c2k, *c1v, *c2v, *memg, *wmkv, *wupa, *wupb, *wupm, *wout, *mixpost, *f2pre, *f2g, *f2u, *f2d, *f2post;
};
struct WsPtrs {
    unsigned char* ws;
#define WSP(name, type, off) DI type* name() const { return (type*)(ws + (off)); }
    WSP(wgu1, bf16, WS_WGU1) WSP(wd1, bf16, WS_WD1) WSP(wgu2, bf16, WS_WGU2) WSP(wd2, bf16, WS_WD2) WSP(win, bf16, WS_WIN) WSP(wgate, bf16, WS_WGATE)
    WSP(wc1k, bf16, WS_WC1K) WSP(wc1v, bf16, WS_WC1V) WSP(wc2k, bf16, WS_WC2K) WSP(wc2v, bf16, WS_WC2V) WSP(cbias, float, WS_CBIAS)
    WSP(wupa, bf16, WS_WUPA) WSP(wupb, bf16, WS_WUPB) WSP(wupm, bf16, WS_WUPM) WSP(wout, bf16, WS_WOUT)
    WSP(U, bf16, WS_U) WSP(F, bf16, WS_F) WSP(HID, bf16, WS_HID) WSP(HB, bf16, WS_HB) WSP(RS, float, WS_RS) WSP(YA, bf16, WS_YA) WSP(YB, bf16, WS_YB) WSP(YM, bf16, WS_YM)
    WSP(MEMKV, bf16, WS_MEMKV) WSP(KCMP, bf16, WS_KCMP) WSP(VCMP, bf16, WS_VCMP) WSP(P, bf16, WS_P) WSP(DILO, bf16, WS_DILO) WSP(QKV, bf16, WS_QKV) WSP(DILL, float, WS_DILL)
#undef WSP
};

template <int PART>
DI void convert_layer(const LayerW& L, const WsPtrs& W, LAS unsigned char* lds, int bx, int G, int tid) {
    LAS float* scr = (LAS float*)lds; const int wave = tid >> 6, lane = tid & 63, gw = bx * NWAVES + wave, NGW = G * NWAVES;
    if constexpr (PART != 2) {
    { const float* s = L.f1g; conv_matrix2([=](int r) { return s + r; }, [](int n) { return (n >> 7) * 256 + (n & 127); }, FF, D, FF, W.wgu1(), scr, bx, G, tid, L.f1pre); }
    { const float* s = L.f1u; conv_matrix2([=](int r) { return s + r; }, [](int n) { return (n >> 7) * 256 + (n & 127) + 128; }, FF, D, FF, W.wgu1(), scr, bx, G, tid, L.f1pre); }
    { const float* s = L.f1d; conv_matrix([=](int r) { return s + r; }, D, FF, D, W.wd1(), scr, bx, G, tid); }
    { const float* s = L.win; conv_matrix([=](int r) -> const float* { if (r < C_QB) return s + r; if (r < C_GN) return s + (r - C_QB + SRC_QB); if (r < C_GN + 18) return s + (r - C_GN + SRC_GN); return nullptr; }, NIN, D, QP, W.win(), scr, bx, G, tid, L.mixpre); }
    { const float* s = L.wmkv; conv_matrix([=](int r) { return s + r; }, 1024, D, 1024, W.win() + (size_t)QP * D, scr, bx, G, tid, L.memg); }
    { const float* s = L.c1k; conv_matrix<true>([=](int r) { return s + r; }, 256, 4096, 256, W.wc1k(), scr, bx, G, tid); }
    { const float* s = L.c1v; conv_matrix<true>([=](int r) { return s + r; }, 256, 4096, 256, W.wc1v(), scr, bx, G, tid); }
    { const float* s = L.c2k; conv_matrix([=](int r) { return s + r; }, 128, 256, 128, W.wc2k(), scr, bx, G, tid); }
    { const float* s = L.c2v; conv_matrix([=](int r) { return s + r; }, 128, 256, 128, W.wc2v(), scr, bx, G, tid); }
    }
    if constexpr (PART != 1) {
    { const float* s = L.f2g; conv_matrix2([=](int r) { return s + r; }, [](int n) { return (n >> 7) * 256 + (n & 127); }, FF, D, FF, W.wgu2(), scr, bx, G, tid, L.f2pre); }
    { const float* s = L.f2u; conv_matrix2([=](int r) { return s + r; }, [](int n) { return (n >> 7) * 256 + (n & 127) + 128; }, FF, D, FF, W.wgu2(), scr, bx, G, tid, L.f2pre); }
    { const float* s = L.f2d; conv_matrix([=](int r) { return s + r; }, D, FF, D, W.wd2(), scr, bx, G, tid); }
    { const float* s = L.win; conv_matrix([=](int r) { return s + SRC_GATES + r; }, NIN, D, 3 * D, W.wgate(), scr, bx, G, tid, L.mixpre); }
    { const float* s = L.wupa; conv_matrix([=](int r) { return s + r; }, D, 768, D, W.wupa(), scr, bx, G, tid); }
    { const float* s = L.wupb; conv_matrix([=](int r) { return s + r; }, D, 256, D, W.wupb(), scr, bx, G, tid); }
    { const float* s = L.wupm; conv_matrix([=](int r) { return s + r; }, D, 512, D, W.wupm(), scr, bx, G, tid); }
    { const float* s = L.wout; conv_matrix([=](int r) { return s + r; }, D, D, D, W.wout(), scr, bx, G, tid); }
    }
    if constexpr (PART != 2)
    for (int it = gw; it < 512; it += NGW) { const int which = it >> 8, hid = it & 255; const float* pe = which ? L.pev : L.pek; const float* w1 = which ? L.c1v : L.c1k;
        float a = 0.f;
#pragma unroll 8
        for (int i = 0; i < 64; ++i) { const int k = lane + 64 * i; a += pe[k] * w1[(size_t)k * 256 + hid]; }
        a = wave_sum(a);
        if (lane == 0) W.cbias()[which * 256 + hid] = a; }
}

DI void norm_phase_first(const float* xbase, bf16* ubase, float* rs, int nrows, int gw, int NGW, int lane) {
    f32x4 v[8], vn[8];
    auto issue = [&](int m, f32x4 (&d)[8]) { const GAS f32x4* xr = (const GAS f32x4*)(xbase + (size_t)m * D) + lane;
#pragma unroll
        for (int j = 0; j < 8; ++j) d[j] = xr[64 * j]; };
    int m = gw;
    if (m < nrows) issue(m, v);
#pragma unroll 1
    for (; m < nrows; m += NGW) {
        if (m + NGW < nrows) issue(m + NGW, vn);
        __builtin_amdgcn_sched_barrier(0);
        float s = 0.f;
#pragma unroll
        for (int j = 0; j < 8; ++j) s += (v[j].x * v[j].x + v[j].y * v[j].y) + (v[j].z * v[j].z + v[j].w * v[j].w);
        const float r = 1.0f / sqrtf(wave_sum(s) * (1.0f / D) + EPS);
        if (lane == 0) rs[m] = r;
        GAS v2u* o8 = (GAS v2u*)(ubase + (size_t)m * D) + lane;
#pragma unroll
        for (int j = 0; j < 8; ++j) { v2u o; o.x = pk2(v[j].x, v[j].y); o.y = pk2(v[j].z, v[j].w); o8[64 * j] = o; }
#pragma unroll
        for (int j = 0; j < 8; ++j) v[j] = vn[j];
    }
}
template <bool HIN_F32, bool HOUT_F32>
DI void norm_phase_res(const void* hin, const bf16* fbuf, const float* gpost, float cs, void* hout, float* rs, int gw, int NGW, int lane) {
    f32x4 h[HIN_F32 ? 8 : 1], hn[HIN_F32 ? 8 : 1], hn2[HIN_F32 ? 8 : 1]; v2u hb[HIN_F32 ? 1 : 8], hbn[HIN_F32 ? 1 : 8], hbn2[HIN_F32 ? 1 : 8]; v2u fw[8], fwn[8], fwn2[8];
    f32x4 gpv[8];
    { const GAS f32x4* gp = (const GAS f32x4*)gpost + lane;
#pragma unroll
      for (int j = 0; j < 8; ++j) gpv[j] = gp[64 * j]; }
    auto issue = [&](int m, f32x4 (&hd)[HIN_F32 ? 8 : 1], v2u (&hbd)[HIN_F32 ? 1 : 8], v2u (&fd)[8]) { const GAS v2u* fr = (const GAS v2u*)(fbuf + (size_t)m * D) + lane;
        if constexpr (HIN_F32) { const GAS f32x4* hr = (const GAS f32x4*)((const float*)hin + (size_t)m * D) + lane;
#pragma unroll
            for (int j = 0; j < 8; ++j) { hd[j] = __builtin_nontemporal_load(hr + 64 * j); fd[j] = __builtin_nontemporal_load(fr + 64 * j); } }
        else { const GAS v2u* hr = (const GAS v2u*)((const bf16*)hin + (size_t)m * D) + lane;
#pragma unroll
            for (int j = 0; j < 8; ++j) { hbd[j] = __builtin_nontemporal_load(hr + 64 * j); fd[j] = __builtin_nontemporal_load(fr + 64 * j); } } };
    int m = gw;
    if (m < T) issue(m, h, hb, fw);
    if (m + NGW < T) issue(m + NGW, hn, hbn, fwn);
#pragma unroll 1
    for (; m < T; m += NGW) {
        const int mn = m + 2 * NGW;
        if (mn < T) issue(mn, hn2, hbn2, fwn2);
        __builtin_amdgcn_sched_barrier(0);
        f32x4 f[8]; float s0 = 0.f;
#pragma unroll
        for (int j = 0; j < 8; ++j) { f[j] = (f32x4){bflo(fw[j].x), bfhi(fw[j].x), bflo(fw[j].y), bfhi(fw[j].y)}; s0 += (f[j].x * f[j].x + f[j].y * f[j].y) + (f[j].z * f[j].z + f[j].w * f[j].w); }
        const float ra = cs / sqrtf(wave_sum(s0) * (1.0f / D) + EPS);
        float t0 = 0.f;
#pragma unroll
        for (int j = 0; j < 8; ++j) { const f32x4 gg = gpv[j]; f32x4 hv;
            if constexpr (HIN_F32) hv = h[j]; else hv = (f32x4){bflo(hb[j].x), bfhi(hb[j].x), bflo(hb[j].y), bfhi(hb[j].y)};
            f[j] = hv + f[j] * ra * gg; t0 += (f[j].x * f[j].x + f[j].y * f[j].y) + (f[j].z * f[j].z + f[j].w * f[j].w);
            if constexpr (HOUT_F32) { GAS f32x4* ho = (GAS f32x4*)((float*)hout + (size_t)m * D) + lane; __builtin_nontemporal_store(f[j], ho + 64 * j); }
            else { GAS v2u* ho = (GAS v2u*)((bf16*)hout + (size_t)m * D) + lane; v2u a; a.x = pk2(f[j].x, f[j].y); a.y = pk2(f[j].z, f[j].w); ho[64 * j] = a; } }
        if (rs) { const float qa = 1.0f / sqrtf(wave_sum(t0) * (1.0f / D) + EPS); if (lane == 0) rs[m] = qa; }
#pragma unroll
        for (int j = 0; j < 8; ++j) { if constexpr (HIN_F32) { h[j] = hn[j]; hn[j] = hn2[j]; } else { hb[j] = hbn[j]; hbn[j] = hbn2[j]; } fw[j] = fwn[j]; fwn[j] = fwn2[j]; }
    }
}
constexpr float NEGB = -1e30f;
struct LaneIx { int lane, r, h, q4, p4, blk; };
DI LaneIx lane_ix(int tid) { LaneIx L; L.lane = tid & 63; L.r = L.lane & 31; L.h = L.lane >> 5; const int i16 = L.lane & 15; L.q4 = i16 >> 2; L.p4 = i16 & 3; L.blk = (L.lane >> 4) & 1; return L; }
DI f32x16 mfma32(bf16x8 a, bf16x8 b, f32x16 c) { return __builtin_amdgcn_mfma_f32_32x32x16_bf16(a, b, c, 0, 0, 0); }
DI f32x16 zero16() { f32x16 z;
#pragma unroll
    for (int i = 0; i < 16; ++i) z[i] = 0.f;
    return z; }
template <int S> DI bf16x8 pack8(const f32x16& x) { typedef __bf16 bfv8 __attribute__((ext_vector_type(8))); bfv8 v;
#pragma unroll
    for (int j = 0; j < 8; ++j) v[j] = (__bf16)x[8 * S + j];
    return __builtin_bit_cast(bf16x8, v); }
DI s16x4 tr16(LAS const unsigned char* p) { return __builtin_amdgcn_ds_read_tr16_b64_v4i16((LAS s16x4*)p); }
DI bf16x8 cat4(s16x4 lo, s16x4 hi) { return __builtin_shufflevector(lo, hi, 0, 1, 2, 3, 4, 5, 6, 7); }
DI float alibi_slope(int i) { return exp2f(-8.0f * (float)(i + 1) / 18.0f); }

template <int DH> struct FlashSt { f32x16 o[DH / 32]; float m, l; };
template <int DH> DI void flash_init(FlashSt<DH>& st) {
#pragma unroll
    for (int d = 0; d < DH / 32; ++d) st.o[d] = zero16();
    st.m = NEGB; st.l = 0.f; }

template <int DH, int KSTR, int QR>
DI f32x16 qk32(const bf16x8 (&q)[QR], LAS const unsigned char* qx, LAS const unsigned char* Kb, const LaneIx& L) {
    bf16x8 kf[DH / 16], qt[DH / 16 - QR + 1];
#pragma unroll
    for (int ks = 0; ks < DH / 16; ++ks) kf[ks] = *(LAS const bf16x8*)(Kb + L.r * KSTR + (16 * ks + 8 * L.h) * 2);
#pragma unroll
    for (int ks = QR; ks < DH / 16; ++ks) qt[ks - QR] = *(LAS const bf16x8*)(qx + ((ks - QR) * 64 + L.lane) * 16);
    __builtin_amdgcn_sched_barrier(0);
    f32x16 s = zero16();
#pragma unroll
    for (int ks = 0; ks < DH / 16; ++ks) s = mfma32(kf[ks], ks < QR ? q[ks < QR ? ks : 0] : qt[ks < QR ? 0 : ks - QR], s);
    return s; }
constexpr float RESCALE_THR = 8.0f, SKIP_THR = 40.0f;
template <int DH, int KSTR, int VSTR, int QR, class OK>
DI void flash32(FlashSt<DH>& st, const bf16x8 (&q)[QR], LAS const unsigned char* qx, LAS const unsigned char* Kb, LAS const unsigned char* Vb, float c2, const LaneIx& L, bool allvalid, float bias0, float bstep, OK okfn) {
    f32x16 s = qk32<DH, KSTR, QR>(q, qx, Kb, L);
    asm volatile("" : "+v"(bstep));
    const float bl = bias0 + bstep * (float)(4 * L.h);
    float mx = NEGB;
    if (allvalid) {
#pragma unroll
        for (int i = 0; i < 16; ++i) { const float v = s[i] * c2 + (bstep * (float)((i & 3) + 8 * (i >> 2)) + bl); s[i] = v; mx = fmaxf(mx, v); }
    } else {
#pragma unroll
        for (int i = 0; i < 16; ++i) { const int kl = (i & 3) + 8 * (i >> 2) + 4 * L.h; const float v = okfn(kl) ? (s[i] * c2 + (bstep * (float)((i & 3) + 8 * (i >> 2)) + bl)) : NEGB; s[i] = v; mx = fmaxf(mx, v); }
    }
    mx = fmaxf(mx, __shfl_xor(mx, 32));
    if (__all(mx < st.m - SKIP_THR)) return;
    if (!__all(mx <= st.m + RESCALE_THR)) {
        const float mn = fmaxf(st.m, mx), alpha = ex2(st.m - mn);
        st.m = mn; st.l *= alpha;
#pragma unroll
        for (int d = 0; d < DH / 32; ++d)
#pragma unroll
            for (int i = 0; i < 16; ++i) st.o[d][i] *= alpha;
    }
    const float mn = st.m;
    float ps = 0.f;
    if (allvalid) {
#pragma unroll
        for (int i = 0; i < 16; ++i) { const float p = ex2(s[i] - mn); s[i] = p; ps += p; }
    } else {
#pragma unroll
        for (int i = 0; i < 16; ++i) { const float p = (s[i] > -1e29f) ? ex2(s[i] - mn) : 0.f; s[i] = p; ps += p; }
    }
    st.l += ps;
    const bf16x8 p0 = pack8<0>(s), p1 = pack8<1>(s);
    { LAS const unsigned char* vp = Vb + (4 * L.h + L.q4) * VSTR + (16 * L.blk + 4 * L.p4) * 2;
      s16x4 vf[DH / 32][4];
#pragma unroll
      for (int d = 0; d < DH / 32; ++d) { vf[d][0] = tr16(vp + 64 * d); vf[d][1] = tr16(vp + 64 * d + 8 * VSTR); vf[d][2] = tr16(vp + 64 * d + 16 * VSTR); vf[d][3] = tr16(vp + 64 * d + 24 * VSTR); }
      __builtin_amdgcn_sched_barrier(0);
#pragma unroll
      for (int d = 0; d < DH / 32; ++d) { st.o[d] = mfma32(cat4(vf[d][0], vf[d][1]), p0, st.o[d]); st.o[d] = mfma32(cat4(vf[d][2], vf[d][3]), p1, st.o[d]); } }
}
template <int DH> DI float flash_l(const FlashSt<DH>& st) { return st.l + __shfl_xor(st.l, 32); }

template <int DH, int STR, int NR, class RF>
DI void stage_rows(LAS unsigned char* dst, RF rowptr, int tid) {
    constexpr int CPR = DH / 8, TOTAL = NR * CPR, NK = TOTAL / NTHREADS; static_assert(TOTAL % NTHREADS == 0, "stage_rows: chunk count");
    v4u v[NK]; bool okv[NK];
#pragma unroll
    for (int k = 0; k < NK; ++k) { const int id = tid + k * NTHREADS, row = id / CPR, ch = id % CPR; const bf16* p = rowptr(row, okv[k]); v[k] = *(const GAS v4u*)(p + ch * 8); }
#pragma unroll
    for (int k = 0; k < NK; ++k) { const int id = tid + k * NTHREADS, row = id / CPR, ch = id % CPR; const v4u z = (v4u){0u, 0u, 0u, 0u};
        *(LAS v4u*)(dst + row * STR + ch * 16) = okv[k] ? v[k] : z; }
}
template <int DH> DI void store_ot(const f32x16 (&o)[DH / 32], float sc, bf16* orow, const LaneIx& L) {
#pragma unroll
    for (int d = 0; d < DH / 32; ++d)
#pragma unroll
        for (int g4 = 0; g4 < 4; ++g4) { v2u w; w.x = pk2(o[d][4 * g4] * sc, o[d][4 * g4 + 1] * sc); w.y = pk2(o[d][4 * g4 + 2] * sc, o[d][4 * g4 + 3] * sc);
            *(GAS v2u*)(orow + 32 * d + 8 * g4 + 4 * L.h) = w; }
}

constexpr int K64STR = 144, V64STR = 192, K128STR = 272, V128STR = 320;
constexpr float C2_64 = 0.125f * LOG2E, C2_128 = 0.08838834764831845f * LOG2E;
DI void dil_unit(const WsPtrs& W, LAS unsigned char* lds, int idx, int tid, int wave, const LaneIx& L) {
    const int gi = idx >> 9; int rem = idx & 511; const int b = rem >> 8; rem &= 255; const int hd = rem >> 6; rem &= 63;
    const int dsh = 2 * gi, d = 1 << dsh, rs = rem & (d - 1), nt = rem >> dsh;
    const int n0 = nt * 256, nk0 = n0 - 128;
    const bf16* base = W.QKV() + (size_t)b * SEQ * QP + gi * 256 + hd * 64;
    LAS unsigned char* Kt = lds; LAS unsigned char* Vt = lds + 384 * K64STR;
    __syncthreads();
    stage_rows<64, K64STR, 384>(Kt, [&](int i, bool& ok) -> const bf16* { const int n = nk0 + i; ok = n >= 0; return base + (size_t)(((ok ? n : 0) << dsh) + rs) * QP + C_KB; }, tid);
    stage_rows<64, V64STR, 384>(Vt, [&](int i, bool& ok) -> const bf16* { const int n = nk0 + i; ok = n >= 0; return base + (size_t)(((ok ? n : 0) << dsh) + rs) * QP + C_VB; }, tid);
    __syncthreads();
    const int nq = n0 + 32 * wave + L.r, tq = (nq << dsh) + rs;
    const bf16* qrow = base + (size_t)tq * QP + C_QB;
    bf16x8 q[4];
#pragma unroll
    for (int ks = 0; ks < 4; ++ks) q[ks] = *(const GAS bf16x8*)(qrow + 16 * ks + 8 * L.h);
    const float sl2 = alibi_slope(6 * gi + (hd < 2 ? hd + 1 : hd + 2)) * LOG2E * (float)d;
    FlashSt<64> st; flash_init(st);
#pragma unroll 1
    for (int sb = 4; sb >= 0; --sb) { const int kb = 32 * wave + 32 * sb, relb = 128 - 32 * sb + L.r, nkb = nk0 + kb;
        flash32<64, K64STR, V64STR, 4>(st, q, nullptr, Kt + kb * K64STR, Vt + kb * V64STR, C2_64, L, sb >= 1 && sb <= 3 && nkb >= 0, -sl2 * (float)relb, sl2,
            [&](int kl) { const int rel = relb - kl; return rel >= 0 && rel <= 128 && (nkb + kl) >= 0; }); }
    const float l = flash_l(st), inv = 1.0f / l;
    const size_t orow = (size_t)gi * T + (size_t)b * SEQ + tq;
    store_ot<64>(st.o, inv, W.DILO() + orow * 256 + hd * 64, L);
    if (L.h == 0) W.DILL()[orow * 4 + hd] = st.m + log2f(l);
}
DI void dil_merge(const WsPtrs& W, int gtid, int gthreads) {
    for (int it = gtid; it < T * 32; it += gthreads) { const int row = it >> 5, ch = it & 31, hd = ch >> 3;
        const float l0 = W.DILL()[(size_t)row * 4 + hd], l1 = W.DILL()[((size_t)T + row) * 4 + hd], l2 = W.DILL()[((size_t)2 * T + row) * 4 + hd];
        const float mx = fmaxf(l0, fmaxf(l1, l2)); float w0 = ex2(l0 - mx), w1 = ex2(l1 - mx), w2 = ex2(l2 - mx); const float inv = 1.0f / (w0 + w1 + w2); w0 *= inv; w1 *= inv; w2 *= inv;
        const v4u a = *(const GAS v4u*)(W.DILO() + (size_t)row * 256 + ch * 8), bq = *(const GAS v4u*)(W.DILO() + ((size_t)T + row) * 256 + ch * 8), c = *(const GAS v4u*)(W.DILO() + ((size_t)2 * T + row) * 256 + ch * 8);
        v4u o;
        o.x = pk2(w0 * bflo(a.x) + w1 * bflo(bq.x) + w2 * bflo(c.x), w0 * bfhi(a.x) + w1 * bfhi(bq.x) + w2 * bfhi(c.x));
        o.y = pk2(w0 * bflo(a.y) + w1 * bflo(bq.y) + w2 * bflo(c.y), w0 * bfhi(a.y) + w1 * bfhi(bq.y) + w2 * bfhi(c.y));
        o.z = pk2(w0 * bflo(a.z) + w1 * bflo(bq.z) + w2 * bflo(c.z), w0 * bfhi(a.z) + w1 * bfhi(bq.z) + w2 * bfhi(c.z));
        o.w = pk2(w0 * bflo(a.w) + w1 * bflo(bq.w) + w2 * bflo(c.w), w0 * bfhi(a.w) + w1 * bfhi(bq.w) + w2 * bfhi(c.w));
        *(GAS v4u*)(W.YB() + (size_t)row * 256 + ch * 8) = o; }
}
DI void mem_unit(const WsPtrs& W, LAS unsigned char* lds, int idx, int tid, int wave, const LaneIx& L) {
    const int b = idx >> 8, hd = (idx >> 6) & 3, qt = idx & 63;
    const size_t row = (size_t)b * SEQ + 256 * qt + 32 * wave + L.r;
    const bf16* qrow = W.QKV() + row * QP + C_QM + hd * 128;
    bf16x8 q[8];
#pragma unroll
    for (int ks = 0; ks < 8; ++ks) q[ks] = *(const GAS bf16x8*)(qrow + 16 * ks + 8 * L.h);
    LAS unsigned char* Kt = lds; LAS unsigned char* Vt = lds + 128 * K128STR;
    FlashSt<128> st; flash_init(st);
#pragma unroll 1
    for (int half = 0; half < 2; ++half) {
        const bf16* kb = W.MEMKV() + (size_t)(b * MEML + 128 * half) * 1024 + hd * 128;
        __syncthreads();
        stage_rows<128, K128STR, 128>(Kt, [&](int i, bool& ok) -> const bf16* { ok = true; return kb + (size_t)i * 1024; }, tid);
        stage_rows<128, V128STR, 128>(Vt, [&](int i, bool& ok) -> const bf16* { ok = true; return kb + (size_t)i * 1024 + 512; }, tid);
        __syncthreads();
#pragma unroll 1
        for (int sb = 0; sb < 4; ++sb) flash32<128, K128STR, V128STR, 8>(st, q, nullptr, Kt + 32 * sb * K128STR, Vt + 32 * sb * V128STR, C2_128, L, true, 0.f, 0.f, [](int) { return true; });
    }
    const float l = flash_l(st);
    store_ot<128>(st.o, 1.0f / l, W.YM() + row * 512 + hd * 128, L);
}
DI void cmp_unit(const WsPtrs& W, LAS unsigned char* lds, int idx, int tid, int wave, const LaneIx& L) {
    const int which = idx >> 7, rg = idx & 127;
    const bf16* w1t = which ? W.wc1v() : W.wc1k(); const bf16* w2t = which ? W.wc2v() : W.wc2k();
    const int rho = 32 * rg + L.r, b = rho >> 11, c = (rho >> 1) & 1023, g = rho & 1;
    const bf16* src = W.QKV() + (size_t)b * SEQ * QP + (which ? C_VC : C_KC) + g * 128;
    f32x16 hid[8];
#pragma unroll
    for (int i = 0; i < 8; ++i) hid[i] = zero16();
    auto issue = [&](int j, bf16x8 (&af)[8], bf16x8& bf) { const int kt = 8 * wave + (j >> 2), ks = j & 3, pos = kt >> 1, e0 = (kt & 1) * 64; int tok = 16 * c + pos; tok = tok < SEQ ? tok : SEQ - 1;
        bf = *(const GAS bf16x8*)(src + (size_t)tok * QP + e0 + 8 * L.h + 16 * ks);
        const bf16* ap = w1t + ((size_t)((kt * 4 + ks) * 8) * 64 + L.h * 32 + L.r) * 8;
#pragma unroll
        for (int hb = 0; hb < 8; ++hb) af[hb] = *(const GAS bf16x8*)(ap + (size_t)hb * 512); };
    bf16x8 a0[8], a1[8], b0, b1;
    issue(0, a0, b0);
#pragma unroll 1
    for (int j = 0; j < 32; j += 2) {
        issue(j + 1, a1, b1);
        __builtin_amdgcn_sched_barrier(0);
#pragma unroll
        for (int hb = 0; hb < 8; ++hb) hid[hb] = mfma32(a0[hb], b0, hid[hb]);
        __builtin_amdgcn_sched_barrier(0);
        issue(j + 2 < 32 ? j + 2 : 31, a0, b0);
        __builtin_amdgcn_sched_barrier(0);
#pragma unroll
        for (int hb = 0; hb < 8; ++hb) hid[hb] = mfma32(a1[hb], b1, hid[hb]);
        __builtin_amdgcn_sched_barrier(0);
    }
    __syncthreads();
#pragma unroll
    for (int half = 4; half >= 1; half >>= 1) {
        if (wave >= half && wave < 2 * half) { LAS float* slot = (LAS float*)(lds + (wave - half) * 32768);
#pragma unroll
            for (int hb = 0; hb < 8; ++hb)
#pragma unroll
                for (int i = 0; i < 16; ++i) slot[(hb * 16 + i) * 64 + L.lane] = hid[hb][i]; }
        __syncthreads();
        if (wave < half) { const LAS float* slot = (const LAS float*)(lds + wave * 32768);
#pragma unroll
            for (int hb = 0; hb < 8; ++hb)
#pragma unroll
                for (int i = 0; i < 16; ++i) hid[hb][i] += slot[(hb * 16 + i) * 64 + L.lane]; }
        __syncthreads();
    }
    if (wave == 0) {
        const float* cb = W.cbias() + which * 256;
        bf16x8 ph[8][2];
#pragma unroll
        for (int hb = 0; hb < 8; ++hb) {
#pragma unroll
            for (int i = 0; i < 16; ++i) { const float v = hid[hb][i] + cb[32 * hb + (i & 3) + 8 * (i >> 2) + 4 * L.h]; hid[hb][i] = v * sigm(v); }
            ph[hb][0] = pack8<0>(hid[hb]); ph[hb][1] = pack8<1>(hid[hb]); }
        f32x16 out[4];
#pragma unroll
        for (int i = 0; i < 4; ++i) out[i] = zero16();
#pragma unroll
        for (int hb = 0; hb < 8; ++hb) { s16x4 wa[4][4];
#pragma unroll
            for (int ob = 0; ob < 4; ++ob) { const bf16* wr = w2t + (size_t)(32 * ob + L.r) * 256 + 32 * hb + 4 * L.h;
                wa[ob][0] = *(const GAS s16x4*)(wr); wa[ob][1] = *(const GAS s16x4*)(wr + 8); wa[ob][2] = *(const GAS s16x4*)(wr + 16); wa[ob][3] = *(const GAS s16x4*)(wr + 24); }
            __builtin_amdgcn_sched_barrier(0);
#pragma unroll
            for (int ob = 0; ob < 4; ++ob) { out[ob] = mfma32(cat4(wa[ob][0], wa[ob][1]), ph[hb][0], out[ob]); out[ob] = mfma32(cat4(wa[ob][2], wa[ob][3]), ph[hb][1], out[ob]); }
            __builtin_amdgcn_sched_barrier(0);
        }
        bf16* dst = (which ? W.VCMP() : W.KCMP()) + ((size_t)(b * 2 + g) * 1024 + c) * 128;
        store_ot<128>(out, 1.0f, dst, L);
        if (which == 0) {
            float ss = 0.f;
#pragma unroll
            for (int ob = 0; ob < 4; ++ob)
#pragma unroll
                for (int i = 0; i < 16; ++i) ss += out[ob][i] * out[ob][i];
            ss += __shfl_xor(ss, 32);
            if (L.h == 0) ((float*)(W.ws + WS_KNC))[(size_t)(b * 2 + g) * 1024 + c] = sqrtf(ss);
        }
    }
}
DI void key_norms(const WsPtrs& W, int gw, int NGW, int lane) {
#pragma unroll 1
    for (int wu = gw; wu < 2048; wu += NGW) { const int type = wu >> 10, b = (wu >> 9) & 1, g = (wu >> 8) & 1, j = wu & 255;
        const bf16* rp = W.QKV() + ((size_t)b * SEQ + 64 * j + lane) * QP + (type ? C_KW : C_KS) + g * 128;
        v4u x[16];
#pragma unroll
        for (int k = 0; k < 16; ++k) x[k] = *(const GAS v4u*)(rp + 8 * k);
        float ss = 0.f;
#pragma unroll
        for (int k = 0; k < 16; ++k) { ss += bflo(x[k].x) * bflo(x[k].x) + bfhi(x[k].x) * bfhi(x[k].x); ss += bflo(x[k].y) * bflo(x[k].y) + bfhi(x[k].y) * bfhi(x[k].y);
            ss += bflo(x[k].z) * bflo(x[k].z) + bfhi(x[k].z) * bfhi(x[k].z); ss += bflo(x[k].w) * bflo(x[k].w) + bfhi(x[k].w) * bfhi(x[k].w); }
#pragma unroll
        for (int o = 1; o < 64; o <<= 1) ss = fmaxf(ss, __shfl_xor(ss, o));
        if (lane == 0) ((float*)(W.ws + WS_KNS))[wu] = sqrtf(ss); }
}
constexpr int NSA_BUF = 64 * K128STR + 64 * V128STR;
constexpr int NSA_SEL_OFF = 2 * NSA_BUF, NSA_WUN_OFF = NSA_SEL_OFF + 8192, NSA_GUN_OFF = NSA_WUN_OFF + 256, NSA_LIST_OFF = NSA_GUN_OFF + 256, NSA_NLIST_OFF = NSA_LIST_OFF + 2048, NSA_QX_OFF = NSA_NLIST_OFF + 256, NSA_STAT_OFF = NSA_QX_OFF + 8 * 4096;
constexpr int NSA_PM_OFF = NSA_STAT_OFF + 3 * NTHREADS * 8;
constexpr int NSA_PMW_OFF = NSA_PM_OFF + 1024, NSA_PMC_OFF = NSA_PMW_OFF + 1024, NSA_VOTE_OFF = NSA_PMC_OFF + 64;
static_assert(NSA_VOTE_OFF + 64 <= RING_BYTES + 14336, "NSA LDS map");
#ifndef NSA_CUT
#define NSA_CUT 7
#endif
static_assert(256 * K128STR <= NSA_SEL_OFF, "step A stages 256 compressed keys at a time below the masks");
#define TOPN 13
typedef unsigned long long u64;
DI void top_insert(u64 (&tk)[TOPN], u64 c) {
#pragma unroll
    for (int k = 0; k < TOPN; ++k) { const u64 a = tk[k]; const bool gt = c > a; tk[k] = gt ? c : a; c = gt ? a : c; }
}
DI u64 top_key(float score, int j) { return ((u64)__builtin_bit_cast(unsigned, score) << 32) | (u64)(0xffffffffu - (unsigned)j); }
DI void nsa_unit(const WsPtrs& W, LAS unsigned char* lds, int idx, int tid, int wave, const LaneIx& L) {
    const int b = idx >> 7, g = (idx >> 6) & 1, qt = idx & 63;
    const int t0 = qt * 256, tw0 = t0 + 32 * wave, t = tw0 + L.r, cur = t >> 6;
    const bf16* qkvb = W.QKV() + (size_t)b * SEQ * QP;
    const bf16* kcmp = W.KCMP() + (size_t)(b * 2 + g) * 1024 * 128; const bf16* vcmp = W.VCMP() + (size_t)(b * 2 + g) * 1024 * 128;
    LAS unsigned char* Kt = lds; LAS unsigned char* Vt = lds + 64 * K128STR;
    LAS unsigned* selm = (LAS unsigned*)(lds + NSA_SEL_OFF); LAS unsigned* wun = (LAS unsigned*)(lds + NSA_WUN_OFF); LAS unsigned* gun = (LAS unsigned*)(lds + NSA_GUN_OFF);
    int n_c = t0 / 16 + 15; n_c = n_c < NCMP ? n_c : NCMP;
    const int ntile = (n_c + 63) >> 6, wave_cmax = t0 / 16 + 2 * wave;
    float sl2[3];
#pragma unroll
    for (int hh = 0; hh < 3; ++hh) sl2[hh] = alibi_slope(3 * (g * 3 + hh)) * LOG2E;
    if (tid == 0) { LAS unsigned* list = (LAS unsigned*)(lds + NSA_LIST_OFF); for (int i = 0; i < ntile; ++i) list[i] = (unsigned)(ntile - 1 - i); }
    if (wave < 2) { const float* kn = (const float*)(W.ws + WS_KNS) + (size_t)((wave * 2 + b) * 2 + g) * 256; const f32x4 v = *(const GAS f32x4*)(kn + 4 * L.lane);
        float p0 = v.x, p1 = fmaxf(p0, v.y), p2 = fmaxf(p1, v.z), p3 = fmaxf(p2, v.w), c = p3;
#pragma unroll
        for (int o = 1; o < 64; o <<= 1) { const float n = __shfl_up(c, o); if (L.lane >= o) c = fmaxf(c, n); }
        float ex = __shfl_up(c, 1); if (L.lane == 0) ex = 0.f;
        LAS float* pm = (LAS float*)(lds + (wave ? NSA_PMW_OFF : NSA_PM_OFF)) + 4 * L.lane;
        pm[0] = fmaxf(p0, ex); pm[1] = fmaxf(p1, ex); pm[2] = fmaxf(p2, ex); pm[3] = fmaxf(p3, ex); }
    if (wave == 2) { const float* knc = (const float*)(W.ws + WS_KNC) + (size_t)(b * 2 + g) * 1024; float pm = 0.f;
#pragma unroll 1
        for (int i = 0; i < ntile; ++i) { const int c = 64 * i + L.lane; float v = c < NCMP ? knc[c] : 0.f;
#pragma unroll
            for (int o = 1; o < 64; o <<= 1) v = fmaxf(v, __shfl_xor(v, o));
            pm = fmaxf(pm, v); if (L.lane == 0) ((LAS float*)(lds + NSA_PMC_OFF))[i] = pm; } }
    __syncthreads();
#pragma unroll 1
    for (int pass = 0; pass < 6; ++pass) { const int hh = pass < 3 ? pass : pass - 3;
        if (pass == 3) {
        const int tS = opaque_v(t), curS = tS >> 6; const LaneIx LS = lane_ix(opaque_v(tid));
        bf16x8 q3[3][8];
#pragma unroll
        for (int hh = 0; hh < 3; ++hh) { const bf16* qrow = qkvb + (size_t)tS * QP + C_QA + (g * 3 + hh) * 128;
#pragma unroll
            for (int ks = 0; ks < 8; ++ks) q3[hh][ks] = *(const GAS bf16x8*)(qrow + 16 * ks + 8 * LS.h); }
        float m3[3], inv3[3];
        { const LAS float* stf = (const LAS float*)(lds + NSA_STAT_OFF);
#pragma unroll
          for (int hh = 0; hh < 3; ++hh) { m3[hh] = stf[(hh * NTHREADS + tid) * 2]; const float lt = stf[(hh * NTHREADS + tid) * 2 + 1]; inv3[hh] = lt > 0.f ? 1.0f / lt : 0.f; } }
        u64 tk[TOPN];
#pragma unroll
        for (int k = 0; k < TOPN; ++k) tk[k] = 0ull;
        float carry = 0.f;
        float qn3[3];
#pragma unroll
        for (int hh = 0; hh < 3; ++hh) { float ss = 0.f;
#pragma unroll
            for (int ks = 0; ks < 8; ++ks)
#pragma unroll
                for (int j = 0; j < 8; ++j) { const float a = bf2f((bf16)q3[hh][ks][j]); ss += a * a; }
            qn3[hh] = sqrtf(ss + __shfl_xor(ss, 32)) * (C2_128 * 1.02f); }
        const int E = (t0 / 16 + 16 + 31) & ~31, NS = (E + 255) >> 8;
        auto skipfn = [&](int cbx) -> bool {
            const float T = tk[TOPN - 1] != 0ull ? __builtin_bit_cast(float, (unsigned)(tk[TOPN - 1] >> 32)) : -1.0f;
            const float kn = ((LAS const float*)(lds + NSA_PMC_OFF))[(cbx + 31) >> 6]; const int dm = tS - (16 * (cbx + 31) + 31); const float dmin = (float)(dm > 0 ? dm : 0);
            float ub = 0.f;
#pragma unroll
            for (int hh = 0; hh < 3; ++hh) ub += ex2(qn3[hh] * kn - sl2[hh] * dmin - m3[hh]) * inv3[hh];
            return __all(4.1f * ub < T); };
        float dfs = 0.f; int dfj = -1;
#pragma unroll 1
        for (int step = 0; step < NS * 8; ++step) {
            const bool ph1 = step < 8; const int sidx = ph1 ? NS - 1 : ((step - 8) >> 3), sub = step & 7, lo = E - 256 * (NS - sidx);
            if (sub == 0) {
                __syncthreads();
                stage_rows<128, K128STR, 256>(Kt, [&](int i, bool& ok) -> const bf16* { const int c = lo + i; ok = c >= 0 && c < NCMP; return kcmp + (size_t)(ok ? c : 0) * 128; }, opaque_v(tid));
                __syncthreads();
                if (!ph1 && sidx == 0) carry = 0.f;
            }
            const int cb = lo + 32 * sub;
            if (cb < 0 || cb > wave_cmax) continue;
            bool defer = false;
            if (!ph1) { const bool last = step == NS * 8 - 1; const bool skB = skipfn(cb); const bool skN = last ? false : skipfn(cb + 32);
                if (skB && skN) { carry = 0.f; continue; } }
            else defer = sub == 0 && NS >= 2;
            {
                const int dist0 = tS - (16 * cb + 31);
                f32x16 imp = zero16();
#pragma unroll
                for (int hh = 0; hh < 3; ++hh) { const f32x16 s = qk32<128, K128STR, 8>(q3[hh], nullptr, Kt + 32 * sub * K128STR, LS);
#pragma unroll
                    for (int i = 0; i < 16; ++i) { const int kl = (i & 3) + 8 * (i >> 2) + 4 * LS.h, dist = dist0 - 16 * kl;
                        const float p = dist >= 0 ? ex2(s[i] * C2_128 - sl2[hh] * (float)dist - m3[hh]) * inv3[hh] : 0.f; imp[i] += p; } }
                const float sx0 = __shfl_xor(imp[3], 32), sx1 = __shfl_xor(imp[7], 32), sx2 = __shfl_xor(imp[11], 32), sx3 = __shfl_xor(imp[15], 32), cx = __shfl_xor(carry, 32);
                float sc[4];
                sc[0] = 0.5f * (LS.h ? sx0 : cx) + imp[0] + imp[1] + imp[2] + 0.5f * imp[3];
                sc[1] = 0.5f * (LS.h ? sx1 : sx0) + imp[4] + imp[5] + imp[6] + 0.5f * imp[7];
                sc[2] = 0.5f * (LS.h ? sx2 : sx1) + imp[8] + imp[9] + imp[10] + 0.5f * imp[11];
                sc[3] = 0.5f * (LS.h ? sx3 : sx2) + imp[12] + imp[13] + imp[14] + 0.5f * imp[15];
                carry = imp[15];
                if (defer) { dfs = imp[0] + imp[1] + imp[2] + 0.5f * imp[3]; dfj = cb >> 2; }
#pragma unroll
                for (int g4 = 0; g4 < 4; ++g4) { const int j = (cb >> 2) + 2 * g4 + LS.h; bool ok = j >= 1 && j <= curS - 2; if (g4 == 0 && defer && LS.h == 0) ok = false; const u64 ck = ok ? top_key(sc[g4], j) : 0ull;
                    if (__any(ck > tk[TOPN - 1])) top_insert(tk, ck); }
            }
        }
        if (dfj >= 0) { const float cx = __shfl_xor(carry, 32); const float scd = 0.5f * cx + dfs;
            const bool ok = LS.h == 0 && dfj >= 1 && dfj <= curS - 2; const u64 ck = ok ? top_key(scd, dfj) : 0ull;
            if (__any(ck > tk[TOPN - 1])) top_insert(tk, ck); }
        { u64 pk[TOPN];
#pragma unroll
            for (int k = 0; k < TOPN; ++k) { const unsigned lo = (unsigned)__shfl_xor((int)(unsigned)tk[k], 32), hi = (unsigned)__shfl_xor((int)(unsigned)(tk[k] >> 32), 32); pk[k] = ((u64)hi << 32) | lo; }
#pragma unroll
            for (int k = 0; k < TOPN; ++k) top_insert(tk, pk[k]); }
        unsigned wsel[8];
#pragma unroll
        for (int wd = 0; wd < 8; ++wd) { unsigned v = (wd == 0) ? 1u : 0u; v |= ((curS >> 5) == wd) ? (1u << (curS & 31)) : 0u; if (curS >= 1) v |= (((curS - 1) >> 5) == wd) ? (1u << ((curS - 1) & 31)) : 0u; wsel[wd] = v; }
#pragma unroll
        for (int k = 0; k < TOPN; ++k) { const bool ok = tk[k] != 0ull; const unsigned jj = 0xffffffffu - (unsigned)tk[k]; const unsigned wj = jj >> 5, bit = 1u << (jj & 31);
#pragma unroll
            for (int wd = 0; wd < 8; ++wd) wsel[wd] |= (ok && wj == (unsigned)wd) ? bit : 0u; }
#pragma unroll
        for (int wd = 0; wd < 8; ++wd) { if (LS.h == 0) selm[(32 * wave + LS.r) * 8 + wd] = wsel[wd];
            unsigned u = wsel[wd]; u |= __shfl_xor(u, 1); u |= __shfl_xor(u, 2); u |= __shfl_xor(u, 4); u |= __shfl_xor(u, 8); u |= __shfl_xor(u, 16);
            if (LS.lane == 0) wun[wave * 8 + wd] = u; }
        __syncthreads();
        if (tid < 8) { unsigned u = 0; for (int w = 0; w < 8; ++w) u |= wun[w * 8 + tid]; gun[tid] = u; }
        __syncthreads();
        if (tid == 0) {
            LAS unsigned* list = (LAS unsigned*)(lds + NSA_LIST_OFF); int n = ntile;
            for (int wd = 7; wd >= 0; --wd) { unsigned wm = gun[wd]; while (wm) { const int bit = 31 - __builtin_clz(wm); wm &= ~(1u << bit); list[n++] = 0x10000u | (unsigned)(32 * wd + bit); } }
            *(LAS int*)(lds + NSA_NLIST_OFF + 4) = n;
            for (int i = 11; i >= 0; --i) if (t0 - 512 + 64 * i + 63 >= 0) list[n++] = 0x20000u | (unsigned)i;
            *(LAS int*)(lds + NSA_NLIST_OFF) = n; }
        __syncthreads();
        }
        const int head = g * 3 + hh; const float s2 = alibi_slope(3 * head) * LOG2E;
        const int tq = opaque_v(t);
        const bf16* trow = qkvb + (size_t)tq * QP;
        bf16x8 q[4];
        LAS unsigned char* qx = lds + NSA_QX_OFF + wave * 4096;
        const LaneIx Lq = lane_ix(opaque_v(tid));
#pragma unroll
        for (int ks = 0; ks < 4; ++ks) q[ks] = *(const GAS bf16x8*)(trow + C_QA + head * 128 + 16 * ks + 8 * Lq.h);
        float qss = 0.f;
        { bf16x8 qt4[4];
#pragma unroll
          for (int ks = 4; ks < 8; ++ks) qt4[ks - 4] = *(const GAS bf16x8*)(trow + C_QA + head * 128 + 16 * ks + 8 * Lq.h);
#pragma unroll
          for (int ks = 4; ks < 8; ++ks) *(LAS bf16x8*)(qx + ((ks - 4) * 64 + Lq.lane) * 16) = qt4[ks - 4];
#pragma unroll
          for (int ks = 0; ks < 4; ++ks)
#pragma unroll
              for (int j = 0; j < 8; ++j) { const float a = bf2f((bf16)q[ks][j]), c = bf2f((bf16)qt4[ks][j]); qss += a * a + c * c; } }
        const float qn = sqrtf(qss + __shfl_xor(qss, 32)) * (C2_128 * 1.02f);
        FlashSt<128> st; flash_init(st);
        const LAS unsigned* list = (const LAS unsigned*)(lds + NSA_LIST_OFF);
        const int e0 = pass < 3 ? 0 : ntile, nlist = pass < 3 ? ntile : __builtin_amdgcn_readfirstlane(*(const LAS int*)(lds + NSA_NLIST_OFF));
        v4u kreg[2], vreg[2];
        auto tile_geom = [&](unsigned e, const bf16*& kb, const bf16*& vb, int& pitch, int& r0, int& r1) {
            const int ty = (int)(e >> 16), ix = (int)(e & 0xffffu); r0 = 0; r1 = 64;
            if (ty == 0) { kb = kcmp + (size_t)(64 * ix) * 128; vb = vcmp + (size_t)(64 * ix) * 128; pitch = 128; r1 = NCMP - 64 * ix; }
            else if (ty == 1) { kb = qkvb + (size_t)(64 * ix) * QP + C_KS + g * 128; vb = kb + (C_VS - C_KS); pitch = QP; }
            else { const int tk0 = t0 - 512 + 64 * ix; kb = qkvb + (ptrdiff_t)tk0 * QP + C_KW + g * 128; vb = kb + (C_VW - C_KW); pitch = QP; r0 = -tk0; } };
        auto tile_load = [&](unsigned e, int tidx) {
            const bf16 *kb, *vb; int pitch, r0, r1; tile_geom(e, kb, vb, pitch, r0, r1);
#pragma unroll
            for (int k = 0; k < 2; ++k) { const int id = tidx + k * NTHREADS, row = id >> 4, ch = id & 15; const bool ok = row >= r0 && row < r1; const int rc = ok ? row : (r0 > 0 ? r0 : 0);
                kreg[k] = *(const GAS v4u*)(kb + (ptrdiff_t)rc * pitch + ch * 8); vreg[k] = *(const GAS v4u*)(vb + (ptrdiff_t)rc * pitch + ch * 8); } };
        auto tile_store = [&](unsigned e, int buf, int tidx) { LAS unsigned char* kt = lds + buf * NSA_BUF; LAS unsigned char* vt = kt + 64 * K128STR;
            const bf16 *kb, *vb; int pitch, r0, r1; tile_geom(e, kb, vb, pitch, r0, r1); const v4u z = (v4u){0u, 0u, 0u, 0u};
#pragma unroll
            for (int k = 0; k < 2; ++k) { const int id = tidx + k * NTHREADS, row = id >> 4, ch = id & 15; const bool ok = row >= r0 && row < r1;
                *(LAS v4u*)(kt + row * K128STR + ch * 16) = ok ? kreg[k] : z; *(LAS v4u*)(vt + row * V128STR + ch * 16) = ok ? vreg[k] : z; } };
        auto branch_done = [&](int ty) {
            const int tq2 = opaque_v(t);
            const int hq2 = opaque_v(tid) >> 5 & 1;
            const float gsel = sigm(bf2f(qkvb[(size_t)tq2 * QP + C_GN + head * 3 + ty]));
            const float lt = flash_l(st), sc = lt > 0.f ? gsel / lt : 0.f;
            float* yacc = (float*)W.F() + ((size_t)b * SEQ + tq2) * 768 + head * 128 + 4 * hq2;
            bf16* yo = W.YA() + ((size_t)b * SEQ + tq2) * 768 + head * 128 + 4 * hq2;
            f32x4 acc[4][4];
            if (ty != 0) {
#pragma unroll
                for (int d = 0; d < 4; ++d)
#pragma unroll
                    for (int g4 = 0; g4 < 4; ++g4) acc[d][g4] = *(const GAS f32x4*)(yacc + 32 * d + 8 * g4);
            } else {
#pragma unroll
                for (int d = 0; d < 4; ++d)
#pragma unroll
                    for (int g4 = 0; g4 < 4; ++g4) acc[d][g4] = (f32x4){0.f, 0.f, 0.f, 0.f};
            }
#pragma unroll
            for (int d = 0; d < 4; ++d)
#pragma unroll
                for (int g4 = 0; g4 < 4; ++g4) { f32x4 a = acc[d][g4];
                    a = (f32x4){a.x + st.o[d][4 * g4] * sc, a.y + st.o[d][4 * g4 + 1] * sc, a.z + st.o[d][4 * g4 + 2] * sc, a.w + st.o[d][4 * g4 + 3] * sc};
                    if (ty != 2) *(GAS f32x4*)(yacc + 32 * d + 8 * g4) = a; else { v2u w; w.x = pk2(a.x, a.y); w.y = pk2(a.z, a.w); *(GAS v2u*)(yo + 32 * d + 8 * g4) = w; } }
            flash_init(st); };
        __syncthreads();
        { const int tid0 = opaque_v(tid); const unsigned d0 = (unsigned)__builtin_amdgcn_readfirstlane((int)list[e0]); tile_load(d0, tid0); tile_store(d0, 0, tid0); }
        __syncthreads();
        int curty = pass < 3 ? 0 : 1;
        const int winstart = __builtin_amdgcn_readfirstlane(*(const LAS int*)(lds + NSA_NLIST_OFF + 4));
        LAS unsigned* votes = (LAS unsigned*)(lds + NSA_VOTE_OFF);
        bool fresh = true;
#pragma unroll 1
        for (int e = e0; e < nlist; ++e) {
            if (!fresh) {
                LAS const unsigned* vp = votes + ((e - 1 - e0) & 1) * 8; const v4u va = *(LAS const v4u*)vp, vb = *(LAS const v4u*)(vp + 4);
                const unsigned all8 = va.x & va.y & va.z & va.w & vb.x & vb.y & vb.z & vb.w;
                if (__builtin_amdgcn_readfirstlane((int)all8) != 0) {
                    const int en = curty == 0 ? nlist : (curty == 1 ? winstart : nlist);
                    if (en >= nlist) break;
                    e = en;
                    { const int tid0 = opaque_v(tid); const unsigned dj = (unsigned)__builtin_amdgcn_readfirstlane((int)list[e]); tile_load(dj, tid0); tile_store(dj, (e - e0) & 1, tid0); }
                    __syncthreads();
                    fresh = true;
                }
            }
            const unsigned de = (unsigned)__builtin_amdgcn_readfirstlane((int)list[e]);
            const int tide = opaque_v(tid); const LaneIx Le = lane_ix(tide);
            if (e + 1 < nlist) tile_load((unsigned)__builtin_amdgcn_readfirstlane((int)list[e + 1]), tide);
            __builtin_amdgcn_sched_barrier(0);
            const int ty = (int)(de >> 16), ix = (int)(de & 0xffffu);
            if (ty != curty) { branch_done(curty); curty = ty; }
            LAS const unsigned char* kt = lds + ((e - e0) & 1) * NSA_BUF; LAS const unsigned char* vt = kt + 64 * K128STR;
            bool selb = true; unsigned wu1 = 1u;
            if (ty == 1) { const int wd = ix >> 5, bit = ix & 31; wu1 = ((unsigned)__builtin_amdgcn_readfirstlane((int)wun[wave * 8 + wd]) >> bit) & 1u; selb = (selm[(32 * wave + Le.r) * 8 + wd] >> bit) & 1u; }
            const bool allsel = __all(selb);
#pragma unroll 1
            for (int sub = 1; sub >= 0; --sub) {
                int dist0, step, dmax, klmin; bool active, allv;
                if (ty == 0) { const int cb = 64 * ix + 32 * sub; active = cb <= wave_cmax; dist0 = t - (16 * cb + 31); step = 16; dmax = 0x7fffffff; klmin = 0; allv = tw0 - 16 * cb - 527 >= 0; }
                else if (ty == 1) { active = wu1 != 0u; dist0 = t - (64 * ix + 32 * sub); step = 1; dmax = 0x7fffffff; klmin = 0; allv = allsel && (tw0 - 64 * ix - 32 * sub - 31 >= 0); }
                else { const int tb = t0 - 512 + 64 * ix + 32 * sub; active = !(tb + 31 < tw0 - 511 || tb > tw0 + 31); dist0 = t - tb; step = 1; dmax = 512; klmin = -tb; allv = tb >= 0 && (tw0 - tb - 31 >= 0) && (tw0 + 31 - tb <= 511); }
                if (active)
                    flash32<128, K128STR, V128STR, 4>(st, q, qx, kt + 32 * sub * K128STR, vt + 32 * sub * V128STR, C2_128, Le, allv, -s2 * (float)dist0, s2 * (float)step,
                        [&](int kl) { const int dist = dist0 - step * kl; return selb && dist >= 0 && dist < dmax && kl >= klmin; });
            }
            { unsigned vote = 0u;
              if (e + 1 < nlist) { const unsigned dn = (unsigned)__builtin_amdgcn_readfirstlane((int)list[e + 1]);
                  if ((int)(dn >> 16) == ty && ((NSA_CUT >> ty) & 1)) {
                      float knr; int npos;
                      if (ty == 0) { knr = ((LAS const float*)(lds + NSA_PMC_OFF))[ix - 1]; npos = 1024 * ix + 15; }
                      else if (ty == 1) { const int jn = (int)(dn & 0xffffu); knr = ((LAS const float*)(lds + NSA_PM_OFF))[jn]; npos = 64 * jn + 63; }
                      else { const int bi = 4 * qt - 8 + ix - 1; knr = ((LAS const float*)(lds + NSA_PMW_OFF))[bi]; npos = 64 * bi + 63; }
                      const int dm = t - npos; const float dmin = (float)(dm > 0 ? dm : 0);
                      const bool okc = qn * knr - s2 * dmin < st.m - SKIP_THR;
                      vote = __all(okc) ? 1u : 0u; } }
              if (Le.lane == 0) votes[((e - e0) & 1) * 8 + wave] = vote; }
            fresh = false;
            __builtin_amdgcn_sched_barrier(0);
            if (e + 1 < nlist) tile_store((unsigned)__builtin_amdgcn_readfirstlane((int)list[e + 1]), (e + 1 - e0) & 1, opaque_v(tid));
            asm volatile("s_waitcnt lgkmcnt(0)" ::: "memory"); __builtin_amdgcn_s_barrier(); asm volatile("" ::: "memory");
        }
        if (pass < 3) { LAS float* stf = (LAS float*)(lds + NSA_STAT_OFF); stf[(hh * NTHREADS + tid) * 2] = st.m; stf[(hh * NTHREADS + tid) * 2 + 1] = flash_l(st); }
        branch_done(curty);
    }
}

#define XB_TMO      128
#define XB_XCNT(j)  (256  + 64 * (j))
#define XB_XSUB(j)  (1280 + 64 * (j))
#define XB_XGEN(j)  (2304 + 64 * (j))
#define XB_TOP      3328
#define XB_TOPGEN   3392
#define XCD_BAR_WORDS 3456
#define XB_SPIN_CAP (1u << 18)

__device__ __forceinline__ unsigned xb_ld(unsigned* p)              { return __hip_atomic_load(p, __ATOMIC_RELAXED, __HIP_MEMORY_SCOPE_AGENT); }
__device__ __forceinline__ unsigned xb_add(unsigned* p, unsigned v) { return __hip_atomic_fetch_add(p, v, __ATOMIC_RELAXED, __HIP_MEMORY_SCOPE_AGENT); }
__device__ __forceinline__ unsigned xb_xcc_id() { return (unsigned)__builtin_amdgcn_s_getreg((3 << 11) | 20) & 0xFu; }
#define XB_SPIN(cond, bar) do { unsigned _sp = 0; while (cond) { __builtin_amdgcn_s_sleep(1); \
    if ((++_sp & 255u) == 0u) { if (xb_ld(&(bar)[XB_TMO])) break; if (_sp > XB_SPIN_CAP) { atomicAdd(&(bar)[XB_TMO], 1u); break; } } } } while (0)

struct XcdBarrier {
    unsigned* bar; unsigned x;
    volatile LAS unsigned* st;
};

__device__ __forceinline__ XcdBarrier xcd_barrier_post(unsigned* bar, volatile LAS unsigned* st, int tid) {
    XcdBarrier b; b.bar = bar; b.x = xb_xcc_id(); b.st = st;
    if (tid == 0) (void)xb_add(&bar[XB_XCNT(b.x)], 1u);
    return b;
}
__device__ __forceinline__ void xcd_barrier_complete(unsigned* bar, unsigned x, unsigned& nloc, unsigned& nx) {
    const unsigned G = gridDim.x * gridDim.y * gridDim.z;
    unsigned sum, cnt, mine, sp = 0u;
    for (;;) {
        sum = 0u; cnt = 0u; mine = 0u;
#pragma unroll
        for (unsigned j = 0; j < 16; ++j) { const unsigned c = xb_ld(&bar[XB_XCNT(j)]); sum += c; cnt += (c > 0u) ? 1u : 0u; mine = (j == x) ? c : mine; }
        if (sum == G) break;
        __builtin_amdgcn_s_sleep(1);
        if ((++sp & 255u) == 0u) { if (xb_ld(&bar[XB_TMO])) break; if (sp > XB_SPIN_CAP) { atomicAdd(&bar[XB_TMO], 1u); break; } }
    }
    nloc = mine > 0u ? mine : 1u; nx = cnt > 0u ? cnt : 1u;
}

__device__ __forceinline__ void xcd_barrier(const XcdBarrier& b, int tid) {
    asm volatile("s_waitcnt vmcnt(0)" ::: "memory");
    __syncthreads();
    if (tid == 0) {
        unsigned* bar = b.bar;
        __builtin_amdgcn_s_waitcnt(0);
        unsigned nloc = b.st[0], nx = b.st[1];
        if (nloc == 0u) { xcd_barrier_complete(bar, b.x, nloc, nx); b.st[0] = nloc; b.st[1] = nx; }
        const unsigned old = xb_add(&bar[XB_XSUB(b.x)], 1u);
        const unsigned gen = old / nloc;
        if (old + 1u == (gen + 1u) * nloc) {
            __builtin_amdgcn_fence(__ATOMIC_RELEASE, "agent");
            asm volatile("s_waitcnt vmcnt(0)" ::: "memory");
            const unsigned og = xb_add(&bar[XB_TOP], 1u);
            const unsigned tg = og / nx;
            if (og + 1u == (tg + 1u) * nx) xb_add(&bar[XB_TOPGEN], 1u);
            else XB_SPIN(xb_ld(&bar[XB_TOPGEN]) == tg, bar);
            __builtin_amdgcn_fence(__ATOMIC_ACQUIRE, "agent");
            xb_add(&bar[XB_XGEN(b.x)], 1u);
            asm volatile("s_waitcnt vmcnt(0)" ::: "memory");
        } else {
            XB_SPIN(xb_ld(&bar[XB_XGEN(b.x)]) == gen, bar);
            __builtin_amdgcn_fence(__ATOMIC_ACQUIRE, "agent");
            asm volatile("s_waitcnt vmcnt(0)" ::: "memory");
        }
    }
    __syncthreads();
}

constexpr int NCONVQ = 256;
constexpr int NPL = 14;
constexpr int NPH = 1 + NPL * DEPTH;
struct Args { const float* in[27]; float* out; unsigned char* ws; int ph_lo, ph_hi; };
static_assert(sizeof(Args) == 27 * 8 + 8 + 8 + 8, "Args has no padding");

typedef __attribute__((address_space(4))) const unsigned long long* kargp_t;
DI kargp_t kargs_opaque() { const unsigned long long v = (unsigned long long)__builtin_amdgcn_kernarg_segment_ptr(); unsigned lo = (unsigned)v, hi = (unsigned)(v >> 32);
    asm volatile("" : "+s"(lo), "+s"(hi)); return (kargp_t)(((unsigned long long)hi << 32) | lo); }
DI const float* kin(kargp_t kp, int i) { return (const float*)kp[i]; }
DI LayerW layer_w(kargp_t kp, int l) {
    LayerW L;
    L.f1pre = kin(kp, 2) + (size_t)l * D; L.f1g = kin(kp, 3) + (size_t)l * D * FF; L.f1u = kin(kp, 4) + (size_t)l * D * FF; L.f1d = kin(kp, 5) + (size_t)l * FF * D; L.f1post = kin(kp, 6) + (size_t)l * D;
    L.mixpre = kin(kp, 7) + (size_t)l * D; L.win = kin(kp, 8) + (size_t)l * D * NIN; L.pek = kin(kp, 9) + (size_t)l * 4096; L.pev = kin(kp, 10) + (size_t)l * 4096;
    L.c1k = kin(kp, 11) + (size_t)l * 4096 * 256; L.c2k = kin(kp, 12) + (size_t)l * 256 * 128; L.c1v = kin(kp, 13) + (size_t)l * 4096 * 256; L.c2v = kin(kp, 14) + (size_t)l * 256 * 128;
    L.memg = kin(kp, 15) + (size_t)l * D; L.wmkv = kin(kp, 16) + (size_t)l * D * 1024; L.wupa = kin(kp, 17) + (size_t)l * 768 * D; L.wupb = kin(kp, 18) + (size_t)l * 256 * D; L.wupm = kin(kp, 19) + (size_t)l * 512 * D;
    L.wout = kin(kp, 20) + (size_t)l * D * D; L.mixpost = kin(kp, 21) + (size_t)l * D; L.f2pre = kin(kp, 22) + (size_t)l * D; L.f2g = kin(kp, 23) + (size_t)l * D * FF; L.f2u = kin(kp, 24) + (size_t)l * D * FF;
    L.f2d = kin(kp, 25) + (size_t)l * FF * D; L.f2post = kin(kp, 26) + (size_t)l * D;
    return L;
}

__global__ void __launch_bounds__(NTHREADS, 2) mk_fwd(Args args) {
    extern __shared__ __attribute__((aligned(16))) unsigned char lds_raw[];
    LAS unsigned char* lds = (LAS unsigned char*)lds_raw;
    const int G = gridDim.x, bx = blockIdx.x;
    const int wave0 = __builtin_amdgcn_readfirstlane((int)threadIdx.x >> 6);
#define MK_TID() (wave0 * 64 + lane_id_v())
    { const int tid0 = MK_TID();
      for (int u = tid0; u < (LDS_BYTES - LDSCTL_OFF) / 4; u += NTHREADS) ((LAS unsigned*)(lds + LDSCTL_OFF))[u] = 0u; }
    __syncthreads();
#if MK_ONE_LAUNCH
    XcdBarrier bar = xcd_barrier_post((unsigned*)((unsigned char*)kargs_opaque()[28] + WS_CTL) + CW_BAR, (volatile LAS unsigned*)(lds + MISC_OFF + 32), MK_TID());
#define GRID_BAR() xcd_barrier(bar, MK_TID())
#else
#define GRID_BAR() do { } while (0)
#endif
    const int lo = args.ph_lo, hi = args.ph_hi;
#define IN(k) (lo <= (k) && (k) < hi)
#define SEAM(k) do { if (IN(k) && IN((k) + 1)) GRID_BAR(); } while (0)
#ifndef PROBE_MASK
#define PROBE_MASK 0
#endif
#define PH_BEGIN(k) {
#define PH_END(k) }
#define PHASE_VIEWS() const kargp_t kp = kargs_opaque(); WsPtrs W; W.ws = (unsigned char*)kp[28]; float* const outp = (float*)kp[27]; (void)outp; const int tid = opaque_v(MK_TID()), lane = tid & 63, wave = wave0; \
    const int bxp = opaque_s(bx), Gp = opaque_s(G); const int gw = bxp * NWAVES + wave, NGW = Gp * NWAVES; (void)lane; (void)gw; (void)NGW; (void)W

    if (IN(0)) { PHASE_VIEWS();
        const LayerW L0 = layer_w(kp, 0);
        convert_layer<1>(L0, W, lds, bxp, Gp, tid);
        const float* x = kin(kp, 0);
        norm_phase_first(x, (bf16*)outp, W.RS(), T, gw, NGW, lane);
    }
    SEAM(0);
#pragma unroll 1
    for (int l = 0; l < DEPTH; ++l) {
        const int pb = 1 + NPL * l;
        if (IN(pb + 0)) { PH_BEGIN(0) PHASE_VIEWS(); pg8::Gemm g{(const bf16*)outp, W.wgu1(), T, 2 * FF, D}; pg8::StaticOrder S; S.init(T, 2 * FF, Gp, bxp); pg8::EpiSwiGLU E{W.HID(), FF, W.RS()};
            pg8::gemm_phase<pg8::EpiSwiGLU, pg8::StaticOrder, true, true>(lds, g, S, E, tid); PH_END(0) }
        SEAM(pb + 0);
        if (IN(pb + 1)) { PH_BEGIN(1) PHASE_VIEWS(); pg8::Gemm g{W.HID(), W.wd1(), T, D, FF}; pg8::StaticOrder S; S.init(T, D, Gp, bxp, 2); S.rev = 1; pg8::EpiBf16 E{W.F(), D, 1 << 30, 0, nullptr, 0, nullptr};
            pg8::gemm_phase<pg8::EpiBf16, pg8::StaticOrder, true, true>(lds, g, S, E, tid); PH_END(1) }
        SEAM(pb + 1);
        if (IN(pb + 2)) { PHASE_VIEWS(); const LayerW LW = layer_w(kp, opaque_s(l));
            bf16* hA = (bf16*)outp; const float* mem = kin(kp, 1);
            norm_phase_res<false, false>(hA, W.F(), LW.f1post, 0.5f, hA, W.RS(), gw, NGW, lane);
            norm_phase_first(mem, hA + (size_t)T * D, W.RS() + T, BATCH * MEML, gw, NGW, lane);
        }
        SEAM(pb + 2);
        if (IN(pb + 3)) { PH_BEGIN(3) PHASE_VIEWS(); pg8::Gemm g{(const bf16*)outp, W.win(), TM, NWIN, D}; pg8::OrderPlusExtra S; S.init(T, QP, Gp, bxp); S.nextra = 8; S.pm0 = T / 256; S.pn0 = QP / 256; S.ncx = 4;
            pg8::EpiBf16 E{W.QKV(), QP, T / 256, QP / 256, W.MEMKV(), 1024, W.RS()};
            pg8::gemm_phase<pg8::EpiBf16, pg8::OrderPlusExtra, true, true>(lds, g, S, E, tid); PH_END(3) }
        SEAM(pb + 3);
        if (IN(pb + 4)) { PH_BEGIN(4) PHASE_VIEWS();
#pragma unroll 1
            for (int it = bxp; it < 256; it += Gp) { const int tidu = opaque_v(MK_TID()); const LaneIx LX = lane_ix(tidu); cmp_unit(W, lds, it, tidu, wave, LX); }
            key_norms(W, gw, NGW, lane);
            __syncthreads();
        PH_END(4) }
        SEAM(pb + 4);
        if (IN(pb + 5)) { PH_BEGIN(5) PHASE_VIEWS();
#pragma unroll 1
            for (int it = bxp; it < 256; it += Gp) { const int tidu = opaque_v(MK_TID()); const LaneIx LX = lane_ix(tidu); nsa_unit(W, lds, ((it & 7) << 5) | ((it >> 3) & 31), tidu, wave, LX); }
            gu32* qhead = (gu32*)(W.ws + WS_CTL) + CW_QUEUE + 64 * opaque_s(l);
            volatile LAS int* qslot = (volatile LAS int*)(lds + MISC_OFF + 64);
#pragma unroll 1
            for (;;) {
                __syncthreads();
                if (MK_TID() == 0) *qslot = (int)__hip_atomic_fetch_add(qhead, 1u, RLX_AGENT);
                __syncthreads();
                int it = __builtin_amdgcn_readfirstlane(*qslot);
                const int nca = (l == 0) ? NCONVQ : 0, ncb = (l + 1 < DEPTH) ? NCONVQ : 0, ncv = nca + ncb;
                if (it >= ncv + 512 + 1536) break;
                const int tidu = opaque_v(MK_TID());
                if (it < nca) { const LayerW LC = layer_w(kp, opaque_s(l)); convert_layer<2>(LC, W, lds, it, NCONVQ, tidu); continue; }
                if (it < ncv) { const LayerW LN = layer_w(kp, opaque_s(l + 1)); convert_layer<1>(LN, W, lds, it - nca, NCONVQ, tidu); continue; }
                it -= ncv;
                const LaneIx LX = lane_ix(tidu);
                if (it < 512) mem_unit(W, lds, it, tidu, wave, LX); else dil_unit(W, lds, it - 512, tidu, wave, LX);
            }
            __syncthreads();
        PH_END(5) }
        SEAM(pb + 5);
        if (IN(pb + 6)) { PH_BEGIN(6) PHASE_VIEWS();
            dil_merge(W, bxp * NTHREADS + tid, Gp * NTHREADS);
            { pg8::Gemm g{W.YA(), W.wupa(), T, D, 768}; pg8::StaticOrder S; S.init(T, D, Gp, bxp); pg8::EpiBf16 E{W.P(), D, 1 << 30, 0, nullptr, 0, nullptr}; pg8::gemm_phase<pg8::EpiBf16, pg8::StaticOrder, true, true>(lds, g, S, E, tid); }
            { pg8::Gemm g{W.YM(), W.wupm(), T, D, 512}; pg8::StaticOrder S; S.init(T, D, Gp, bxp); pg8::EpiBf16 E{W.P() + (size_t)2 * T * D, D, 1 << 30, 0, nullptr, 0, nullptr}; pg8::gemm_phase<pg8::EpiBf16, pg8::StaticOrder, true, true>(lds, g, S, E, tid); }
        PH_END(6) }
        SEAM(pb + 6);
        if (IN(pb + 7)) { PH_BEGIN(7) PHASE_VIEWS();
            { pg8::Gemm g{W.YB(), W.wupb(), T, D, 256}; pg8::StaticOrder S; S.init(T, D, Gp, bxp); pg8::EpiBf16 E{W.P() + (size_t)T * D, D, 1 << 30, 0, nullptr, 0, nullptr}; pg8::gemm_phase<pg8::EpiBf16, pg8::StaticOrder, true, true>(lds, g, S, E, tid); }
        PH_END(7) }
        SEAM(pb + 7);
        if (IN(pb + 8)) { PHASE_VIEWS(); pg8::Gemm g{(const bf16*)outp, W.wgate(), T, 3 * D, D}; pg8::OrderTriple S; S.init(T, D, Gp, bxp); pg8::EpiGateMerge E{W.P(), (size_t)T * D, D, W.RS()};
            pg8::gemm_phase<pg8::EpiGateMerge, pg8::OrderTriple, true, true>(lds, g, S, E, tid); }
        SEAM(pb + 8);
        if (IN(pb + 9)) { PH_BEGIN(9) PHASE_VIEWS(); pg8::Gemm g{W.P(), W.wout(), T, D, D}; pg8::StaticOrder S; S.init(T, D, Gp, bxp); pg8::EpiBf16 E{W.F(), D, 1 << 30, 0, nullptr, 0, nullptr};
            pg8::gemm_phase<pg8::EpiBf16, pg8::StaticOrder, true, true>(lds, g, S, E, tid); PH_END(9) }
        SEAM(pb + 9);
        if (IN(pb + 10)) { PHASE_VIEWS(); const LayerW LW = layer_w(kp, opaque_s(l));
            norm_phase_res<false, false>((const bf16*)outp, W.F(), LW.mixpost, 1.0f, W.HB(), W.RS(), gw, NGW, lane);
        }
        SEAM(pb + 10);
        if (IN(pb + 11)) { PH_BEGIN(11) PHASE_VIEWS(); pg8::Gemm g{W.HB(), W.wgu2(), T, 2 * FF, D}; pg8::StaticOrder S; S.init(T, 2 * FF, Gp, bxp); pg8::EpiSwiGLU E{W.HID(), FF, W.RS()};
            pg8::gemm_phase<pg8::EpiSwiGLU, pg8::StaticOrder, true, true>(lds, g, S, E, tid); PH_END(11) }
        SEAM(pb + 11);
        if (IN(pb + 12)) { PH_BEGIN(12) PHASE_VIEWS(); pg8::Gemm g{W.HID(), W.wd2(), T, D, FF}; pg8::StaticOrder S; S.init(T, D, Gp, bxp, 2); S.rev = 1; pg8::EpiBf16 E{W.F(), D, 1 << 30, 0, nullptr, 0, nullptr};
            pg8::gemm_phase<pg8::EpiBf16, pg8::StaticOrder, true, true>(lds, g, S, E, tid); PH_END(12) }
        SEAM(pb + 12);
        if (IN(pb + 13)) { PHASE_VIEWS(); const LayerW LW = layer_w(kp, opaque_s(l));
            const bool more = (l + 1 < DEPTH);
            const LayerW LN = layer_w(kp, opaque_s(more ? l + 1 : l));
            if (more) norm_phase_res<false, false>(W.HB(), W.F(), LW.f2post, 0.5f, (bf16*)outp, W.RS(), gw, NGW, lane);
            else norm_phase_res<false, true>(W.HB(), W.F(), LW.f2post, 0.5f, outp, nullptr, gw, NGW, lane);
            if (more) { __syncthreads(); convert_layer<2>(LN, W, lds, bxp, Gp, tid); }
        }
        SEAM(pb + 13);
    }
#undef IN
#undef SEAM
}

extern "C" void kernel_launch(void* const* d_in, const int* in_sizes, int n_in, void* d_out, int out_size, void* d_ws, size_t ws_size, hipStream_t stream) {
    static int grid = 0;
    if (grid == 0) {
        if (n_in != 27 || in_sizes[0] != T * D || out_size != T * D || ws_size < WS_END) { fprintf(stderr, "kernel_launch: unexpected shapes (n_in %d, in0 %d, out %d, ws %zu, need %zu); nothing launched\n", n_in, n_in > 0 ? in_sizes[0] : -1, out_size, ws_size, (size_t)WS_END); grid = -1; return; }
        int dev = 0, cus = 0, per_cu = 0;
        if (hipGetDevice(&dev) != hipSuccess || hipDeviceGetAttribute(&cus, hipDeviceAttributeMultiprocessorCount, dev) != hipSuccess) { grid = -1; return; }
        if (hipFuncSetAttribute((const void*)mk_fwd, hipFuncAttributeMaxDynamicSharedMemorySize, LDS_BYTES) != hipSuccess) { fprintf(stderr, "kernel_launch: hipFuncSetAttribute failed\n"); grid = -1; return; }
        if (hipOccupancyMaxActiveBlocksPerMultiprocessor(&per_cu, (const void*)mk_fwd, NTHREADS, LDS_BYTES) != hipSuccess || per_cu < 1) fprintf(stderr, "kernel_launch: note: occupancy query reports %d\n", per_cu);
        (void)hipGetLastError();
        grid = cus;
    }
    if (grid < 0) return;
    if (hipMemsetAsync((char*)d_ws + WS_CTL, 0, CTL_ZERO_BYTES, stream) != hipSuccess) return;
    Args a{};
    for (int i = 0; i < 27; ++i) a.in[i] = (const float*)d_in[i];
    a.out = (float*)d_out; a.ws = (unsigned char*)d_ws;
#if MK_ONE_LAUNCH
    a.ph_lo = 0; a.ph_hi = NPH;
    hipLaunchKernelGGL(mk_fwd, dim3(grid), dim3(NTHREADS), LDS_BYTES, stream, a);
#else
    for (int p = 0; p < NPH; ++p) { a.ph_lo = p; a.ph_hi = p + 1; const int reps = ((p >= 1 && ((PROBE_MASK >> ((p - 1) % NPL)) & 1)) || (p == 0 && ((PROBE_MASK >> 13) & 1))) ? 2 : 1;
        for (int r = 0; r < reps; ++r) hipLaunchKernelGGL(mk_fwd, dim3(grid), dim3(NTHREADS), LDS_BYTES, stream, a); }
#endif
}
```
